# Optimizing an MI355X kernel written in HIP

```python
import math
import jax, jax.numpy as jnp
from jax import lax
import numpy as np

D_MODEL = 1024
BATCH = 8
SEQ = 2048
DEPTH = 4

N_EVEN = (DEPTH + 1) // 2
N_ODD = DEPTH // 2
MIX_WIDTH = D_MODEL
GLA_HEADS = 4
GLA_WIDTH = MIX_WIDTH // 2
GLA_HEAD_V = GLA_WIDTH // GLA_HEADS
GLA_KEY = GLA_WIDTH // 2
GLA_HEAD_K = GLA_KEY // GLA_HEADS
GATE_RANK = 16
GATE_NORMALIZER = 16.0
GLA_CHUNK = 64
DIFF_HEADS = 4
DIFF_WIDTH = MIX_WIDTH - GLA_WIDTH
DIFF_HEAD_V = DIFF_WIDTH // DIFF_HEADS
DIFF_HEAD_DIM = DIFF_HEAD_V // 2
Q_BLOCK = 128
REL_BUCKETS = 32
REL_MAX_DIST = 128
POOL_WINDOWS = (2, 4, 8, 16)
POOL_GROUPS = 4
POOL_GROUP_W = D_MODEL // POOL_GROUPS
N_EXPERTS = 16
N_EXPERT_GROUPS = 4
EXPERTS_PER_GROUP = N_EXPERTS // N_EXPERT_GROUPS
TOP_K = 2
D_FF = D_MODEL
ALPHA = (2.0 * DEPTH) ** 0.25
BETA = (8.0 * DEPTH) ** -0.25
LN_EPS = 1e-5
RMS_EPS = 1e-6

IN_SIZES = (GLA_KEY, GLA_KEY, GLA_WIDTH, GLA_WIDTH, 2 * GATE_RANK, DIFF_WIDTH, DIFF_WIDTH, DIFF_WIDTH)
IN_COLS = sum(IN_SIZES)
IN_OFFSETS = tuple(sum(IN_SIZES[:i + 1]) for i in range(len(IN_SIZES) - 1))

kernel_name = "hybrid_gla_diffattn_pool_groupedmoe_encoder"


def layer_norm(x, g, b):
    xf = x.astype(jnp.float32)
    mu = jnp.mean(xf, axis=-1, keepdims=True)
    var = jnp.mean(jnp.square(xf - mu), axis=-1, keepdims=True)
    return ((xf - mu) * lax.rsqrt(var + LN_EPS) * g + b).astype(x.dtype)


def rms_norm(x, w):
    xf = x.astype(jnp.float32)
    return xf * lax.rsqrt(jnp.mean(jnp.square(xf), axis=-1, keepdims=True) + RMS_EPS) * w


def t5_bucket(rel):
    nb = REL_BUCKETS // 2
    max_exact = nb // 2
    ret = jnp.where(rel > 0, nb, 0)
    n = jnp.abs(rel)
    nf = jnp.maximum(n, 1).astype(jnp.float32)
    large = max_exact + (jnp.log(nf / max_exact) / math.log(REL_MAX_DIST / max_exact)
                         * (nb - max_exact)).astype(jnp.int32)
    large = jnp.minimum(large, nb - 1)
    return ret + jnp.where(n < max_exact, n, large)


def gla_chunked(q, k, v, log_a, inclusive):
    B, H, S, dk = q.shape
    dv = v.shape[-1]
    L = GLA_CHUNK
    n = S // L
    q = q.reshape(B, H, n, L, dk)
    k = k.reshape(B, H, n, L, dk)
    v = v.reshape(B, H, n, L, dv)
    b = jnp.cumsum(log_a.reshape(B, H, n, L, dk), axis=3)
    b_mid = b[:, :, :, L // 2 - 1:L // 2, :]
    b_last = b[:, :, :, L - 1:L, :]
    scores = jnp.einsum('bhnik,bhnjk->bhnij', q * jnp.exp(b - b_mid), k * jnp.exp(b_mid - b))
    mask = jnp.tril(jnp.ones((L, L), dtype=bool), k=0 if inclusive else -1)
    o_intra = jnp.einsum('bhnij,bhnjv->bhniv', jnp.where(mask, scores, 0.0), v)
    d_state = jnp.einsum('bhnjk,bhnjv->bhnkv', k * jnp.exp(b_last - b), v)
    decay = jnp.exp(b_last[:, :, :, 0, :])

    def step(state, inp):
        dec, ds = inp
        return dec[..., None] * state + ds, state

    init = jnp.zeros((B, H, dk, dv), jnp.float32)
    _, prev_states = lax.scan(step, init, (jnp.moveaxis(decay, 2, 0), jnp.moveaxis(d_state, 2, 0)))
    prev_states = jnp.moveaxis(prev_states, 0, 2)
    o_inter = jnp.einsum('bhnik,bhnkv->bhniv', q * jnp.exp(b), prev_states)
    return (o_intra + o_inter).reshape(B, H, S, dv)


def gla_mixer(q, k, v, g_out, lowrank, w_gate, b_gate, norm_w):
    B, S, _ = q.shape

    def heads(t, d):
        return t.reshape(B, S, GLA_HEADS, d).transpose(0, 2, 1, 3).astype(jnp.float32)

    qh = heads(q, GLA_HEAD_K) * (GLA_HEAD_K ** -0.5)
    kh = heads(k, GLA_HEAD_K)
    vh = heads(v, GLA_HEAD_V)
    lr = lowrank.reshape(B, S, 2, GATE_RANK)
    logit = jnp.einsum('bsdr,drk->bsdk', lr, w_gate) + b_gate
    log_a = jax.nn.log_sigmoid(logit.astype(jnp.float32)) / GATE_NORMALIZER
    la_fwd = heads(log_a[:, :, 0], GLA_HEAD_K)
    la_bwd = heads(log_a[:, :, 1], GLA_HEAD_K)
    o_fwd = gla_chunked(qh, kh, vh, la_fwd, True)
    flip = lambda t: jnp.flip(t, axis=2)
    o_bwd = flip(gla_chunked(flip(qh), flip(kh), flip(vh), flip(la_bwd), False))
    o = rms_norm(o_fwd + o_bwd, norm_w)
    o = o.transpose(0, 2, 1, 3).reshape(B, S, GLA_WIDTH)
    return o * jax.nn.silu(g_out.astype(jnp.float32))


def diff_mixer(q, k, v, lam, norm_w, rel_bias, lam_init):
    B, S, _ = q.shape
    qh = q.reshape(B, S, DIFF_HEADS, 2, DIFF_HEAD_DIM).transpose(3, 0, 2, 1, 4).astype(jnp.float32)
    qh = qh * (DIFF_HEAD_DIM ** -0.5)
    kh = k.reshape(B, S, DIFF_HEADS, 2, DIFF_HEAD_DIM).transpose(3, 0, 2, 1, 4).astype(jnp.float32)
    vh = v.reshape(B, S, DIFF_HEADS, DIFF_HEAD_V).transpose(0, 2, 1, 3).astype(jnp.float32)
    lam = lam.astype(jnp.float32)
    lam_full = jnp.exp(jnp.sum(lam[0] * lam[1])) - jnp.exp(jnp.sum(lam[2] * lam[3])) + lam_init
    n_blocks = S // Q_BLOCK
    q_blocks = qh.reshape(2, B, DIFF_HEADS, n_blocks, Q_BLOCK, DIFF_HEAD_DIM).transpose(3, 0, 1, 2, 4, 5)
    kpos = jnp.arange(S, dtype=jnp.int32)

    def block(args):
        qb, start = args
        qpos = start + jnp.arange(Q_BLOCK, dtype=jnp.int32)
        bucket = t5_bucket(kpos[None, :] - qpos[:, None])
        bias = rel_bias[bucket].transpose(2, 0, 1).astype(jnp.float32)
        s = jnp.einsum('cbhqd,cbhkd->cbhqk', qb, kh) + bias
        p = jax.nn.softmax(s, axis=-1)
        return jnp.einsum('bhqk,bhkv->bhqv', p[0] - lam_full * p[1], vh)

    starts = jnp.arange(n_blocks, dtype=jnp.int32) * Q_BLOCK
    o = lax.map(block, (q_blocks, starts))
    o = o.transpose(1, 2, 0, 3, 4).reshape(B, DIFF_HEADS, S, DIFF_HEAD_V)
    o = rms_norm(o, norm_w) * (1.0 - lam_init)
    return o.transpose(0, 2, 1, 3).reshape(B, S, DIFF_WIDTH)


def pool_mixer(x, w_pool, scale):
    B, S, D = x.shape
    xg = x.astype(jnp.float32).reshape(B, S, POOL_GROUPS, POOL_GROUP_W)
    cs = jnp.pad(jnp.cumsum(xg, axis=1), ((0, 0), (1, 0), (0, 0), (0, 0)))
    half = jnp.array([w // 2 for w in POOL_WINDOWS], dtype=jnp.int32)
    pos = jnp.arange(S, dtype=jnp.int32)[:, None]
    lo = jnp.clip(pos - half[None, :], 0, S)
    hi = jnp.clip(pos + half[None, :], 0, S)
    gi = jnp.arange(POOL_GROUPS, dtype=jnp.int32)[None, :]
    window_sum = cs[:, hi, gi] - cs[:, lo, gi]
    count = (hi - lo).astype(jnp.float32)[None, :, :, None]
    pooled = window_sum / count - xg
    y = jnp.einsum('bsgc,gcd->bsgd', pooled, w_pool).reshape(B, S, D)
    return (y * scale).astype(x.dtype)


def grouped_moe(x, w_router, router_bias, w_gate, w_up, w_down):
    B, S, D = x.shape
    xt = x.reshape(B * S, D)
    aff = jax.nn.sigmoid((xt @ w_router).astype(jnp.float32))
    sel = aff + router_bias
    grouped = sel.reshape(-1, N_EXPERT_GROUPS, EXPERTS_PER_GROUP)
    group_score = jnp.sum(lax.top_k(grouped, TOP_K)[0], axis=-1)
    best_group = jnp.argmax(group_score, axis=-1)
    in_group = (jnp.arange(N_EXPERTS) // EXPERTS_PER_GROUP)[None, :] == best_group[:, None]
    _, idx = lax.top_k(jnp.where(in_group, sel, -jnp.inf), TOP_K)
    w = jnp.take_along_axis(aff, idx, axis=-1)
    w = w / jnp.sum(w, axis=-1, keepdims=True)
    gates = jnp.sum(jax.nn.one_hot(idx, N_EXPERTS, dtype=jnp.float32) * w[..., None], axis=1)
    y = jnp.zeros((B * S, D), jnp.float32)
    for e in range(N_EXPERTS):
        h = jax.nn.silu(xt @ w_gate[e]) * (xt @ w_up[e])
        y = y + gates[:, e:e + 1] * (h @ w_down[e])
    return y.reshape(B, S, D).astype(x.dtype)


def setup_inputs(seed: int = 0) -> dict:
    key = jax.random.key(seed)
    ks = jax.random.split(key, 18)
    nrm = jax.random.normal
    f32 = jnp.float32
    v_scale = jnp.concatenate([
        jnp.full((s,), BETA if name == 'v' else 1.0, f32)
        for s, name in zip(IN_SIZES, ('q', 'k', 'v', 'g', 'lr', 'q', 'k', 'v'))])
    return {
        "x": nrm(ks[0], (BATCH, SEQ, D_MODEL), f32),
        "rel_bias": 0.5 * nrm(ks[1], (REL_BUCKETS, DIFF_HEADS), f32),
        "w_in": nrm(ks[2], (N_EVEN, D_MODEL, IN_COLS), f32) * (D_MODEL ** -0.5) * v_scale,
        "w_gla_gate": nrm(ks[3], (N_EVEN, 2, GATE_RANK, GLA_KEY), f32) * (GATE_RANK ** -0.5),
        "b_gla_gate": 0.1 * nrm(ks[4], (N_EVEN, 2, GLA_KEY), f32),
        "gla_norm": 1.0 + 0.1 * nrm(ks[5], (N_EVEN, GLA_HEAD_V), f32),
        "diff_lambda": 0.1 * nrm(ks[6], (N_EVEN, 4, DIFF_HEAD_DIM), f32),
        "diff_norm": 1.0 + 0.1 * nrm(ks[7], (N_EVEN, DIFF_HEAD_V), f32),
        "w_out_mix": nrm(ks[8], (N_EVEN, MIX_WIDTH, D_MODEL), f32) * (MIX_WIDTH ** -0.5) * BETA,
        "w_pool": nrm(ks[9], (N_ODD, POOL_GROUPS, POOL_GROUP_W, POOL_GROUP_W), f32) * (POOL_GROUP_W ** -0.5) * BETA,
        "pool_scale": 1.0 + 0.1 * nrm(ks[10], (N_ODD, D_MODEL), f32),
        "ln_g": 1.0 + 0.1 * nrm(ks[11], (DEPTH, 2, D_MODEL), f32),
        "ln_b": 0.02 * nrm(ks[12], (DEPTH, 2, D_MODEL), f32),
        "w_router": nrm(ks[13], (D_MODEL, N_EXPERTS), f32) * (D_MODEL ** -0.5),
        "router_bias": 0.01 * nrm(ks[14], (N_EXPERTS,), f32),
        "w_gate": nrm(ks[15], (DEPTH, N_EXPERTS, D_MODEL, D_FF), f32) * (D_MODEL ** -0.5),
        "w_up": nrm(ks[16], (DEPTH, N_EXPERTS, D_MODEL, D_FF), f32) * (D_MODEL ** -0.5) * BETA,
        "w_down": nrm(ks[17], (DEPTH, N_EXPERTS, D_FF, D_MODEL), f32) * (D_FF ** -0.5) * BETA,
    }


def reference(x, rel_bias, w_in, w_gla_gate, b_gla_gate, gla_norm, diff_lambda, diff_norm,
              w_out_mix, w_pool, pool_scale, ln_g, ln_b, w_router, router_bias,
              w_gate, w_up, w_down):
    for layer in range(DEPTH):
        if layer % 2 == 0:
            i = layer // 2
            h = x @ w_in[i]
            gq, gk, gv, gg, glr, dq, dk, dv = jnp.split(h, IN_OFFSETS, axis=-1)
            o_gla = gla_mixer(gq, gk, gv, gg, glr, w_gla_gate[i], b_gla_gate[i], gla_norm[i])
            lam_init = 0.8 - 0.6 * math.exp(-0.3 * layer)
            o_diff = diff_mixer(dq, dk, dv, diff_lambda[i], diff_norm[i], rel_bias, lam_init)
            mix = (jnp.concatenate([o_gla, o_diff], axis=-1).astype(x.dtype) @ w_out_mix[i]).astype(x.dtype)
        else:
            j = layer // 2
            mix = pool_mixer(x, w_pool[j], pool_scale[j])
        x = layer_norm(ALPHA * x + mix, ln_g[layer, 0], ln_b[layer, 0])
        ffn = grouped_moe(x, w_router, router_bias, w_gate[layer], w_up[layer], w_down[layer])
        x = layer_norm(ALPHA * x + ffn, ln_g[layer, 1], ln_b[layer, 1])
    return x
```

```cpp
#include <hip/hip_runtime.h>
#include <stdint.h>
#include <stdio.h>

typedef unsigned short u16;
typedef unsigned int u32;
typedef __attribute__((ext_vector_type(8))) short bf16x8;
typedef __attribute__((ext_vector_type(4))) float f32x4;
typedef __attribute__((ext_vector_type(16))) float f32x16;
#define LAS __attribute__((address_space(3)))

#ifndef ONE_LAUNCH
#define ONE_LAUNCH 0
#endif

constexpr int TOK = 16384, DM = 1024, SEQ = 2048, NBATCH = 8, NLAYER = 4;
constexpr int HC = 2560;
constexpr int NEXP = 16;
constexpr int IN_COLS = 3104;
constexpr float ALPHA = 1.681792830507429f;
constexpr float LN_EPS = 1e-5f, RMS_EPS = 1e-6f;
constexpr int NTHR = 512;
constexpr int LDS_BYTES = 163840 - 256;
constexpr int LDS_BARW = LDS_BYTES - 16;
constexpr int LDS_MOEMAP = LDS_BARW - 256;

constexpr size_t WS_CTL   = 0;
constexpr size_t CTL_BYTES = 65536;
constexpr size_t CTL_CNT  = 16384;
constexpr size_t WS_WIN   = WS_CTL + CTL_BYTES;
constexpr size_t WS_WOUT  = WS_WIN + (size_t)2 * 3072 * 1024 * 2;
constexpr size_t WS_WPOOL = WS_WOUT + (size_t)2 * 1024 * 1024 * 2;
constexpr size_t WS_WG    = WS_WPOOL + (size_t)2 * 4 * 256 * 256 * 2;
constexpr size_t WS_WU    = WS_WG + (size_t)64 * 1048576 * 2;
constexpr size_t WS_WD    = WS_WU + (size_t)64 * 1048576 * 2;
constexpr size_t WS_XA    = WS_WD + (size_t)64 * 1048576 * 2;
constexpr size_t WS_XB    = WS_XA + (size_t)TOK * DM * 4;
constexpr size_t WS_XH    = WS_XB + (size_t)TOK * DM * 4;
constexpr size_t WS_MIXIN = WS_XH + (size_t)TOK * DM * 2;
constexpr size_t WS_LR    = WS_MIXIN + (size_t)TOK * DM * 2;
constexpr size_t WS_VT    = WS_LR + (size_t)TOK * 32 * 4;
constexpr size_t WS_R1    = WS_VT + (size_t)TOK * 512 * 2;
constexpr size_t R1_BYTES = (size_t)TOK * HC * 2;
constexpr size_t WS_R2    = WS_R1 + R1_BYTES;
constexpr size_t R2_BYTES = (size_t)36864 * 1024 * 2 > (size_t)TOK * DM * 4 ? (size_t)36864 * 1024 * 2 : (size_t)TOK * DM * 4;
constexpr size_t WS_SLOT  = WS_R2 + R2_BYTES;
constexpr size_t WS_TINFO = WS_SLOT + (size_t)16 * 16384 * 4;
constexpr size_t WS_DEC   = WS_TINFO + (size_t)TOK * 32;
constexpr size_t WS_END   = WS_DEC + (size_t)1024 * 2 * 64 * 4;

__device__ __forceinline__ u16 f2bf(float f) { u32 u = __float_as_uint(f); u += 0x7fffu + ((u >> 16) & 1u); return (u16)(u >> 16); }
__device__ __forceinline__ float bf2f(u16 h) { return __uint_as_float(((u32)h) << 16); }
__device__ __forceinline__ u32 pack2(float a, float b) { return (u32)f2bf(a) | ((u32)f2bf(b) << 16); }
__device__ __forceinline__ float wave_sum(float v) {
#pragma unroll
    for (int o = 32; o > 0; o >>= 1) v += __shfl_xor(v, o);
    return v;
}
__device__ __forceinline__ int otid() { int t = threadIdx.x; asm volatile("" : "+v"(t)); return t; }
__device__ __forceinline__ float sigmoidf_(float x) { return 1.f / (1.f + __expf(-x)); }

#define XB_TMO      128
#define XB_XCNT(j)  (256  + 64 * (j))
#define XB_XSUB(j)  (1280 + 64 * (j))
#define XB_XGEN(j)  (2304 + 64 * (j))
#define XB_TOP      3328
#define XB_TOPGEN   3392
#define XCD_BAR_WORDS 3456
#define XB_SPIN_CAP (1u << 20)
__device__ __forceinline__ unsigned xb_ld(unsigned* p)              { return __hip_atomic_load(p, __ATOMIC_RELAXED, __HIP_MEMORY_SCOPE_AGENT); }
__device__ __forceinline__ unsigned xb_add(unsigned* p, unsigned v) { return __hip_atomic_fetch_add(p, v, __ATOMIC_RELAXED, __HIP_MEMORY_SCOPE_AGENT); }
__device__ __forceinline__ unsigned xb_xcc_id() { return (unsigned)__builtin_amdgcn_s_getreg((3 << 11) | 20) & 0xFu; }
#define XB_SPIN(cond, bar) do { unsigned _sp = 0; while (cond) { __builtin_amdgcn_s_sleep(1); \
    if ((++_sp & 255u) == 0u) { if (xb_ld(&(bar)[XB_TMO])) break; if (_sp > XB_SPIN_CAP) { atomicAdd(&(bar)[XB_TMO], 1u); break; } } } } while (0)
struct XcdBarrier { unsigned* bar; unsigned x; volatile LAS unsigned* st; };
__device__ __forceinline__ XcdBarrier xcd_barrier_post(unsigned* bar, volatile LAS unsigned* st) {
    XcdBarrier b; b.bar = bar; b.x = xb_xcc_id(); b.st = st;
    if (threadIdx.x == 0) (void)xb_add(&bar[XB_XCNT(b.x)], 1u);
    return b;
}
__device__ __forceinline__ void xcd_barrier_complete(unsigned* bar, unsigned x, unsigned& nloc, unsigned& nx) {
    const unsigned G = gridDim.x * gridDim.y * gridDim.z;
    unsigned sum, cnt, mine, sp = 0u;
    for (;;) {
        sum = 0u; cnt = 0u; mine = 0u;
#pragma unroll
        for (unsigned j = 0; j < 16; ++j) { const unsigned c = xb_ld(&bar[XB_XCNT(j)]); sum += c; cnt += (c > 0u) ? 1u : 0u; mine = (j == x) ? c : mine; }
        if (sum == G) break;
        __builtin_amdgcn_s_sleep(1);
        if ((++sp & 255u) == 0u) { if (xb_ld(&bar[XB_TMO])) break; if (sp > XB_SPIN_CAP) { atomicAdd(&bar[XB_TMO], 1u); break; } }
    }
    nloc = mine > 0u ? mine : 1u; nx = cnt > 0u ? cnt : 1u;
}
__device__ __forceinline__ void xcd_barrier(const XcdBarrier& b) {
    asm volatile("s_waitcnt vmcnt(0)" ::: "memory");
    __syncthreads();
    if (threadIdx.x == 0) {
        unsigned* bar = b.bar;
        __builtin_amdgcn_s_waitcnt(0);
        unsigned nloc = b.st[0], nx = b.st[1];
        if (nloc == 0u) { xcd_barrier_complete(bar, b.x, nloc, nx); b.st[0] = nloc; b.st[1] = nx; }
        const unsigned old = xb_add(&bar[XB_XSUB(b.x)], 1u);
        const unsigned gen = old / nloc;
        if (old + 1u == (gen + 1u) * nloc) {
            __builtin_amdgcn_fence(__ATOMIC_RELEASE, "agent");
            asm volatile("s_waitcnt vmcnt(0)" ::: "memory");
            const unsigned og = xb_add(&bar[XB_TOP], 1u);
            const unsigned tg = og / nx;
            if (og + 1u == (tg + 1u) * nx) xb_add(&bar[XB_TOPGEN], 1u);
            else XB_SPIN(xb_ld(&bar[XB_TOPGEN]) == tg, bar);
            __builtin_amdgcn_fence(__ATOMIC_ACQUIRE, "agent");
            xb_add(&bar[XB_XGEN(b.x)], 1u);
            asm volatile("s_waitcnt vmcnt(0)" ::: "memory");
        } else {
            XB_SPIN(xb_ld(&bar[XB_XGEN(b.x)]) == gen, bar);
            __builtin_amdgcn_fence(__ATOMIC_ACQUIRE, "agent");
            asm volatile("s_waitcnt vmcnt(0)" ::: "memory");
        }
    }
    __syncthreads();
}

struct Params {
    const float* in[18];
    float* out;
    unsigned char* ws;
    int ph_lo, ph_hi;
};
enum { I_X = 0, I_RELB, I_WIN, I_WGG, I_BGG, I_GNORM, I_DLAM, I_DNORM, I_WOUT, I_WPOOL, I_PSCALE, I_LNG, I_LNB, I_WR, I_RB, I_WG, I_WU, I_WD };

constexpr int BK = 64, HALF = 128, HT = HALF * BK;
__device__ __forceinline__ int lds_byte(int r, int c) {
    int st = (r >> 4) * 2 + (c >> 5), rr = r & 15, cc = c & 31, ob = rr * 64 + cc * 2;
    return st * 1024 + (ob ^ (((ob >> 9) & 1) << 5));
}
__device__ __forceinline__ void stage_rc(int b, int& R, int& C) {
    int st = b / 1024, sb = b % 1024, swz = sb ^ (((sb >> 9) & 1) << 5);
    R = (st >> 1) * 16 + swz / 64; C = (st & 1) * 32 + (swz % 64) / 2;
}

#define WAIT_V(n) asm volatile("s_waitcnt vmcnt(" #n ")" ::: "memory")
#define WAIT_L(n) asm volatile("s_waitcnt lgkmcnt(" #n ")" ::: "memory")
#define BAR __builtin_amdgcn_s_barrier()
#define SCHED __builtin_amdgcn_sched_barrier(0)

template <bool SWAP, bool GATHER>
__device__ __forceinline__ void gemm_core(u16* shm, const u16* __restrict__ A, const int (&aq)[4], int lda64,
                                          const u16* __restrict__ B0p, const u16* __restrict__ B1p, int bo, int ldb64,
                                          int nt, f32x4 (&acc)[2][2][4][2]) {
#define SA(b, h) (shm + ((b) * 2 + (h)) * HT)
#define SB(b, h) (shm + (4 + (b) * 2 + (h)) * HT)
#define GLDS(src, dst) __builtin_amdgcn_global_load_lds((const unsigned*)(src), (unsigned*)(dst), 16, 0, 0)
#define AOFF(q) (GATHER ? aq[q] : aq[0] + (q) * lda64)
#define GLDS_O(base, off, dst) do { int _o = (off); asm volatile("" : "+v"(_o)); GLDS((base) + _o, dst); } while (0)
#define STAGE_A(P, h, kt) do { const u16* _s = A + (kt) * BK; char* _d = (char*)(P) + tz * 16; \
        GLDS_O(_s, AOFF(2 * (h)), _d); GLDS_O(_s, AOFF(2 * (h) + 1), _d + 8192); } while (0)
#define STAGE_B(P, h, kt) do { const u16* _s = ((h) ? B1p : B0p) + (kt) * BK; char* _d = (char*)(P) + tz * 16; \
        GLDS_O(_s, bo, _d); GLDS_O(_s, bo + ldb64, _d + 8192); } while (0)
#define LDA(dst, b, h) _Pragma("unroll") for (int m = 0; m < 4; ++m) _Pragma("unroll") for (int k = 0; k < 2; ++k) \
        dst[m][k] = *reinterpret_cast<const bf16x8*>((char*)SA(b, h) + lds_byte(wr * 64 + m * 16 + fr, k * 32 + fq * 8))
#define LDB(dst, b, h) _Pragma("unroll") for (int n = 0; n < 2; ++n) _Pragma("unroll") for (int k = 0; k < 2; ++k) \
        dst[n][k] = *reinterpret_cast<const bf16x8*>((char*)SB(b, h) + lds_byte(wc * 32 + n * 16 + fr, k * 32 + fq * 8))
#define MMA(ai, bj, At, Bt) do { __builtin_amdgcn_s_setprio(1); \
        _Pragma("unroll") for (int m = 0; m < 4; ++m) _Pragma("unroll") for (int n = 0; n < 2; ++n) _Pragma("unroll") for (int k = 0; k < 2; ++k) \
            acc[ai][bj][m][n] = SWAP ? __builtin_amdgcn_mfma_f32_16x16x32_bf16(Bt[n][k], At[m][k], acc[ai][bj][m][n], 0, 0, 0) \
                                     : __builtin_amdgcn_mfma_f32_16x16x32_bf16(At[m][k], Bt[n][k], acc[ai][bj][m][n], 0, 0, 0); \
        __builtin_amdgcn_s_setprio(0); } while (0)
    int tz = otid();
    int wid = tz >> 6, lane = tz & 63, wr = wid >> 2, wc = wid & 3, fr = lane & 15, fq = lane >> 4;
    bf16x8 At[4][2], B0[2][2], B1[2][2];
    STAGE_B(SB(0, 0), 0, 0); STAGE_A(SA(0, 0), 0, 0);
    STAGE_B(SB(0, 1), 1, 0); STAGE_A(SA(0, 1), 1, 0);
    if (wr == 1) BAR;
    WAIT_V(4); BAR;
    STAGE_B(SB(1, 0), 0, 1); STAGE_A(SA(1, 0), 0, 1); STAGE_B(SB(1, 1), 1, 1);
    WAIT_V(6); BAR;
    for (int t = 0; t < nt - 2; t += 2) {
        LDB(B0, 0, 0); SCHED; LDA(At, 0, 0); STAGE_A(SA(1, 1), 1, t + 1);
        WAIT_L(8); BAR; WAIT_L(0); MMA(0, 0, At, B0); BAR; SCHED;
        LDB(B1, 0, 1); STAGE_B(SB(0, 0), 0, t + 2);
        BAR; WAIT_L(0); MMA(0, 1, At, B1); BAR;
        LDA(At, 0, 1); STAGE_A(SA(0, 0), 0, t + 2);
        BAR; WAIT_L(0); MMA(1, 0, At, B0); BAR; SCHED;
        STAGE_B(SB(0, 1), 1, t + 2);
        WAIT_V(6); BAR; MMA(1, 1, At, B1); BAR;
        LDB(B0, 1, 0); SCHED; LDA(At, 1, 0); STAGE_A(SA(0, 1), 1, t + 2);
        WAIT_L(8); BAR; WAIT_L(0); MMA(0, 0, At, B0); BAR; SCHED;
        LDB(B1, 1, 1); STAGE_B(SB(1, 0), 0, t + 3);
        BAR; WAIT_L(0); MMA(0, 1, At, B1); BAR;
        LDA(At, 1, 1); STAGE_A(SA(1, 0), 0, t + 3);
        BAR; WAIT_L(0); MMA(1, 0, At, B0); BAR; SCHED;
        STAGE_B(SB(1, 1), 1, t + 3);
        WAIT_V(6); BAR; MMA(1, 1, At, B1); BAR;
    }
    asm volatile("" : "+v"(tz)); wid = tz >> 6; lane = tz & 63; wr = wid >> 2; wc = wid & 3; fr = lane & 15; fq = lane >> 4;
    { LDB(B0, 0, 0); WAIT_V(0); LDA(At, 0, 0); STAGE_A(SA(1, 1), 1, nt - 1);
      BAR; WAIT_L(0); MMA(0, 0, At, B0); BAR;
      LDB(B1, 0, 1); BAR; WAIT_L(0); MMA(0, 1, At, B1); BAR;
      LDA(At, 0, 1); WAIT_V(4); BAR; WAIT_L(0); MMA(1, 0, At, B0); MMA(1, 1, At, B1); BAR; }
    { LDB(B0, 1, 0); LDA(At, 1, 0); WAIT_V(2); BAR; WAIT_L(0); MMA(0, 0, At, B0); BAR;
      LDB(B1, 1, 1); WAIT_V(0); BAR; WAIT_L(0); MMA(0, 1, At, B1); BAR;
      LDA(At, 1, 1); BAR; WAIT_L(0); MMA(1, 0, At, B0); MMA(1, 1, At, B1); BAR; }
    if (wr == 0) BAR;
#undef SA
#undef SB
#undef STAGE_A
#undef GLDS_O
#undef AOFF
#undef STAGE_B
#undef LDA
#undef LDB
#undef MMA
}

__device__ __forceinline__ void stage_geom(int& R0, int& C0) { stage_rc(otid() * 16, R0, C0); }

#define ACC_ZERO(acc) do { _Pragma("unroll") for (int a_ = 0; a_ < 2; ++a_) _Pragma("unroll") for (int b_ = 0; b_ < 2; ++b_) _Pragma("unroll") for (int m_ = 0; m_ < 4; ++m_) _Pragma("unroll") for (int n_ = 0; n_ < 2; ++n_) \
        acc[a_][b_][m_][n_] = f32x4{0.f, 0.f, 0.f, 0.f}; } while (0)

__device__ __forceinline__ void phase_inproj(u16* shm, const u16* __restrict__ XH, const u16* __restrict__ Wt, u16* __restrict__ Hb, u16* __restrict__ Vt) {
    const int nunits = 64 * 12;
    for (int u = blockIdx.x; u < nunits; u += gridDim.x) {
        const int pm = u & 63, pn = u >> 6;
        const int brow = pm * 256, bcol = pn * 256;
        int R0, C0; stage_geom(R0, C0);
        const int aq[4] = {(brow + R0) * DM + C0, 0, 0, 0};
        const u16* B0p = Wt + (size_t)bcol * DM;
        const int bo = R0 * DM + C0;
        f32x4 acc[2][2][4][2]; ACC_ZERO(acc);
        if (pn < 10) {
            gemm_core<true, false>(shm, XH, aq, 64 * DM, B0p, B0p + (size_t)128 * DM, bo, 64 * DM, DM / BK, acc);
            int tz = otid();
            const int wid = tz >> 6, lane = tz & 63, wr = wid >> 2, wc = wid & 3, fr = lane & 15, fq = lane >> 4;
            _Pragma("unroll") for (int ai = 0; ai < 2; ++ai) _Pragma("unroll") for (int bj = 0; bj < 2; ++bj) _Pragma("unroll") for (int m = 0; m < 4; ++m) _Pragma("unroll") for (int n = 0; n < 2; ++n) {
                const int row = brow + ai * 128 + wr * 64 + m * 16 + fr;
                const int col = bcol + bj * 128 + wc * 32 + n * 16 + fq * 4;
                uint2 v; v.x = pack2(acc[ai][bj][m][n][0], acc[ai][bj][m][n][1]); v.y = pack2(acc[ai][bj][m][n][2], acc[ai][bj][m][n][3]);
                *reinterpret_cast<uint2*>(Hb + (size_t)row * HC + col) = v;
            }
        } else {
            gemm_core<false, false>(shm, XH, aq, 64 * DM, B0p, B0p + (size_t)128 * DM, bo, 64 * DM, DM / BK, acc);
            int tz = otid();
            const int wid = tz >> 6, lane = tz & 63, wr = wid >> 2, wc = wid & 3, fr = lane & 15, fq = lane >> 4;
            _Pragma("unroll") for (int ai = 0; ai < 2; ++ai) _Pragma("unroll") for (int bj = 0; bj < 2; ++bj) _Pragma("unroll") for (int m = 0; m < 4; ++m) _Pragma("unroll") for (int n = 0; n < 2; ++n) {
                const int row = brow + ai * 128 + wr * 64 + m * 16 + fq * 4;
                const int col = bcol - 2560 + bj * 128 + wc * 32 + n * 16 + fr;
                const int b = row >> 11, s = row & 2047, hd = col >> 7, dv = col & 127;
                uint2 v; v.x = pack2(acc[ai][bj][m][n][0], acc[ai][bj][m][n][1]); v.y = pack2(acc[ai][bj][m][n][2], acc[ai][bj][m][n][3]);
                *reinterpret_cast<uint2*>(Vt + ((size_t)((b * 4 + hd) * 128 + dv)) * SEQ + s) = v;
            }
        }
    }
}

__device__ __forceinline__ void phase_mixproj(u16* shm, const u16* __restrict__ MIX, const u16* __restrict__ Wt, bool pool,
                              const float* __restrict__ xin, const float* __restrict__ scale, float* __restrict__ Z) {
    const int nunits = 64 * 4;
    for (int u = blockIdx.x; u < nunits; u += gridDim.x) {
        const int pm = u & 63, pn = u >> 6;
        const int brow = pm * 256, bcol = pn * 256;
        int R0, C0; stage_geom(R0, C0);
        const int ldb = pool ? 256 : 1024;
        const int aq[4] = {(brow + R0) * DM + C0 + (pool ? pn * 256 : 0), 0, 0, 0};
        const u16* B0p = pool ? (Wt + (size_t)pn * 65536) : (Wt + (size_t)bcol * DM);
        const int bo = R0 * ldb + C0;
        f32x4 acc[2][2][4][2]; ACC_ZERO(acc);
        gemm_core<true, false>(shm, MIX, aq, 64 * DM, B0p, B0p + (size_t)128 * ldb, bo, 64 * ldb, ldb / BK, acc);
        int tz = otid();
        const int wid = tz >> 6, lane = tz & 63, wr = wid >> 2, wc = wid & 3, fr = lane & 15, fq = lane >> 4;
        _Pragma("unroll") for (int ai = 0; ai < 2; ++ai) _Pragma("unroll") for (int bj = 0; bj < 2; ++bj) _Pragma("unroll") for (int m = 0; m < 4; ++m) _Pragma("unroll") for (int n = 0; n < 2; ++n) {
            const int row = brow + ai * 128 + wr * 64 + m * 16 + fr;
            const int col = bcol + bj * 128 + wc * 32 + n * 16 + fq * 4;
            const float4 xv = *reinterpret_cast<const float4*>(xin + (size_t)row * DM + col);
            float4 sc = make_float4(1.f, 1.f, 1.f, 1.f);
            if (pool) sc = *reinterpret_cast<const float4*>(scale + col);
            float4 o;
            o.x = ALPHA * xv.x + acc[ai][bj][m][n][0] * sc.x; o.y = ALPHA * xv.y + acc[ai][bj][m][n][1] * sc.y;
            o.z = ALPHA * xv.z + acc[ai][bj][m][n][2] * sc.z; o.w = ALPHA * xv.w + acc[ai][bj][m][n][3] * sc.w;
            *reinterpret_cast<float4*>(Z + (size_t)row * DM + col) = o;
        }
    }
}

struct MoeMap { int toff[17]; int cnt[16]; };
__device__ __forceinline__ void moe_build_map(LAS MoeMap* mp, const u32* __restrict__ gcnt) {
    if (otid() == 0) {
        int o = 0;
        for (int e = 0; e < 16; ++e) { int c = (int)__hip_atomic_load(gcnt + e, __ATOMIC_RELAXED, __HIP_MEMORY_SCOPE_AGENT); mp->cnt[e] = c; mp->toff[e] = o; o += (c + 255) >> 8; }
        mp->toff[16] = o;
    }
    __syncthreads();
}

__device__ __forceinline__ void phase_moe1(u16* shm, LAS MoeMap* mp, const u32* __restrict__ gcnt, const int* __restrict__ slot_tok, const u16* __restrict__ XH,
                           const u16* __restrict__ Wg, const u16* __restrict__ Wu, u16* __restrict__ Hout) {
    moe_build_map(mp, gcnt);
    const int RT = mp->toff[16];
    const int nunits = RT * 8;
    for (int u = blockIdx.x; u < nunits; u += gridDim.x) {
        const int rt = u >> 3, ft = u & 7;
        int e = 0;
        for (int i = 1; i < 16; ++i) e += (rt >= mp->toff[i]) ? 1 : 0;
        const int pos0 = (rt - mp->toff[e]) * 256, ne = mp->cnt[e];
        int R0, C0; stage_geom(R0, C0);
        int aq[4];
#pragma unroll
        for (int q = 0; q < 4; ++q) {
            const int p = pos0 + q * 64 + R0;
            const int tok = (p < ne) ? slot_tok[e * 16384 + p] : 0;
            aq[q] = tok * DM + C0;
        }
        const u16* B0p = Wg + ((size_t)e * 1024 + ft * 128) * DM;
        const u16* B1p = Wu + ((size_t)e * 1024 + ft * 128) * DM;
        const int bo = R0 * DM + C0;
        f32x4 acc[2][2][4][2]; ACC_ZERO(acc);
        gemm_core<true, true>(shm, XH, aq, 0, B0p, B1p, bo, 64 * DM, DM / BK, acc);
        int tz = otid();
        const int wid = tz >> 6, lane = tz & 63, wr = wid >> 2, wc = wid & 3, fr = lane & 15, fq = lane >> 4;
        _Pragma("unroll") for (int ai = 0; ai < 2; ++ai) _Pragma("unroll") for (int m = 0; m < 4; ++m) _Pragma("unroll") for (int n = 0; n < 2; ++n) {
            const int row = rt * 256 + ai * 128 + wr * 64 + m * 16 + fr;
            const int col = ft * 128 + wc * 32 + n * 16 + fq * 4;
            float hv[4];
#pragma unroll
            for (int j = 0; j < 4; ++j) { const float g = acc[ai][0][m][n][j], uu = acc[ai][1][m][n][j]; hv[j] = g * sigmoidf_(g) * uu; }
            uint2 v; v.x = pack2(hv[0], hv[1]); v.y = pack2(hv[2], hv[3]);
            *reinterpret_cast<uint2*>(Hout + (size_t)row * 1024 + col) = v;
        }
    }
}

__device__ __forceinline__ void phase_moe2(u16* shm, LAS MoeMap* mp, const u32* __restrict__ gcnt, const u16* __restrict__ Hin, const u16* __restrict__ Wd, u16* __restrict__ Y) {
    moe_build_map(mp, gcnt);
    const int RT = mp->toff[16];
    const int nunits = RT * 4;
    for (int u = blockIdx.x; u < nunits; u += gridDim.x) {
        const int rt = u >> 2, pn = u & 3;
        int e = 0;
        for (int i = 1; i < 16; ++i) e += (rt >= mp->toff[i]) ? 1 : 0;
        int R0, C0; stage_geom(R0, C0);
        const int aq[4] = {(rt * 256 + R0) * 1024 + C0, 0, 0, 0};
        const u16* B0p = Wd + ((size_t)e * 1024 + pn * 256) * 1024;
        const int bo = R0 * 1024 + C0;
        f32x4 acc[2][2][4][2]; ACC_ZERO(acc);
        gemm_core<true, false>(shm, Hin, aq, 64 * 1024, B0p, B0p + (size_t)128 * 1024, bo, 64 * 1024, 1024 / BK, acc);
        int tz = otid();
        const int wid = tz >> 6, lane = tz & 63, wr = wid >> 2, wc = wid & 3, fr = lane & 15, fq = lane >> 4;
        _Pragma("unroll") for (int ai = 0; ai < 2; ++ai) _Pragma("unroll") for (int bj = 0; bj < 2; ++bj) _Pragma("unroll") for (int m = 0; m < 4; ++m) _Pragma("unroll") for (int n = 0; n < 2; ++n) {
            const int row = rt * 256 + ai * 128 + wr * 64 + m * 16 + fr;
            const int col = pn * 256 + bj * 128 + wc * 32 + n * 16 + fq * 4;
            uint2 v; v.x = pack2(acc[ai][bj][m][n][0], acc[ai][bj][m][n][1]); v.y = pack2(acc[ai][bj][m][n][2], acc[ai][bj][m][n][3]);
            *reinterpret_cast<uint2*>(Y + (size_t)row * 1024 + col) = v;
        }
    }
}

__device__ __forceinline__ void conv_tile(float* sT, const float* __restrict__ src, int ld, int k0, int n0src, u16* __restrict__ dst, int K, int n0dst) {
    const int tid = otid();
    { const int r = tid >> 4, c4 = (tid & 15) * 4;
      const float4 a = *reinterpret_cast<const float4*>(src + (size_t)(k0 + r) * ld + n0src + c4);
      const float4 b = *reinterpret_cast<const float4*>(src + (size_t)(k0 + r + 32) * ld + n0src + c4);
      float* p = sT + r * 65 + c4; p[0] = a.x; p[1] = a.y; p[2] = a.z; p[3] = a.w;
      p = sT + (r + 32) * 65 + c4; p[0] = b.x; p[1] = b.y; p[2] = b.z; p[3] = b.w; }
    __syncthreads();
    { const int n = tid >> 3, k8 = (tid & 7) * 8;
      float v[8];
      for (int j = 0; j < 8; ++j) v[j] = sT[(k8 + j) * 65 + n];
      uint4 o; o.x = pack2(v[0], v[1]); o.y = pack2(v[2], v[3]); o.z = pack2(v[4], v[5]); o.w = pack2(v[6], v[7]);
      *reinterpret_cast<uint4*>(dst + (size_t)(n0dst + n) * K + k0 + k8) = o; }
    __syncthreads();
}
__device__ __forceinline__ void phase_convert(float* sT, const Params& p) {
    unsigned char* ws = p.ws;
    const int total = 2176 + 49152;
    for (int t = blockIdx.x; t < total; t += gridDim.x) {
        if (t < 1536) {
            const int i = t / 768, r = t % 768, kt = r / 48, ntl = r % 48;
            const int n0 = ntl * 64, n0src = n0 + (n0 >= 1536 ? 32 : 0);
            conv_tile(sT, p.in[I_WIN] + (size_t)i * 1024 * IN_COLS, IN_COLS, kt * 64, n0src, (u16*)(ws + WS_WIN) + (size_t)i * 3072 * 1024, 1024, n0);
        } else if (t < 2048) {
            const int q = t - 1536, i = q >> 8, r = q & 255, kt = r >> 4, ntl = r & 15;
            conv_tile(sT, p.in[I_WOUT] + (size_t)i * 1048576, 1024, kt * 64, ntl * 64, (u16*)(ws + WS_WOUT) + (size_t)i * 1048576, 1024, ntl * 64);
        } else if (t < 2176) {
            const int q = t - 2048, mtx = q >> 4, r = q & 15, kt = r >> 2, ntl = r & 3;
            conv_tile(sT, p.in[I_WPOOL] + (size_t)mtx * 65536, 256, kt * 64, ntl * 64, (u16*)(ws + WS_WPOOL) + (size_t)mtx * 65536, 256, ntl * 64);
        } else {
            const int q = t - 2176, which = q / 16384, r = q % 16384, mtx = r >> 8, tt = r & 255, kt = tt >> 4, ntl = tt & 15;
            const float* src = p.in[I_WG + which] + (size_t)mtx * 1048576;
            u16* dst = (u16*)(ws + (which == 0 ? WS_WG : (which == 1 ? WS_WU : WS_WD))) + (size_t)mtx * 1048576;
            conv_tile(sT, src, 1024, kt * 64, ntl * 64, dst, 1024, ntl * 64);
        }
    }
}

__device__ __forceinline__ int rho_of_k(int k) { return ((k >> 2) & 63) + 64 * ((k & 3) + 4 * (k >> 8)); }
template <int NO>
__device__ __forceinline__ void load_skinny(float* sW, const float* __restrict__ W, int ld, int c0) {
    for (int idx = otid(); idx < 1024 * (NO / 4); idx += NTHR) {
        const int k = idx / (NO / 4), c4 = (idx % (NO / 4)) * 4;
        const float4 v = *reinterpret_cast<const float4*>(W + (size_t)k * ld + c0 + c4);
        *reinterpret_cast<float4*>(sW + rho_of_k(k) * (NO + 4) + c4) = v;
    }
}
template <int NO>
__device__ __forceinline__ void skinny_dot(const float* sW, const float (&xv)[16], float (&o)[NO]) {
    const int lane = otid() & 63;
#pragma unroll
    for (int e = 0; e < NO; ++e) o[e] = 0.f;
#pragma unroll
    for (int i = 0; i < 4; ++i)
#pragma unroll
        for (int jj = 0; jj < 4; ++jj) {
            const float x = xv[i * 4 + jj];
            const float* wrow = sW + (lane + 64 * (jj + 4 * i)) * (NO + 4);
#pragma unroll
            for (int e4 = 0; e4 < NO; e4 += 4) {
                const float4 w = *reinterpret_cast<const float4*>(wrow + e4);
                o[e4] += x * w.x; o[e4 + 1] += x * w.y; o[e4 + 2] += x * w.z; o[e4 + 3] += x * w.w;
            }
            __builtin_amdgcn_sched_barrier(0);
        }
#pragma unroll
    for (int e = 0; e < NO; ++e) o[e] = wave_sum(o[e]);
}
__device__ __forceinline__ void store_row_bf16(u16* __restrict__ dst, const float (&v)[16], int lane) {
#pragma unroll
    for (int i = 0; i < 4; ++i) {
        uint2 o; o.x = pack2(v[i * 4], v[i * 4 + 1]); o.y = pack2(v[i * 4 + 2], v[i * 4 + 3]);
        *reinterpret_cast<uint2*>(dst + i * 256 + lane * 4) = o;
    }
}
__device__ __forceinline__ void store_row_f32(float* __restrict__ dst, const float (&v)[16], int lane) {
#pragma unroll
    for (int i = 0; i < 4; ++i) *reinterpret_cast<float4*>(dst + i * 256 + lane * 4) = make_float4(v[i * 4], v[i * 4 + 1], v[i * 4 + 2], v[i * 4 + 3]);
}
__device__ __forceinline__ void load_row_f32(const float* __restrict__ src, float (&v)[16], int lane) {
#pragma unroll
    for (int i = 0; i < 4; ++i) { const float4 t = *reinterpret_cast<const float4*>(src + i * 256 + lane * 4); v[i * 4] = t.x; v[i * 4 + 1] = t.y; v[i * 4 + 2] = t.z; v[i * 4 + 3] = t.w; }
}
__device__ __forceinline__ void layer_norm_row(float (&v)[16], const float* __restrict__ g, const float* __restrict__ b, int lane) {
    float s = 0.f;
#pragma unroll
    for (int i = 0; i < 16; ++i) s += v[i];
    const float mu = wave_sum(s) * (1.f / 1024.f);
    float q = 0.f;
#pragma unroll
    for (int i = 0; i < 16; ++i) { const float d = v[i] - mu; q += d * d; }
    const float rs = rsqrtf(wave_sum(q) * (1.f / 1024.f) + LN_EPS);
#pragma unroll
    for (int i = 0; i < 4; ++i) {
        const float4 gg = *reinterpret_cast<const float4*>(g + i * 256 + lane * 4);
        const float4 bb = *reinterpret_cast<const float4*>(b + i * 256 + lane * 4);
        v[i * 4] = (v[i * 4] - mu) * rs * gg.x + bb.x; v[i * 4 + 1] = (v[i * 4 + 1] - mu) * rs * gg.y + bb.y;
        v[i * 4 + 2] = (v[i * 4 + 2] - mu) * rs * gg.z + bb.z; v[i * 4 + 3] = (v[i * 4 + 3] - mu) * rs * gg.w + bb.w;
    }
}

__device__ __forceinline__ void phase_rows_prologue(float* sW, const float* __restrict__ x, const float* __restrict__ w_in0, u16* __restrict__ XH, float* __restrict__ LR) {
    load_skinny<32>(sW, w_in0, IN_COLS, 1536);
    __syncthreads();
    const int tid_ = otid(); const int lane = tid_ & 63, wave = tid_ >> 6;
    for (int row = blockIdx.x * 8 + wave; row < TOK; row += gridDim.x * 8) {
        float v[16]; load_row_f32(x + (size_t)row * DM, v, lane);
        store_row_bf16(XH + (size_t)row * DM, v, lane);
        float o[32]; skinny_dot<32>(sW, v, o);
        if (lane < 32) { float r = 0.f;
#pragma unroll
            for (int e = 0; e < 32; ++e) r = (lane == e) ? o[e] : r;
            LR[(size_t)row * 32 + lane] = r; }
    }
}

struct RouteLds { int e0[64], e1[64], lp0[64], lp1[64]; float w0[64], w1[64]; int cnt[16], base[16]; };
__device__ __forceinline__ void phase_rows_ln1(float* sW, LAS RouteLds* rl, const float* __restrict__ Z, const float* __restrict__ g, const float* __restrict__ b,
                               const float* __restrict__ w_router, const float* __restrict__ rbias,
                               float* __restrict__ X1, u16* __restrict__ XH, u32* __restrict__ gcnt, int* __restrict__ slot_tok, int* __restrict__ tinfo) {
    load_skinny<16>(sW, w_router, 16, 0);
    __syncthreads();
    const int tid = otid(); const int lane = tid & 63, wave = tid >> 6;
    for (int blk = blockIdx.x; blk < TOK / 64; blk += gridDim.x) {
        if (tid < 16) rl->cnt[tid] = 0;
        __syncthreads();
        for (int rr = 0; rr < 8; ++rr) {
            const int lr = wave * 8 + rr, row = blk * 64 + lr;
            float v[16]; load_row_f32(Z + (size_t)row * DM, v, lane);
            layer_norm_row(v, g, b, lane);
            store_row_f32(X1 + (size_t)row * DM, v, lane);
            store_row_bf16(XH + (size_t)row * DM, v, lane);
            float o[16]; skinny_dot<16>(sW, v, o);
            float aff[16], sel[16];
#pragma unroll
            for (int e = 0; e < 16; ++e) { aff[e] = 1.f / (1.f + expf(-o[e])); sel[e] = aff[e] + rbias[e]; }
            int bestg = 0; float bests = -1e30f;
#pragma unroll
            for (int gi = 0; gi < 4; ++gi) {
                float m1 = -1e30f, m2 = -1e30f;
#pragma unroll
                for (int j = 0; j < 4; ++j) { const float s = sel[gi * 4 + j]; if (s > m1) { m2 = m1; m1 = s; } else if (s > m2) m2 = s; }
                const float gs = m1 + m2;
                if (gs > bests) { bests = gs; bestg = gi; }
            }
            int i0 = 0, i1 = 0; float s0 = -1e30f, s1 = -1e30f, a0 = 0.f, a1 = 0.f;
#pragma unroll
            for (int e = 0; e < 16; ++e) {
                const bool in = (e >> 2) == bestg;
                const float s = sel[e];
                if (in) { if (s > s0) { s1 = s0; i1 = i0; a1 = a0; s0 = s; i0 = e; a0 = aff[e]; } else if (s > s1) { s1 = s; i1 = e; a1 = aff[e]; } }
            }
            if (lane == 0) { const float inv = 1.f / (a0 + a1); rl->e0[lr] = i0; rl->e1[lr] = i1; rl->w0[lr] = a0 * inv; rl->w1[lr] = a1 * inv; }
        }
        __syncthreads();
        if (tid < 64) { rl->lp0[tid] = atomicAdd((int*)&rl->cnt[rl->e0[tid]], 1); rl->lp1[tid] = atomicAdd((int*)&rl->cnt[rl->e1[tid]], 1); }
        __syncthreads();
        if (tid < 16) rl->base[tid] = (int)atomicAdd(gcnt + tid, (u32)rl->cnt[tid]);
        __syncthreads();
        if (tid < 64) {
            const int row = blk * 64 + tid;
            const int e0 = rl->e0[tid], e1 = rl->e1[tid];
            const int p0 = rl->base[e0] + rl->lp0[tid], p1 = rl->base[e1] + rl->lp1[tid];
            slot_tok[e0 * 16384 + p0] = row; slot_tok[e1 * 16384 + p1] = row;
            int4 a; a.x = e0; a.y = p0; a.z = e1; a.w = p1;
            *reinterpret_cast<int4*>(tinfo + (size_t)row * 8) = a;
            float2 w; w.x = rl->w0[tid]; w.y = rl->w1[tid];
            *reinterpret_cast<float2*>(tinfo + (size_t)row * 8 + 4) = w;
        }
        __syncthreads();
    }
}

__device__ __forceinline__ void phase_rows_ln2(float* sW, LAS MoeMap* mp, const u32* __restrict__ gcnt, const float* __restrict__ X1, const u16* __restrict__ Y, const int* __restrict__ tinfo,
                               const float* __restrict__ g, const float* __restrict__ b, float* __restrict__ X2, u16* __restrict__ XH,
                               const float* __restrict__ w_in_next, float* __restrict__ LR) {
    moe_build_map(mp, gcnt);
    if (w_in_next) { load_skinny<32>(sW, w_in_next, IN_COLS, 1536); __syncthreads(); }
    const int tid_ = otid(); const int lane = tid_ & 63, wave = tid_ >> 6;
    for (int row = blockIdx.x * 8 + wave; row < TOK; row += gridDim.x * 8) {
        const int4 a = *reinterpret_cast<const int4*>(tinfo + (size_t)row * 8);
        const float2 w = *reinterpret_cast<const float2*>(tinfo + (size_t)row * 8 + 4);
        const size_t r0 = (size_t)(mp->toff[a.x] * 256 + a.y), r1 = (size_t)(mp->toff[a.z] * 256 + a.w);
        float v[16]; load_row_f32(X1 + (size_t)row * DM, v, lane);
#pragma unroll
        for (int i = 0; i < 4; ++i) {
            const uint2 y0 = *reinterpret_cast<const uint2*>(Y + r0 * 1024 + i * 256 + lane * 4);
            const uint2 y1 = *reinterpret_cast<const uint2*>(Y + r1 * 1024 + i * 256 + lane * 4);
            v[i * 4 + 0] = ALPHA * v[i * 4 + 0] + w.x * bf2f((u16)(y0.x & 0xffff)) + w.y * bf2f((u16)(y1.x & 0xffff));
            v[i * 4 + 1] = ALPHA * v[i * 4 + 1] + w.x * bf2f((u16)(y0.x >> 16)) + w.y * bf2f((u16)(y1.x >> 16));
            v[i * 4 + 2] = ALPHA * v[i * 4 + 2] + w.x * bf2f((u16)(y0.y & 0xffff)) + w.y * bf2f((u16)(y1.y & 0xffff));
            v[i * 4 + 3] = ALPHA * v[i * 4 + 3] + w.x * bf2f((u16)(y0.y >> 16)) + w.y * bf2f((u16)(y1.y >> 16));
        }
        layer_norm_row(v, g, b, lane);
        store_row_f32(X2 + (size_t)row * DM, v, lane);
        store_row_bf16(XH + (size_t)row * DM, v, lane);
        if (w_in_next) {
            float o[32]; skinny_dot<32>(sW, v, o);
            if (lane < 32) { float r = 0.f;
#pragma unroll
                for (int e = 0; e < 32; ++e) r = (lane == e) ? o[e] : r;
                LR[(size_t)row * 32 + lane] = r; }
        }
    }
}

__device__ __forceinline__ void phase_rows_pool(const float* __restrict__ X, u16* __restrict__ MIX) {
    const int tid_ = otid(); const int lane = tid_ & 63, wave = tid_ >> 6;
    for (int row = blockIdx.x * 8 + wave; row < TOK; row += gridDim.x * 8) {
        const int pos = row & (SEQ - 1), rb = row - pos;
        float v[16];
#pragma unroll
        for (int i = 0; i < 4; ++i) {
            const int half = 1 << i;
            const int lo = max(pos - half, 0), hi = min(pos + half, SEQ);
            float4 s = make_float4(0.f, 0.f, 0.f, 0.f);
            for (int t = lo; t < hi; ++t) { const float4 q = *reinterpret_cast<const float4*>(X + (size_t)(rb + t) * DM + i * 256 + lane * 4); s.x += q.x; s.y += q.y; s.z += q.z; s.w += q.w; }
            const float4 c = *reinterpret_cast<const float4*>(X + (size_t)row * DM + i * 256 + lane * 4);
            const float inv = 1.f / (float)(hi - lo);
            v[i * 4] = s.x * inv - c.x; v[i * 4 + 1] = s.y * inv - c.y; v[i * 4 + 2] = s.z * inv - c.z; v[i * 4 + 3] = s.w * inv - c.w;
        }
        store_row_bf16(MIX + (size_t)row * DM, v, lane);
    }
}

__device__ __forceinline__ float log_sigmoid_(float x) { return fminf(x, 0.f) - log1pf(expf(-fabsf(x))); }
__device__ __forceinline__ void gla_gates(float* sb  , float* slr  , float* swg  ,
                          const float* __restrict__ LR, const float* __restrict__ wgg, const float* __restrict__ bgg, int t0, int hd) {
    const int tid = otid();
    for (int i = tid; i < 64 * 32; i += NTHR) slr[i] = LR[(size_t)t0 * 32 + i];
    for (int i = tid; i < 2 * 16 * 64; i += NTHR) { const int d = i >> 10, r = (i >> 6) & 15, kk = i & 63; swg[i] = wgg[(d * 16 + r) * 256 + hd * 64 + kk]; }
    if (tid < 128) swg[2048 + tid] = bgg[(tid >> 6) * 256 + hd * 64 + (tid & 63)];
    __syncthreads();
    for (int i = tid; i < 2 * 64 * 64; i += NTHR) {
        const int d = i >> 12, j = (i >> 6) & 63, kk = i & 63;
        float a = swg[2048 + d * 64 + kk];
#pragma unroll
        for (int r = 0; r < 16; ++r) a += slr[j * 32 + d * 16 + r] * swg[(d * 16 + r) * 64 + kk];
        sb[i] = log_sigmoid_(a) * (1.f / 16.f);
    }
    __syncthreads();
    if (tid < 128) {
        const int d = tid >> 6, kk = tid & 63;
        float run = 0.f;
        if (d == 0) { for (int j = 0; j < 64; ++j) { run += sb[j * 64 + kk]; sb[j * 64 + kk] = run; } }
        else { for (int j = 63; j >= 0; --j) { run += sb[4096 + j * 64 + kk]; sb[4096 + j * 64 + kk] = run; } }
    }
    __syncthreads();
}

__device__ __forceinline__ void phase_gla_g1(float* lds, const u16* __restrict__ Hb, const float* __restrict__ LR, const float* __restrict__ wgg, const float* __restrict__ bgg,
                             float* __restrict__ ST, float* __restrict__ DEC, int item_lo_stride_dummy) {
    float* sb = lds;
    float* slr = sb + 8192;
    float* swg = slr + 2048;
    float* sv = swg + 2304;
    float* skh = sv + 8192;
    const int tid = otid();
    for (int item = blockIdx.x; item < 1024; item += gridDim.x) {
        const int c = item & 31, hd = (item >> 5) & 3, b = item >> 7;
        const int t0 = b * SEQ + c * 64;
        gla_gates(sb, slr, swg, LR, wgg, bgg, t0, hd);
        for (int i = tid; i < 64 * 128; i += NTHR) { const int j = i >> 7, vv = i & 127; sv[i] = bf2f(Hb[(size_t)(t0 + j) * HC + 512 + hd * 128 + vv]); }
        for (int i = tid; i < 2 * 64 * 64; i += NTHR) {
            const int d = i >> 12, j = (i >> 6) & 63, kk = i & 63;
            const float kval = bf2f(Hb[(size_t)(t0 + j) * HC + 256 + hd * 64 + kk]);
            const float bend = d == 0 ? sb[63 * 64 + kk] : sb[4096 + kk];
            skh[i] = kval * expf(bend - sb[i]);
        }
        if (tid < 128) { const int d = tid >> 6, kk = tid & 63; DEC[((size_t)item * 2 + d) * 64 + kk] = expf(d == 0 ? sb[63 * 64 + kk] : sb[4096 + kk]); }
        __syncthreads();
        {
            const int d = tid >> 8, kb = (tid >> 4) & 15, vb = tid & 15;
            float acc[4][8];
#pragma unroll
            for (int a = 0; a < 4; ++a)
#pragma unroll
                for (int q = 0; q < 8; ++q) acc[a][q] = 0.f;
            for (int j = 0; j < 64; ++j) {
                const float4 kq = *reinterpret_cast<const float4*>(skh + d * 4096 + j * 64 + kb * 4);
                const float4 v0 = *reinterpret_cast<const float4*>(sv + j * 128 + vb * 8);
                const float4 v1 = *reinterpret_cast<const float4*>(sv + j * 128 + vb * 8 + 4);
                const float kk4[4] = {kq.x, kq.y, kq.z, kq.w};
                const float vv8[8] = {v0.x, v0.y, v0.z, v0.w, v1.x, v1.y, v1.z, v1.w};
#pragma unroll
                for (int a = 0; a < 4; ++a)
#pragma unroll
                    for (int q = 0; q < 8; ++q) acc[a][q] += kk4[a] * vv8[q];
            }
            float* dst = ST + ((size_t)item * 2 + d) * 8192;
#pragma unroll
            for (int a = 0; a < 4; ++a) {
                *reinterpret_cast<float4*>(dst + (kb * 4 + a) * 128 + vb * 8) = make_float4(acc[a][0], acc[a][1], acc[a][2], acc[a][3]);
                *reinterpret_cast<float4*>(dst + (kb * 4 + a) * 128 + vb * 8 + 4) = make_float4(acc[a][4], acc[a][5], acc[a][6], acc[a][7]);
            }
        }
        __syncthreads();
    }
}

__device__ __forceinline__ void phase_gla_g2(float* __restrict__ ST, const float* __restrict__ DEC) {
    const int nwork = 64 * 2048;
    for (int w = blockIdx.x * NTHR + otid(); w < nwork; w += gridDim.x * NTHR) {
        const int e4 = w & 2047, bhd = w >> 11, d = bhd & 1, bh = bhd >> 1;
        const int kk = e4 >> 5;
        float4 st = make_float4(0.f, 0.f, 0.f, 0.f);
        for (int s = 0; s < 32; ++s) {
            const int c = d == 0 ? s : 31 - s;
            const size_t item = (size_t)bh * 32 + c;
            float4* pp = reinterpret_cast<float4*>(ST + (item * 2 + d) * 8192) + e4;
            const float4 ds = *pp;
            const float dec = DEC[(item * 2 + d) * 64 + kk];
            *pp = st;
            st.x = dec * st.x + ds.x; st.y = dec * st.y + ds.y; st.z = dec * st.z + ds.z; st.w = dec * st.w + ds.w;
        }
    }
}

__device__ __forceinline__ void phase_gla_g3(float* lds, const u16* __restrict__ Hb, const float* __restrict__ LR, const float* __restrict__ wgg, const float* __restrict__ bgg,
                             const float* __restrict__ ST, const float* __restrict__ gnorm, u16* __restrict__ MIX) {
    float* sb = lds;
    float* slr = sb + 8192;
    float* swg = slr + 2048;
    float* sqt = slr;
    float* sq = swg + 2304;
    float* sk = sq + 4096;
    float* sv = sk + 4096;
    float* skt = sv + 8192;
    float* ssc = skt + 4352;
    const int tid = otid();
    for (int item = blockIdx.x; item < 1024; item += gridDim.x) {
        const int c = item & 31, hd = (item >> 5) & 3, b = item >> 7;
        const int t0 = b * SEQ + c * 64;
        gla_gates(sb, slr, swg, LR, wgg, bgg, t0, hd);
        for (int i = tid; i < 64 * 64; i += NTHR) { const int j = i >> 6, kk = i & 63;
            sq[i] = bf2f(Hb[(size_t)(t0 + j) * HC + hd * 64 + kk]) * 0.125f;
            sk[i] = bf2f(Hb[(size_t)(t0 + j) * HC + 256 + hd * 64 + kk]); }
        for (int i = tid; i < 64 * 128; i += NTHR) { const int j = i >> 7, vv = i & 127; sv[i] = bf2f(Hb[(size_t)(t0 + j) * HC + 512 + hd * 128 + vv]); }
        __syncthreads();
        const int ib = tid >> 5, vb = tid & 31;
        float o[4][4];
#pragma unroll
        for (int a = 0; a < 4; ++a)
#pragma unroll
            for (int q = 0; q < 4; ++q) o[a][q] = 0.f;
        for (int d = 0; d < 2; ++d) {
            const float* bd = sb + d * 4096;
            const int mid = d == 0 ? 31 : 32;
            for (int i = tid; i < 64 * 64; i += NTHR) { const int j = i >> 6, kk = i & 63;
                const float bm = bd[mid * 64 + kk], bj = bd[i];
                sqt[j * 68 + kk] = sq[i] * expf(bj - bm);
                skt[j * 68 + kk] = sk[i] * expf(bm - bj); }
            __syncthreads();
            {
                const int jb = tid & 31;
                float sc[4][2];
#pragma unroll
                for (int a = 0; a < 4; ++a) { sc[a][0] = 0.f; sc[a][1] = 0.f; }
#pragma unroll 1
                for (int k4 = 0; k4 < 64; k4 += 4) {
                    float4 qv[4], kv[2];
#pragma unroll
                    for (int a = 0; a < 4; ++a) qv[a] = *reinterpret_cast<const float4*>(sqt + (ib * 4 + a) * 68 + k4);
#pragma unroll
                    for (int q = 0; q < 2; ++q) kv[q] = *reinterpret_cast<const float4*>(skt + (jb * 2 + q) * 68 + k4);
#pragma unroll
                    for (int a = 0; a < 4; ++a)
#pragma unroll
                        for (int q = 0; q < 2; ++q) sc[a][q] += qv[a].x * kv[q].x + qv[a].y * kv[q].y + qv[a].z * kv[q].z + qv[a].w * kv[q].w;
                }
#pragma unroll
                for (int a = 0; a < 4; ++a)
#pragma unroll
                    for (int q = 0; q < 2; ++q) {
                        const int i = ib * 4 + a, j = jb * 2 + q;
                        const bool keep = d == 0 ? (j <= i) : (j > i);
                        ssc[i * 68 + j] = keep ? sc[a][q] : 0.f;
                    }
            }
            __syncthreads();
#pragma unroll 1
            for (int j4 = 0; j4 < 64; j4 += 4) {
                float4 sv4[4], vv4[4];
#pragma unroll
                for (int a = 0; a < 4; ++a) sv4[a] = *reinterpret_cast<const float4*>(ssc + (ib * 4 + a) * 68 + j4);
#pragma unroll
                for (int q = 0; q < 4; ++q) vv4[q] = *reinterpret_cast<const float4*>(sv + (j4 + q) * 128 + vb * 4);
#pragma unroll
                for (int a = 0; a < 4; ++a) {
                    o[a][0] += sv4[a].x * vv4[0].x + sv4[a].y * vv4[1].x + sv4[a].z * vv4[2].x + sv4[a].w * vv4[3].x;
                    o[a][1] += sv4[a].x * vv4[0].y + sv4[a].y * vv4[1].y + sv4[a].z * vv4[2].y + sv4[a].w * vv4[3].y;
                    o[a][2] += sv4[a].x * vv4[0].z + sv4[a].y * vv4[1].z + sv4[a].z * vv4[2].z + sv4[a].w * vv4[3].z;
                    o[a][3] += sv4[a].x * vv4[0].w + sv4[a].y * vv4[1].w + sv4[a].z * vv4[2].w + sv4[a].w * vv4[3].w;
                }
            }
            __syncthreads();
            float* sps = skt;
            for (int i = tid; i < 64 * 64; i += NTHR) { const int j = i >> 6, kk = i & 63; sqt[j * 68 + kk] = sq[i] * expf(bd[i]); }
            { const float4* src = reinterpret_cast<const float4*>(ST + ((size_t)item * 2 + d) * 8192);
              for (int i = tid; i < 2048; i += NTHR) reinterpret_cast<float4*>(sps)[i] = src[i]; }
            __syncthreads();
#pragma unroll 1
            for (int k4 = 0; k4 < 64; k4 += 4) {
                float4 qv[4], pv[4];
#pragma unroll
                for (int a = 0; a < 4; ++a) qv[a] = *reinterpret_cast<const float4*>(sqt + (ib * 4 + a) * 68 + k4);
#pragma unroll
                for (int q = 0; q < 4; ++q) pv[q] = *reinterpret_cast<const float4*>(sps + (k4 + q) * 128 + vb * 4);
#pragma unroll
                for (int a = 0; a < 4; ++a) {
                    o[a][0] += qv[a].x * pv[0].x + qv[a].y * pv[1].x + qv[a].z * pv[2].x + qv[a].w * pv[3].x;
                    o[a][1] += qv[a].x * pv[0].y + qv[a].y * pv[1].y + qv[a].z * pv[2].y + qv[a].w * pv[3].y;
                    o[a][2] += qv[a].x * pv[0].z + qv[a].y * pv[1].z + qv[a].z * pv[2].z + qv[a].w * pv[3].z;
                    o[a][3] += qv[a].x * pv[0].w + qv[a].y * pv[1].w + qv[a].z * pv[2].w + qv[a].w * pv[3].w;
                }
            }
            __syncthreads();
        }
        const float4 gn = *reinterpret_cast<const float4*>(gnorm + vb * 4);
#pragma unroll
        for (int a = 0; a < 4; ++a) {
            float ss = o[a][0] * o[a][0] + o[a][1] * o[a][1] + o[a][2] * o[a][2] + o[a][3] * o[a][3];
#pragma unroll
            for (int off = 16; off > 0; off >>= 1) ss += __shfl_xor(ss, off);
            const float rs = rsqrtf(ss * (1.f / 128.f) + RMS_EPS);
            const int t = t0 + ib * 4 + a;
            const uint2 gg = *reinterpret_cast<const uint2*>(Hb + (size_t)t * HC + 1024 + hd * 128 + vb * 4);
            const float g0 = bf2f((u16)(gg.x & 0xffff)), g1 = bf2f((u16)(gg.x >> 16)), g2 = bf2f((u16)(gg.y & 0xffff)), g3 = bf2f((u16)(gg.y >> 16));
            const float r0 = o[a][0] * rs * gn.x * (g0 * sigmoidf_(g0));
            const float r1 = o[a][1] * rs * gn.y * (g1 * sigmoidf_(g1));
            const float r2 = o[a][2] * rs * gn.z * (g2 * sigmoidf_(g2));
            const float r3 = o[a][3] * rs * gn.w * (g3 * sigmoidf_(g3));
            uint2 ov; ov.x = pack2(r0, r1); ov.y = pack2(r2, r3);
            *reinterpret_cast<uint2*>(MIX + (size_t)t * DM + hd * 128 + vb * 4) = ov;
        }
        __syncthreads();
    }
}

constexpr int KROW = 136, VROW = 72;
constexpr int ATT_KBYTES = 64 * KROW * 2, ATT_VBYTES = 128 * VROW * 2;
constexpr int ATT_BUF = ATT_KBYTES + ATT_VBYTES;
constexpr int ATT_TBL = 2 * ATT_BUF;
constexpr int ATT_MISC = ATT_TBL + 4096 * 4;
__device__ __forceinline__ int t5_bucket(int rel) {
    const int n = rel < 0 ? -rel : rel;
    int v;
    if (n < 8) v = n;
    else v = 8 + (n >= 12) + (n >= 16) + (n >= 23) + (n >= 32) + (n >= 46) + (n >= 64) + (n >= 91);
    return v + (rel > 0 ? 16 : 0);
}
__device__ __forceinline__ void phase_attn(char* lds, const u16* __restrict__ Hb, const u16* __restrict__ Vt, const float* __restrict__ relb, const float* __restrict__ dlam,
                           const float* __restrict__ dnorm, float lam_init, u16* __restrict__ MIX) {
    const int tid = otid(), lane = tid & 63, wave = tid >> 6, map = wave >> 2, qsub = wave & 3, lq = lane & 31, hh = lane >> 5;
    float* tbl = reinterpret_cast<float*>(lds + ATT_TBL);
    float* misc = reinterpret_cast<float*>(lds + ATT_MISC);
    const float LOG2E = 1.4426950408889634f;
    if (wave == 0) {
        float a = dlam[lane] * dlam[64 + lane], bq = dlam[128 + lane] * dlam[192 + lane];
        a = wave_sum(a); bq = wave_sum(bq);
        if (lane == 0) misc[0] = expf(a) - expf(bq) + lam_init;
    }
    __syncthreads();
    const float lam_full = misc[0];
    const int pi_lq = (lq & 0x13) | ((lq & 4) << 1) | ((lq & 8) >> 1);
    for (int item = blockIdx.x; item < 512; item += gridDim.x) {
        const int qb = item & 15, hd = (item >> 4) & 3, b = item >> 6;
        for (int i = tid; i < 4095; i += NTHR) tbl[i] = relb[t5_bucket(i - 2047) * 4 + hd] * LOG2E;
        const float c_lo = relb[15 * 4 + hd] * LOG2E, c_hi = relb[31 * 4 + hd] * LOG2E;
        const int q0 = qb * 128 + qsub * 32;
        const size_t trow = (size_t)b * SEQ;
        bf16x8 qf[4];
#pragma unroll
        for (int ks = 0; ks < 4; ++ks)
            qf[ks] = *reinterpret_cast<const bf16x8*>(Hb + (trow + q0 + lq) * HC + 1536 + hd * 128 + map * 64 + ks * 16 + hh * 8);
        f32x16 oacc[4];
#pragma unroll
        for (int db = 0; db < 4; ++db)
#pragma unroll
            for (int i = 0; i < 16; ++i) oacc[db][i] = 0.f;
        float m_run = -1e30f, l_run = 0.f;
        const u16* kbase = Hb + trow * HC + 2048 + hd * 128;
        const u16* vbase = Vt + ((size_t)(b * 4 + hd) * 128) * SEQ;
        uint4 kreg[2], vreg[2];
#define ATT_LOAD(k0) do { \
            for (int i_ = 0; i_ < 2; ++i_) { const int p_ = tid + i_ * 512; \
                kreg[i_] = *reinterpret_cast<const uint4*>(kbase + (size_t)((k0) + (p_ >> 4)) * HC + (p_ & 15) * 8); \
                vreg[i_] = *reinterpret_cast<const uint4*>(vbase + (size_t)(p_ >> 3) * SEQ + (k0) + (p_ & 7) * 8); } } while (0)
#define ATT_WRITE(buf) do { char* kb_ = lds + (buf) * ATT_BUF; char* vb_ = kb_ + ATT_KBYTES; \
            for (int i_ = 0; i_ < 2; ++i_) { const int p_ = tid + i_ * 512; \
                *reinterpret_cast<uint4*>(kb_ + ((p_ >> 4) * KROW + (p_ & 15) * 8) * 2) = kreg[i_]; \
                *reinterpret_cast<uint4*>(vb_ + ((p_ >> 3) * VROW + (p_ & 7) * 8) * 2) = vreg[i_]; } } while (0)
        ATT_LOAD(0);
        ATT_WRITE(0);
        __syncthreads();
        for (int kt = 0; kt < 32; ++kt) {
            const int k0 = kt * 64;
            if (kt + 1 < 32) ATT_LOAD(k0 + 64);
            const char* kb = lds + (kt & 1) * ATT_BUF;
            const char* vb = kb + ATT_KBYTES;
            f32x16 sacc[2];
#pragma unroll
            for (int st = 0; st < 2; ++st) {
#pragma unroll
                for (int i = 0; i < 16; ++i) sacc[st][i] = 0.f;
#pragma unroll
                for (int ks = 0; ks < 4; ++ks) {
                    const bf16x8 kf = *reinterpret_cast<const bf16x8*>(kb + ((st * 32 + pi_lq) * KROW + map * 64 + ks * 16 + hh * 8) * 2);
                    sacc[st] = __builtin_amdgcn_mfma_f32_32x32x16_bf16(kf, qf[ks], sacc[st], 0, 0, 0);
                }
            }
            const float c1 = 0.125f * LOG2E;
            float mx = -1e30f;
            const bool far_hi = (k0 - (q0 + 31)) >= 128, far_lo = (q0 - (k0 + 63)) >= 128;
            if (far_hi || far_lo) {
                const float cb = far_hi ? c_hi : c_lo;
#pragma unroll
                for (int st = 0; st < 2; ++st)
#pragma unroll
                    for (int i = 0; i < 16; ++i) { const float s = sacc[st][i] * c1 + cb; sacc[st][i] = s; mx = fmaxf(mx, s); }
            } else {
                const int rbase = k0 - (q0 + lq) + 2047 + 8 * hh;
#pragma unroll
                for (int st = 0; st < 2; ++st)
#pragma unroll
                    for (int i = 0; i < 16; ++i) {
                        const int koff = st * 32 + (i & 3) + 4 * ((i >> 2) & 1) + 16 * (i >> 3);
                        const float s = sacc[st][i] * c1 + tbl[rbase + koff];
                        sacc[st][i] = s; mx = fmaxf(mx, s);
                    }
            }
            mx = fmaxf(mx, __shfl_xor(mx, 32));
            const float m_new = fmaxf(m_run, mx);
            const float alpha = exp2f(m_run - m_new);
            m_run = m_new;
            float psum = 0.f;
            bf16x8 pf[4];
#pragma unroll
            for (int st = 0; st < 2; ++st)
#pragma unroll
                for (int s2 = 0; s2 < 2; ++s2) {
                    float pv[8];
#pragma unroll
                    for (int j = 0; j < 8; ++j) { pv[j] = exp2f(sacc[st][s2 * 8 + j] - m_new); psum += pv[j]; }
                    union { bf16x8 v; u32 w[4]; } cv;
                    cv.w[0] = pack2(pv[0], pv[1]); cv.w[1] = pack2(pv[2], pv[3]); cv.w[2] = pack2(pv[4], pv[5]); cv.w[3] = pack2(pv[6], pv[7]);
                    pf[st * 2 + s2] = cv.v;
                }
            l_run = l_run * alpha + psum;
#pragma unroll
            for (int db = 0; db < 4; ++db)
#pragma unroll
                for (int i = 0; i < 16; ++i) oacc[db][i] *= alpha;
#pragma unroll
            for (int db = 0; db < 4; ++db)
#pragma unroll
                for (int st = 0; st < 2; ++st)
#pragma unroll
                    for (int s2 = 0; s2 < 2; ++s2) {
                        const bf16x8 vf = *reinterpret_cast<const bf16x8*>(vb + ((db * 32 + lq) * VROW + st * 32 + s2 * 16 + hh * 8) * 2);
                        oacc[db] = __builtin_amdgcn_mfma_f32_32x32x16_bf16(vf, pf[st * 2 + s2], oacc[db], 0, 0, 0);
                    }
            if (kt + 1 < 32) ATT_WRITE((kt + 1) & 1);
            __syncthreads();
        }
        const float l_tot = l_run + __shfl_xor(l_run, 32);
        float* xch = reinterpret_cast<float*>(lds);
        const int qrow = qsub * 32 + lq;
        if (map == 1) {
            const float sc = lam_full / l_tot;
#pragma unroll
            for (int db = 0; db < 4; ++db)
#pragma unroll
                for (int g4 = 0; g4 < 4; ++g4) {
                    const int dv = db * 32 + g4 * 8 + hh * 4;
                    *reinterpret_cast<float4*>(xch + qrow * 132 + dv) = make_float4(oacc[db][g4 * 4] * sc, oacc[db][g4 * 4 + 1] * sc, oacc[db][g4 * 4 + 2] * sc, oacc[db][g4 * 4 + 3] * sc);
                }
        }
        __syncthreads();
        if (map == 0) {
            const float inv = 1.f / l_tot;
            float ss = 0.f;
#pragma unroll
            for (int db = 0; db < 4; ++db)
#pragma unroll
                for (int g4 = 0; g4 < 4; ++g4) {
                    const int dv = db * 32 + g4 * 8 + hh * 4;
                    const float4 o1 = *reinterpret_cast<const float4*>(xch + qrow * 132 + dv);
                    float v0 = oacc[db][g4 * 4] * inv - o1.x, v1 = oacc[db][g4 * 4 + 1] * inv - o1.y, v2 = oacc[db][g4 * 4 + 2] * inv - o1.z, v3 = oacc[db][g4 * 4 + 3] * inv - o1.w;
                    oacc[db][g4 * 4] = v0; oacc[db][g4 * 4 + 1] = v1; oacc[db][g4 * 4 + 2] = v2; oacc[db][g4 * 4 + 3] = v3;
                    ss += v0 * v0 + v1 * v1 + v2 * v2 + v3 * v3;
                }
            ss += __shfl_xor(ss, 32);
            const float rs = rsqrtf(ss * (1.f / 128.f) + RMS_EPS) * (1.f - lam_init);
            u16* dst = MIX + (trow + q0 + lq) * DM + 512 + hd * 128;
#pragma unroll
            for (int db = 0; db < 4; ++db)
#pragma unroll
                for (int g4 = 0; g4 < 4; ++g4) {
                    const int dv = db * 32 + g4 * 8 + hh * 4;
                    const float4 nw = *reinterpret_cast<const float4*>(dnorm + dv);
                    uint2 ov; ov.x = pack2(oacc[db][g4 * 4] * rs * nw.x, oacc[db][g4 * 4 + 1] * rs * nw.y);
                    ov.y = pack2(oacc[db][g4 * 4 + 2] * rs * nw.z, oacc[db][g4 * 4 + 3] * rs * nw.w);
                    *reinterpret_cast<uint2*>(dst + dv) = ov;
                }
        }
        __syncthreads();
    }
#undef ATT_LOAD
#undef ATT_WRITE
}

constexpr int NPHASE = 1 + 9 * NLAYER;
__global__ void __launch_bounds__(NTHR, 2) fwd_kernel(Params p) {
    extern __shared__ __attribute__((aligned(16))) unsigned char lds[];
    unsigned char* ws = p.ws;
    const int lo = p.ph_lo, hi = p.ph_hi;
    volatile LAS unsigned* barw = (volatile LAS unsigned*)(lds + LDS_BARW);
    if (threadIdx.x == 0) { barw[0] = 0u; barw[1] = 0u; barw[2] = 0u; barw[3] = 0u; }
    __syncthreads();
    XcdBarrier bar; bar.bar = (unsigned*)(ws + WS_CTL); bar.x = 0; bar.st = barw;
    const bool multi = (hi - lo) > 1;
    if (multi) bar = xcd_barrier_post((unsigned*)(ws + WS_CTL), barw);
#define IN(k) (lo <= (k) && (k) < hi)
#define SEAM(k) do { if (IN(k) && IN((k) + 1)) xcd_barrier(bar); } while (0)

    u16* shm = reinterpret_cast<u16*>(lds);
    float* ldsf = reinterpret_cast<float*>(lds);
    LAS MoeMap* mp = (LAS MoeMap*)(lds + LDS_MOEMAP);
    u16* Wt_in = (u16*)(ws + WS_WIN); u16* Wt_out = (u16*)(ws + WS_WOUT); u16* Wt_pool = (u16*)(ws + WS_WPOOL);
    u16* Wt_g = (u16*)(ws + WS_WG); u16* Wt_u = (u16*)(ws + WS_WU); u16* Wt_d = (u16*)(ws + WS_WD);
    float* XA = (float*)(ws + WS_XA); float* XB = (float*)(ws + WS_XB);
    u16* XH = (u16*)(ws + WS_XH); u16* MIX = (u16*)(ws + WS_MIXIN);
    float* LR = (float*)(ws + WS_LR); u16* Vt = (u16*)(ws + WS_VT);
    u16* Hb = (u16*)(ws + WS_R1); u16* Hmoe = (u16*)(ws + WS_R1);
    float* ST = (float*)(ws + WS_R2); float* Z = (float*)(ws + WS_R2); u16* Y = (u16*)(ws + WS_R2);
    int* slot_tok = (int*)(ws + WS_SLOT); int* tinfo = (int*)(ws + WS_TINFO); float* DEC = (float*)(ws + WS_DEC);
    u32* gcnt_all = (u32*)(ws + WS_CTL + CTL_CNT);

    if (IN(0)) {
        phase_convert(ldsf, p);
        __syncthreads();
        phase_rows_prologue(ldsf, p.in[I_X], p.in[I_WIN], XH, LR);
    }
    SEAM(0);
    for (int L = 0; L < NLAYER; ++L) {
        const int base = 1 + 9 * L;
        const bool even = (L & 1) == 0;
        const int i2 = L >> 1;
        const float* xin = (L == 0) ? p.in[I_X] : XA;
        float* xout = (L == NLAYER - 1) ? p.out : XA;
        u32* gcnt = gcnt_all + L * 16;
        if (even) {
            if (IN(base + 0)) phase_inproj(shm, XH, Wt_in + (size_t)i2 * 3072 * 1024, Hb, Vt);
            SEAM(base + 0);
            if (IN(base + 1)) {
                const float lam_init = 0.8f - 0.6f * expf(-0.3f * (float)L);
                phase_attn((char*)lds, Hb, Vt, p.in[I_RELB], p.in[I_DLAM] + i2 * 256, p.in[I_DNORM] + i2 * 128, lam_init, MIX);
                __syncthreads();
                phase_gla_g1(ldsf, Hb, LR, p.in[I_WGG] + i2 * 2 * 16 * 256, p.in[I_BGG] + i2 * 2 * 256, ST, DEC, 0);
            }
            SEAM(base + 1);
            if (IN(base + 2)) phase_gla_g2(ST, DEC);
            SEAM(base + 2);
            if (IN(base + 3)) phase_gla_g3(ldsf, Hb, LR, p.in[I_WGG] + i2 * 2 * 16 * 256, p.in[I_BGG] + i2 * 2 * 256, ST, p.in[I_GNORM] + i2 * 128, MIX);
            SEAM(base + 3);
            if (IN(base + 4)) phase_mixproj(shm, MIX, Wt_out + (size_t)i2 * 1048576, false, xin, nullptr, Z);
            SEAM(base + 4);
        } else {
            if (IN(base + 0)) phase_rows_pool(xin, MIX);
            if (IN(base + 0) && IN(base + 4)) xcd_barrier(bar);
            if (IN(base + 4)) phase_mixproj(shm, MIX, Wt_pool + (size_t)i2 * 4 * 65536, true, xin, p.in[I_PSCALE] + i2 * 1024, Z);
            SEAM(base + 4);
        }
        if (IN(base + 5)) phase_rows_ln1(ldsf, (LAS RouteLds*)(lds + 98304), Z, p.in[I_LNG] + (L * 2) * 1024, p.in[I_LNB] + (L * 2) * 1024,
                                         p.in[I_WR], p.in[I_RB], XB, XH, gcnt, slot_tok, tinfo);
        SEAM(base + 5);
        if (IN(base + 6)) phase_moe1(shm, mp, gcnt, slot_tok, XH, Wt_g + (size_t)L * 16 * 1048576, Wt_u + (size_t)L * 16 * 1048576, Hmoe);
        SEAM(base + 6);
        if (IN(base + 7)) phase_moe2(shm, mp, gcnt, Hmoe, Wt_d + (size_t)L * 16 * 1048576, Y);
        SEAM(base + 7);
        if (IN(base + 8)) phase_rows_ln2(ldsf, mp, gcnt, XB, Y, tinfo, p.in[I_LNG] + (L * 2 + 1) * 1024, p.in[I_LNB] + (L * 2 + 1) * 1024, xout, XH,
                                         (L + 1 < NLAYER && ((L + 1) & 1) == 0) ? p.in[I_WIN] + (size_t)((L + 1) >> 1) * 1024 * IN_COLS : nullptr, LR);
        SEAM(base + 8);
    }
#undef IN
#undef SEAM
}

extern "C" void kernel_launch(void* const* d_in, const int* in_sizes, int n_in, void* d_out, int out_size, void* d_ws, size_t ws_size, hipStream_t stream) {
    static int grid = 0;
    if (grid == 0) {
        if (n_in != 18 || ws_size < WS_END) { fprintf(stderr, "kernel_launch: unexpected inputs (n_in %d, ws %zu < %zu)\n", n_in, ws_size, (size_t)WS_END); grid = -1; return; }
        int dev = 0, cus = 0, per_cu = 0;
        hipGetDevice(&dev);
        hipDeviceGetAttribute(&cus, hipDeviceAttributeMultiprocessorCount, dev);
        if (hipFuncSetAttribute((const void*)fwd_kernel, hipFuncAttributeMaxDynamicSharedMemorySize, LDS_BYTES) != hipSuccess) { fprintf(stderr, "kernel_launch: hipFuncSetAttribute failed\n"); grid = -1; return; }
        if (hipOccupancyMaxActiveBlocksPerMultiprocessor(&per_cu, (const void*)fwd_kernel, NTHR, LDS_BYTES) != hipSuccess || per_cu < 1) {
            fprintf(stderr, "kernel_launch: occupancy query reports %d blocks per CU\n", per_cu); }
        (void)hipGetLastError();
        grid = cus;
    }
    if (grid < 0) return;
    hipMemsetAsync((char*)d_ws + WS_CTL, 0, CTL_BYTES, stream);
    Params p{};
    for (int i = 0; i < 18; ++i) p.in[i] = (const float*)d_in[i];
    p.out = (float*)d_out; p.ws = (unsigned char*)d_ws;
#if ONE_LAUNCH
    p.ph_lo = 0; p.ph_hi = NPHASE;
    hipLaunchKernelGGL(fwd_kernel, dim3(grid), dim3(NTHR), LDS_BYTES, stream, p);
#else
    for (int k = 0; k < NPHASE; ++k) {
        const int L = (k - 1) / 9, r = (k - 1) % 9;
        if (k > 0 && (L & 1) == 1 && (r == 1 || r == 2 || r == 3)) continue;
        p.ph_lo = k; p.ph_hi = k + 1;
        hipLaunchKernelGGL(fwd_kernel, dim3(grid), dim3(NTHR), LDS_BYTES, stream, p);
    }
#endif
}
```

```cpp
#include <hip/hip_runtime.h>
#include <stdint.h>
#include <stdio.h>

typedef unsigned short u16;
typedef unsigned int u32;
typedef __attribute__((ext_vector_type(8))) short bf16x8;
typedef __attribute__((ext_vector_type(4))) float f32x4;
typedef __attribute__((ext_vector_type(16))) float f32x16;
#define LAS __attribute__((address_space(3)))

#ifndef ONE_LAUNCH
#define ONE_LAUNCH 1
#endif

constexpr int TOK = 16384, DM = 1024, SEQ = 2048, NBATCH = 8, NLAYER = 4;
constexpr int HC = 2560;
constexpr int NEXP = 16;
constexpr int IN_COLS = 3104;
constexpr float ALPHA = 1.681792830507429f;
constexpr float LN_EPS = 1e-5f, RMS_EPS = 1e-6f;
constexpr int NTHR = 512;
constexpr int LDS_BYTES = 163840 - 256;
constexpr int LDS_BARW = LDS_BYTES - 16;
constexpr int LDS_MOEMAP = LDS_BARW - 256;

constexpr size_t WS_CTL   = 0;
constexpr size_t CTL_BYTES = 65536;
constexpr size_t CTL_CNT  = 16384;
constexpr size_t WS_WIN   = WS_CTL + CTL_BYTES;
constexpr size_t WS_WOUT  = WS_WIN + (size_t)2 * 3072 * 1024 * 2;
constexpr size_t WS_WPOOL = WS_WOUT + (size_t)2 * 1024 * 1024 * 2;
constexpr size_t WS_WG    = WS_WPOOL + (size_t)2 * 4 * 256 * 256 * 2;
constexpr size_t WS_WU    = WS_WG + (size_t)64 * 1048576 * 2;
constexpr size_t WS_WD    = WS_WU + (size_t)64 * 1048576 * 2;
constexpr size_t WS_XA    = WS_WD + (size_t)64 * 1048576 * 2;
constexpr size_t WS_XB    = WS_XA + (size_t)TOK * DM * 4;
constexpr size_t WS_XH    = WS_XB + (size_t)TOK * DM * 4;
constexpr size_t WS_MIXIN = WS_XH + (size_t)TOK * DM * 2;
constexpr size_t WS_LR    = WS_MIXIN + (size_t)TOK * DM * 2;
constexpr size_t WS_VT    = WS_LR + (size_t)TOK * 32 * 4;
constexpr size_t WS_R1    = WS_VT + (size_t)TOK * 512 * 2;
constexpr size_t R1_BYTES = (size_t)TOK * HC * 2;
constexpr size_t WS_R2    = WS_R1 + R1_BYTES;
constexpr size_t R2_BYTES = (size_t)36864 * 1024 * 2 > (size_t)TOK * DM * 4 ? (size_t)36864 * 1024 * 2 : (size_t)TOK * DM * 4;
constexpr size_t WS_SLOT  = WS_R2 + R2_BYTES;
constexpr size_t WS_TINFO = WS_SLOT + (size_t)16 * 16384 * 4;
constexpr size_t WS_DEC   = WS_TINFO + (size_t)TOK * 32;
constexpr size_t WS_END   = WS_DEC + (size_t)1024 * 2 * 64 * 4;

__device__ __forceinline__ u16 f2bf(float f) { u32 u = __float_as_uint(f); u += 0x7fffu + ((u >> 16) & 1u); return (u16)(u >> 16); }
__device__ __forceinline__ float bf2f(u16 h) { return __uint_as_float(((u32)h) << 16); }
__device__ __forceinline__ u32 pack2(float a, float b) { return (u32)f2bf(a) | ((u32)f2bf(b) << 16); }
__device__ __forceinline__ float wave_sum(float v) {
#pragma unroll
    for (int o = 32; o > 0; o >>= 1) v += __shfl_xor(v, o);
    return v;
}
__device__ __forceinline__ int otid() { int t = threadIdx.x; asm volatile("" : "+v"(t)); return t; }
__device__ __forceinline__ float sigmoidf_(float x) { return 1.f / (1.f + __expf(-x)); }

#define XB_TMO      128
#define XB_XCNT(j)  (256  + 64 * (j))
#define XB_XSUB(j)  (1280 + 64 * (j))
#define XB_XGEN(j)  (2304 + 64 * (j))
#define XB_TOP      3328
#define XB_TOPGEN   3392
#define XCD_BAR_WORDS 3456
#define XB_SPIN_CAP (1u << 20)
__device__ __forceinline__ unsigned xb_ld(unsigned* p)              { return __hip_atomic_load(p, __ATOMIC_RELAXED, __HIP_MEMORY_SCOPE_AGENT); }
__device__ __forceinline__ unsigned xb_add(unsigned* p, unsigned v) { return __hip_atomic_fetch_add(p, v, __ATOMIC_RELAXED, __HIP_MEMORY_SCOPE_AGENT); }
__device__ __forceinline__ unsigned xb_xcc_id() { return (unsigned)__builtin_amdgcn_s_getreg((3 << 11) | 20) & 0xFu; }
#define XB_SPIN(cond, bar) do { unsigned _sp = 0; while (cond) { __builtin_amdgcn_s_sleep(1); \
    if ((++_sp & 255u) == 0u) { if (xb_ld(&(bar)[XB_TMO])) break; if (_sp > XB_SPIN_CAP) { atomicAdd(&(bar)[XB_TMO], 1u); break; } } } } while (0)
struct XcdBarrier { unsigned* bar; unsigned x; volatile LAS unsigned* st; };
__device__ __forceinline__ XcdBarrier xcd_barrier_post(unsigned* bar, volatile LAS unsigned* st) {
    XcdBarrier b; b.bar = bar; b.x = xb_xcc_id(); b.st = st;
    if (threadIdx.x == 0) (void)xb_add(&bar[XB_XCNT(b.x)], 1u);
    return b;
}
__device__ __forceinline__ void xcd_barrier_complete(unsigned* bar, unsigned x, unsigned& nloc, unsigned& nx) {
    const unsigned G = gridDim.x * gridDim.y * gridDim.z;
    unsigned sum, cnt, mine, sp = 0u;
    for (;;) {
        sum = 0u; cnt = 0u; mine = 0u;
#pragma unroll
        for (unsigned j = 0; j < 16; ++j) { const unsigned c = xb_ld(&bar[XB_XCNT(j)]); sum += c; cnt += (c > 0u) ? 1u : 0u; mine = (j == x) ? c : mine; }
        if (sum == G) break;
        __builtin_amdgcn_s_sleep(1);
        if ((++sp & 255u) == 0u) { if (xb_ld(&bar[XB_TMO])) break; if (sp > XB_SPIN_CAP) { atomicAdd(&bar[XB_TMO], 1u); break; } }
    }
    nloc = mine > 0u ? mine : 1u; nx = cnt > 0u ? cnt : 1u;
}
__device__ __forceinline__ void xcd_barrier(const XcdBarrier& b) {
    asm volatile("s_waitcnt vmcnt(0)" ::: "memory");
    __syncthreads();
    if (threadIdx.x == 0) {
        unsigned* bar = b.bar;
        __builtin_amdgcn_s_waitcnt(0);
        unsigned nloc = b.st[0], nx = b.st[1];
        if (nloc == 0u) { xcd_barrier_complete(bar, b.x, nloc, nx); b.st[0] = nloc; b.st[1] = nx; }
        const unsigned old = xb_add(&bar[XB_XSUB(b.x)], 1u);
        const unsigned gen = old / nloc;
        if (old + 1u == (gen + 1u) * nloc) {
            __builtin_amdgcn_fence(__ATOMIC_RELEASE, "agent");
            asm volatile("s_waitcnt vmcnt(0)" ::: "memory");
            const unsigned og = xb_add(&bar[XB_TOP], 1u);
            const unsigned tg = og / nx;
            if (og + 1u == (tg + 1u) * nx) xb_add(&bar[XB_TOPGEN], 1u);
            else XB_SPIN(xb_ld(&bar[XB_TOPGEN]) == tg, bar);
            __builtin_amdgcn_fence(__ATOMIC_ACQUIRE, "agent");
            xb_add(&bar[XB_XGEN(b.x)], 1u);
            asm volatile("s_waitcnt vmcnt(0)" ::: "memory");
        } else {
            XB_SPIN(xb_ld(&bar[XB_XGEN(b.x)]) == gen, bar);
            __builtin_amdgcn_fence(__ATOMIC_ACQUIRE, "agent");
            asm volatile("s_waitcnt vmcnt(0)" ::: "memory");
        }
    }
    __syncthreads();
}

struct Params {
    const float* in[18];
    float* out;
    unsigned char* ws;
    int ph_lo, ph_hi;
};
enum { I_X = 0, I_RELB, I_WIN, I_WGG, I_BGG, I_GNORM, I_DLAM, I_DNORM, I_WOUT, I_WPOOL, I_PSCALE, I_LNG, I_LNB, I_WR, I_RB, I_WG, I_WU, I_WD };

constexpr int BK = 64, HALF = 128, HT = HALF * BK;
__device__ __forceinline__ int lds_byte(int r, int c) {
    int st = (r >> 4) * 2 + (c >> 5), rr = r & 15, cc = c & 31, ob = rr * 64 + cc * 2;
    return st * 1024 + (ob ^ (((ob >> 9) & 1) << 5));
}
__device__ __forceinline__ void stage_rc(int b, int& R, int& C) {
    int st = b / 1024, sb = b % 1024, swz = sb ^ (((sb >> 9) & 1) << 5);
    R = (st >> 1) * 16 + swz / 64; C = (st & 1) * 32 + (swz % 64) / 2;
}

#define WAIT_V(n) asm volatile("s_waitcnt vmcnt(" #n ")" ::: "memory")
#define WAIT_L(n) asm volatile("s_waitcnt lgkmcnt(" #n ")" ::: "memory")
#define BAR __builtin_amdgcn_s_barrier()
#define SCHED __builtin_amdgcn_sched_barrier(0)

template <bool SWAP, bool GATHER>
__device__ __forceinline__ void gemm_core(u16* shm, const u16* __restrict__ A, const int (&aq)[4], int lda64,
                                          const u16* __restrict__ B0p, const u16* __restrict__ B1p, int bo, int ldb64,
                                          int nt, f32x4 (&acc)[2][2][4][2]) {
#define SA(b, h) (shm + ((b) * 2 + (h)) * HT)
#define SB(b, h) (shm + (4 + (b) * 2 + (h)) * HT)
#define GLDS(src, dst) __builtin_amdgcn_global_load_lds((const unsigned*)(src), (unsigned*)(dst), 16, 0, 0)
#define AOFF(q) (GATHER ? aq[q] : aq[0] + (q) * lda64)
#define GLDS_O(base, off, dst) do { int _o = (off); asm volatile("" : "+v"(_o)); GLDS((base) + _o, dst); } while (0)
#define STAGE_A(P, h, kt) do { const u16* _s = A + (kt) * BK; char* _d = (char*)(P) + tz * 16; \
        GLDS_O(_s, AOFF(2 * (h)), _d); GLDS_O(_s, AOFF(2 * (h) + 1), _d + 8192); } while (0)
#define STAGE_B(P, h, kt) do { const u16* _s = ((h) ? B1p : B0p) + (kt) * BK; char* _d = (char*)(P) + tz * 16; \
        GLDS_O(_s, bo, _d); GLDS_O(_s, bo + ldb64, _d + 8192); } while (0)
#define LDA(dst, b, h) _Pragma("unroll") for (int m = 0; m < 4; ++m) _Pragma("unroll") for (int k = 0; k < 2; ++k) \
        dst[m][k] = *reinterpret_cast<const bf16x8*>((char*)SA(b, h) + lds_byte(wr * 64 + m * 16 + fr, k * 32 + fq * 8))
#define LDB(dst, b, h) _Pragma("unroll") for (int n = 0; n < 2; ++n) _Pragma("unroll") for (int k = 0; k < 2; ++k) \
        dst[n][k] = *reinterpret_cast<const bf16x8*>((char*)SB(b, h) + lds_byte(wc * 32 + n * 16 + fr, k * 32 + fq * 8))
#define MMA(ai, bj, At, Bt) do { __builtin_amdgcn_s_setprio(1); \
        _Pragma("unroll") for (int m = 0; m < 4; ++m) _Pragma("unroll") for (int n = 0; n < 2; ++n) _Pragma("unroll") for (int k = 0; k < 2; ++k) \
            acc[ai][bj][m][n] = SWAP ? __builtin_amdgcn_mfma_f32_16x16x32_bf16(Bt[n][k], At[m][k], acc[ai][bj][m][n], 0, 0, 0) \
                                     : __builtin_amdgcn_mfma_f32_16x16x32_bf16(At[m][k], Bt[n][k], acc[ai][bj][m][n], 0, 0, 0); \
        __builtin_amdgcn_s_setprio(0); } while (0)
    int tz = otid();
    int wid = tz >> 6, lane = tz & 63, wr = wid >> 2, wc = wid & 3, fr = lane & 15, fq = lane >> 4;
    bf16x8 At[4][2], B0[2][2], B1[2][2];
    STAGE_B(SB(0, 0), 0, 0); STAGE_A(SA(0, 0), 0, 0);
    STAGE_B(SB(0, 1), 1, 0); STAGE_A(SA(0, 1), 1, 0);
    if (wr == 1) BAR;
    WAIT_V(4); BAR;
    STAGE_B(SB(1, 0), 0, 1); STAGE_A(SA(1, 0), 0, 1); STAGE_B(SB(1, 1), 1, 1);
    WAIT_V(6); BAR;
    for (int t = 0; t < nt - 2; t += 2) {
        LDB(B0, 0, 0); SCHED; LDA(At, 0, 0); STAGE_A(SA(1, 1), 1, t + 1);
        WAIT_L(8); BAR; WAIT_L(0); MMA(0, 0, At, B0); BAR; SCHED;
        LDB(B1, 0, 1); STAGE_B(SB(0, 0), 0, t + 2);
        BAR; WAIT_L(0); MMA(0, 1, At, B1); BAR;
        LDA(At, 0, 1); STAGE_A(SA(0, 0), 0, t + 2);
        BAR; WAIT_L(0); MMA(1, 0, At, B0); BAR; SCHED;
        STAGE_B(SB(0, 1), 1, t + 2);
        WAIT_V(6); BAR; MMA(1, 1, At, B1); BAR;
        LDB(B0, 1, 0); SCHED; LDA(At, 1, 0); STAGE_A(SA(0, 1), 1, t + 2);
        WAIT_L(8); BAR; WAIT_L(0); MMA(0, 0, At, B0); BAR; SCHED;
        LDB(B1, 1, 1); STAGE_B(SB(1, 0), 0, t + 3);
        BAR; WAIT_L(0); MMA(0, 1, At, B1); BAR;
        LDA(At, 1, 1); STAGE_A(SA(1, 0), 0, t + 3);
        BAR; WAIT_L(0); MMA(1, 0, At, B0); BAR; SCHED;
        STAGE_B(SB(1, 1), 1, t + 3);
        WAIT_V(6); BAR; MMA(1, 1, At, B1); BAR;
    }
    asm volatile("" : "+v"(tz)); wid = tz >> 6; lane = tz & 63; wr = wid >> 2; wc = wid & 3; fr = lane & 15; fq = lane >> 4;
    { LDB(B0, 0, 0); WAIT_V(0); LDA(At, 0, 0); STAGE_A(SA(1, 1), 1, nt - 1);
      BAR; WAIT_L(0); MMA(0, 0, At, B0); BAR;
      LDB(B1, 0, 1); BAR; WAIT_L(0); MMA(0, 1, At, B1); BAR;
      LDA(At, 0, 1); WAIT_V(4); BAR; WAIT_L(0); MMA(1, 0, At, B0); MMA(1, 1, At, B1); BAR; }
    { LDB(B0, 1, 0); LDA(At, 1, 0); WAIT_V(2); BAR; WAIT_L(0); MMA(0, 0, At, B0); BAR;
      LDB(B1, 1, 1); WAIT_V(0); BAR; WAIT_L(0); MMA(0, 1, At, B1); BAR;
      LDA(At, 1, 1); BAR; WAIT_L(0); MMA(1, 0, At, B0); MMA(1, 1, At, B1); BAR; }
    if (wr == 0) BAR;
#undef SA
#undef SB
#undef STAGE_A
#undef GLDS_O
#undef AOFF
#undef STAGE_B
#undef LDA
#undef LDB
#undef MMA
}

__device__ __forceinline__ void stage_geom(int& R0, int& C0) { stage_rc(otid() * 16, R0, C0); }

#define ACC_ZERO(acc) do { _Pragma("unroll") for (int a_ = 0; a_ < 2; ++a_) _Pragma("unroll") for (int b_ = 0; b_ < 2; ++b_) _Pragma("unroll") for (int m_ = 0; m_ < 4; ++m_) _Pragma("unroll") for (int n_ = 0; n_ < 2; ++n_) \
        acc[a_][b_][m_][n_] = f32x4{0.f, 0.f, 0.f, 0.f}; } while (0)

__device__ __forceinline__ void phase_inproj(u16* shm, const u16* __restrict__ XH, const u16* __restrict__ Wt, u16* __restrict__ Hb, u16* __restrict__ Vt) {
    const int nunits = 64 * 12;
    for (int u = blockIdx.x; u < nunits; u += gridDim.x) {
        const int pm = u & 63, pn = u >> 6;
        const int brow = pm * 256, bcol = pn * 256;
        int R0, C0; stage_geom(R0, C0);
        const int aq[4] = {(brow + R0) * DM + C0, 0, 0, 0};
        const u16* B0p = Wt + (size_t)bcol * DM;
        const int bo = R0 * DM + C0;
        f32x4 acc[2][2][4][2]; ACC_ZERO(acc);
        if (pn < 10) {
            gemm_core<true, false>(shm, XH, aq, 64 * DM, B0p, B0p + (size_t)128 * DM, bo, 64 * DM, DM / BK, acc);
            int tz = otid();
            const int wid = tz >> 6, lane = tz & 63, wr = wid >> 2, wc = wid & 3, fr = lane & 15, fq = lane >> 4;
            _Pragma("unroll") for (int ai = 0; ai < 2; ++ai) _Pragma("unroll") for (int bj = 0; bj < 2; ++bj) _Pragma("unroll") for (int m = 0; m < 4; ++m) _Pragma("unroll") for (int n = 0; n < 2; ++n) {
                const int row = brow + ai * 128 + wr * 64 + m * 16 + fr;
                const int col = bcol + bj * 128 + wc * 32 + n * 16 + fq * 4;
                uint2 v; v.x = pack2(acc[ai][bj][m][n][0], acc[ai][bj][m][n][1]); v.y = pack2(acc[ai][bj][m][n][2], acc[ai][bj][m][n][3]);
                *reinterpret_cast<uint2*>(Hb + (size_t)row * HC + col) = v;
            }
        } else {
            gemm_core<false, false>(shm, XH, aq, 64 * DM, B0p, B0p + (size_t)128 * DM, bo, 64 * DM, DM / BK, acc);
            int tz = otid();
            const int wid = tz >> 6, lane = tz & 63, wr = wid >> 2, wc = wid & 3, fr = lane & 15, fq = lane >> 4;
            _Pragma("unroll") for (int ai = 0; ai < 2; ++ai) _Pragma("unroll") for (int bj = 0; bj < 2; ++bj) _Pragma("unroll") for (int m = 0; m < 4; ++m) _Pragma("unroll") for (int n = 0; n < 2; ++n) {
                const int row = brow + ai * 128 + wr * 64 + m * 16 + fq * 4;
                const int col = bcol - 2560 + bj * 128 + wc * 32 + n * 16 + fr;
                const int b = row >> 11, s = row & 2047, hd = col >> 7, dv = col & 127;
                uint2 v; v.x = pack2(acc[ai][bj][m][n][0], acc[ai][bj][m][n][1]); v.y = pack2(acc[ai][bj][m][n][2], acc[ai][bj][m][n][3]);
                *reinterpret_cast<uint2*>(Vt + ((size_t)((b * 4 + hd) * 128 + dv)) * SEQ + s) = v;
            }
        }
    }
}

__device__ __forceinline__ void phase_mixproj(u16* shm, const u16* __restrict__ MIX, const u16* __restrict__ Wt, bool pool,
                              const float* __restrict__ xin, const float* __restrict__ scale, float* __restrict__ Z) {
    const int nunits = 64 * 4;
    for (int u = blockIdx.x; u < nunits; u += gridDim.x) {
        const int pm = u & 63, pn = u >> 6;
        const int brow = pm * 256, bcol = pn * 256;
        int R0, C0; stage_geom(R0, C0);
        const int ldb = pool ? 256 : 1024;
        const int aq[4] = {(brow + R0) * DM + C0 + (pool ? pn * 256 : 0), 0, 0, 0};
        const u16* B0p = pool ? (Wt + (size_t)pn * 65536) : (Wt + (size_t)bcol * DM);
        const int bo = R0 * ldb + C0;
        f32x4 acc[2][2][4][2]; ACC_ZERO(acc);
        gemm_core<true, false>(shm, MIX, aq, 64 * DM, B0p, B0p + (size_t)128 * ldb, bo, 64 * ldb, ldb / BK, acc);
        int tz = otid();
        const int wid = tz >> 6, lane = tz & 63, wr = wid >> 2, wc = wid & 3, fr = lane & 15, fq = lane >> 4;
        _Pragma("unroll") for (int ai = 0; ai < 2; ++ai) _Pragma("unroll") for (int bj = 0; bj < 2; ++bj) _Pragma("unroll") for (int m = 0; m < 4; ++m) _Pragma("unroll") for (int n = 0; n < 2; ++n) {
            const int row = brow + ai * 128 + wr * 64 + m * 16 + fr;
            const int col = bcol + bj * 128 + wc * 32 + n * 16 + fq * 4;
            const float4 xv = *reinterpret_cast<const float4*>(xin + (size_t)row * DM + col);
            float4 sc = make_float4(1.f, 1.f, 1.f, 1.f);
            if (pool) sc = *reinterpret_cast<const float4*>(scale + col);
            float4 o;
            o.x = ALPHA * xv.x + acc[ai][bj][m][n][0] * sc.x; o.y = ALPHA * xv.y + acc[ai][bj][m][n][1] * sc.y;
            o.z = ALPHA * xv.z + acc[ai][bj][m][n][2] * sc.z; o.w = ALPHA * xv.w + acc[ai][bj][m][n][3] * sc.w;
            *reinterpret_cast<float4*>(Z + (size_t)row * DM + col) = o;
        }
    }
}

struct MoeMap { int toff[17]; int cnt[16]; };
__device__ __forceinline__ void moe_build_map(LAS MoeMap* mp, const u32* __restrict__ gcnt) {
    if (otid() == 0) {
        int o = 0;
        for (int e = 0; e < 16; ++e) { int c = (int)__hip_atomic_load(gcnt + e, __ATOMIC_RELAXED, __HIP_MEMORY_SCOPE_AGENT); mp->cnt[e] = c; mp->toff[e] = o; o += (c + 255) >> 8; }
        mp->toff[16] = o;
    }
    __syncthreads();
}

__device__ __forceinline__ void phase_moe1(u16* shm, LAS MoeMap* mp, const u32* __restrict__ gcnt, const int* __restrict__ slot_tok, const u16* __restrict__ XH,
                           const u16* __restrict__ Wg, const u16* __restrict__ Wu, u16* __restrict__ Hout) {
    moe_build_map(mp, gcnt);
    const int RT = mp->toff[16];
    const int nunits = RT * 8;
    for (int u = blockIdx.x; u < nunits; u += gridDim.x) {
        const int rt = u >> 3, ft = u & 7;
        int e = 0;
        for (int i = 1; i < 16; ++i) e += (rt >= mp->toff[i]) ? 1 : 0;
        const int pos0 = (rt - mp->toff[e]) * 256, ne = mp->cnt[e];
        int R0, C0; stage_geom(R0, C0);
        int aq[4];
#pragma unroll
        for (int q = 0; q < 4; ++q) {
            const int p = pos0 + q * 64 + R0;
            const int tok = (p < ne) ? slot_tok[e * 16384 + p] : 0;
            aq[q] = tok * DM + C0;
        }
        const u16* B0p = Wg + ((size_t)e * 1024 + ft * 128) * DM;
        const u16* B1p = Wu + ((size_t)e * 1024 + ft * 128) * DM;
        const int bo = R0 * DM + C0;
        f32x4 acc[2][2][4][2]; ACC_ZERO(acc);
        gemm_core<true, true>(shm, XH, aq, 0, B0p, B1p, bo, 64 * DM, DM / BK, acc);
        int tz = otid();
        const int wid = tz >> 6, lane = tz & 63, wr = wid >> 2, wc = wid & 3, fr = lane & 15, fq = lane >> 4;
        _Pragma("unroll") for (int ai = 0; ai < 2; ++ai) _Pragma("unroll") for (int m = 0; m < 4; ++m) _Pragma("unroll") for (int n = 0; n < 2; ++n) {
            const int row = rt * 256 + ai * 128 + wr * 64 + m * 16 + fr;
            const int col = ft * 128 + wc * 32 + n * 16 + fq * 4;
            float hv[4];
#pragma unroll
            for (int j = 0; j < 4; ++j) { const float g = acc[ai][0][m][n][j], uu = acc[ai][1][m][n][j]; hv[j] = g * sigmoidf_(g) * uu; }
            uint2 v; v.x = pack2(hv[0], hv[1]); v.y = pack2(hv[2], hv[3]);
            *reinterpret_cast<uint2*>(Hout + (size_t)row * 1024 + col) = v;
        }
    }
}

__device__ __forceinline__ void phase_moe2(u16* shm, LAS MoeMap* mp, const u32* __restrict__ gcnt, const u16* __restrict__ Hin, const u16* __restrict__ Wd, u16* __restrict__ Y) {
    moe_build_map(mp, gcnt);
    const int RT = mp->toff[16];
    const int nunits = RT * 4;
    for (int u = blockIdx.x; u < nunits; u += gridDim.x) {
        const int rt = u >> 2, pn = u & 3;
        int e = 0;
        for (int i = 1; i < 16; ++i) e += (rt >= mp->toff[i]) ? 1 : 0;
        int R0, C0; stage_geom(R0, C0);
        const int aq[4] = {(rt * 256 + R0) * 1024 + C0, 0, 0, 0};
        const u16* B0p = Wd + ((size_t)e * 1024 + pn * 256) * 1024;
        const int bo = R0 * 1024 + C0;
        f32x4 acc[2][2][4][2]; ACC_ZERO(acc);
        gemm_core<true, false>(shm, Hin, aq, 64 * 1024, B0p, B0p + (size_t)128 * 1024, bo, 64 * 1024, 1024 / BK, acc);
        int tz = otid();
        const int wid = tz >> 6, lane = tz & 63, wr = wid >> 2, wc = wid & 3, fr = lane & 15, fq = lane >> 4;
        _Pragma("unroll") for (int ai = 0; ai < 2; ++ai) _Pragma("unroll") for (int bj = 0; bj < 2; ++bj) _Pragma("unroll") for (int m = 0; m < 4; ++m) _Pragma("unroll") for (int n = 0; n < 2; ++n) {
            const int row = rt * 256 + ai * 128 + wr * 64 + m * 16 + fr;
            const int col = pn * 256 + bj * 128 + wc * 32 + n * 16 + fq * 4;
            uint2 v; v.x = pack2(acc[ai][bj][m][n][0], acc[ai][bj][m][n][1]); v.y = pack2(acc[ai][bj][m][n][2], acc[ai][bj][m][n][3]);
            *reinterpret_cast<uint2*>(Y + (size_t)row * 1024 + col) = v;
        }
    }
}

__device__ __forceinline__ void conv_tile(float* sT, const float* __restrict__ src, int ld, int k0, int n0src, u16* __restrict__ dst, int K, int n0dst) {
    const int tid = otid();
    { const int r = tid >> 4, c4 = (tid & 15) * 4;
      const float4 a = *reinterpret_cast<const float4*>(src + (size_t)(k0 + r) * ld + n0src + c4);
      const float4 b = *reinterpret_cast<const float4*>(src + (size_t)(k0 + r + 32) * ld + n0src + c4);
      float* p = sT + r * 65 + c4; p[0] = a.x; p[1] = a.y; p[2] = a.z; p[3] = a.w;
      p = sT + (r + 32) * 65 + c4; p[0] = b.x; p[1] = b.y; p[2] = b.z; p[3] = b.w; }
    __syncthreads();
    { const int n = tid >> 3, k8 = (tid & 7) * 8;
      float v[8];
      for (int j = 0; j < 8; ++j) v[j] = sT[(k8 + j) * 65 + n];
      uint4 o; o.x = pack2(v[0], v[1]); o.y = pack2(v[2], v[3]); o.z = pack2(v[4], v[5]); o.w = pack2(v[6], v[7]);
      *reinterpret_cast<uint4*>(dst + (size_t)(n0dst + n) * K + k0 + k8) = o; }
    __syncthreads();
}
__device__ __forceinline__ void phase_convert(float* sT, const Params& p) {
    unsigned char* ws = p.ws;
    const int total = 2176 + 49152;
    for (int t = blockIdx.x; t < total; t += gridDim.x) {
        if (t < 1536) {
            const int i = t / 768, r = t % 768, kt = r / 48, ntl = r % 48;
            const int n0 = ntl * 64, n0src = n0 + (n0 >= 1536 ? 32 : 0);
            conv_tile(sT, p.in[I_WIN] + (size_t)i * 1024 * IN_COLS, IN_COLS, kt * 64, n0src, (u16*)(ws + WS_WIN) + (size_t)i * 3072 * 1024, 1024, n0);
        } else if (t < 2048) {
            const int q = t - 1536, i = q >> 8, r = q & 255, kt = r >> 4, ntl = r & 15;
            conv_tile(sT, p.in[I_WOUT] + (size_t)i * 1048576, 1024, kt * 64, ntl * 64, (u16*)(ws + WS_WOUT) + (size_t)i * 1048576, 1024, ntl * 64);
        } else if (t < 2176) {
            const int q = t - 2048, mtx = q >> 4, r = q & 15, kt = r >> 2, ntl = r & 3;
            conv_tile(sT, p.in[I_WPOOL] + (size_t)mtx * 65536, 256, kt * 64, ntl * 64, (u16*)(ws + WS_WPOOL) + (size_t)mtx * 65536, 256, ntl * 64);
        } else {
            const int q = t - 2176, which = q / 16384, r = q % 16384, mtx = r >> 8, tt = r & 255, kt = tt >> 4, ntl = tt & 15;
            const float* src = p.in[I_WG + which] + (size_t)mtx * 1048576;
            u16* dst = (u16*)(ws + (which == 0 ? WS_WG : (which == 1 ? WS_WU : WS_WD))) + (size_t)mtx * 1048576;
            conv_tile(sT, src, 1024, kt * 64, ntl * 64, dst, 1024, ntl * 64);
        }
    }
}

__device__ __forceinline__ int rho_of_k(int k) { return ((k >> 2) & 63) + 64 * ((k & 3) + 4 * (k >> 8)); }
template <int NO>
__device__ __forceinline__ void load_skinny(float* sW, const float* __restrict__ W, int ld, int c0) {
    for (int idx = otid(); idx < 1024 * (NO / 4); idx += NTHR) {
        const int k = idx / (NO / 4), c4 = (idx % (NO / 4)) * 4;
        const float4 v = *reinterpret_cast<const float4*>(W + (size_t)k * ld + c0 + c4);
        *reinterpret_cast<float4*>(sW + rho_of_k(k) * (NO + 4) + c4) = v;
    }
}
template <int NO>
__device__ __forceinline__ void skinny_dot(const float* sW, const float (&xv)[16], float (&o)[NO]) {
    const int lane = otid() & 63;
#pragma unroll
    for (int e = 0; e < NO; ++e) o[e] = 0.f;
#pragma unroll
    for (int i = 0; i < 4; ++i)
#pragma unroll
        for (int jj = 0; jj < 4; ++jj) {
            const float x = xv[i * 4 + jj];
            const float* wrow = sW + (lane + 64 * (jj + 4 * i)) * (NO + 4);
#pragma unroll
            for (int e4 = 0; e4 < NO; e4 += 4) {
                const float4 w = *reinterpret_cast<const float4*>(wrow + e4);
                o[e4] += x * w.x; o[e4 + 1] += x * w.y; o[e4 + 2] += x * w.z; o[e4 + 3] += x * w.w;
            }
            __builtin_amdgcn_sched_barrier(0);
        }
#pragma unroll
    for (int e = 0; e < NO; ++e) o[e] = wave_sum(o[e]);
}
__device__ __forceinline__ void store_row_bf16(u16* __restrict__ dst, const float (&v)[16], int lane) {
#pragma unroll
    for (int i = 0; i < 4; ++i) {
        uint2 o; o.x = pack2(v[i * 4], v[i * 4 + 1]); o.y = pack2(v[i * 4 + 2], v[i * 4 + 3]);
        *reinterpret_cast<uint2*>(dst + i * 256 + lane * 4) = o;
    }
}
__device__ __forceinline__ void store_row_f32(float* __restrict__ dst, const float (&v)[16], int lane) {
#pragma unroll
    for (int i = 0; i < 4; ++i) *reinterpret_cast<float4*>(dst + i * 256 + lane * 4) = make_float4(v[i * 4], v[i * 4 + 1], v[i * 4 + 2], v[i * 4 + 3]);
}
__device__ __forceinline__ void load_row_f32(const float* __restrict__ src, float (&v)[16], int lane) {
#pragma unroll
    for (int i = 0; i < 4; ++i) { const float4 t = *reinterpret_cast<const float4*>(src + i * 256 + lane * 4); v[i * 4] = t.x; v[i * 4 + 1] = t.y; v[i * 4 + 2] = t.z; v[i * 4 + 3] = t.w; }
}
__device__ __forceinline__ void layer_norm_row(float (&v)[16], const float* __restrict__ g, const float* __restrict__ b, int lane) {
    float s = 0.f;
#pragma unroll
    for (int i = 0; i < 16; ++i) s += v[i];
    const float mu = wave_sum(s) * (1.f / 1024.f);
    float q = 0.f;
#pragma unroll
    for (int i = 0; i < 16; ++i) { const float d = v[i] - mu; q += d * d; }
    const float rs = rsqrtf(wave_sum(q) * (1.f / 1024.f) + LN_EPS);
#pragma unroll
    for (int i = 0; i < 4; ++i) {
        const float4 gg = *reinterpret_cast<const float4*>(g + i * 256 + lane * 4);
        const float4 bb = *reinterpret_cast<const float4*>(b + i * 256 + lane * 4);
        v[i * 4] = (v[i * 4] - mu) * rs * gg.x + bb.x; v[i * 4 + 1] = (v[i * 4 + 1] - mu) * rs * gg.y + bb.y;
        v[i * 4 + 2] = (v[i * 4 + 2] - mu) * rs * gg.z + bb.z; v[i * 4 + 3] = (v[i * 4 + 3] - mu) * rs * gg.w + bb.w;
    }
}

__device__ __forceinline__ void phase_rows_prologue(float* sW, const float* __restrict__ x, const float* __restrict__ w_in0, u16* __restrict__ XH, float* __restrict__ LR) {
    load_skinny<32>(sW, w_in0, IN_COLS, 1536);
    __syncthreads();
    const int tid_ = otid(); const int lane = tid_ & 63, wave = tid_ >> 6;
    for (int row = blockIdx.x * 8 + wave; row < TOK; row += gridDim.x * 8) {
        float v[16]; load_row_f32(x + (size_t)row * DM, v, lane);
        store_row_bf16(XH + (size_t)row * DM, v, lane);
        float o[32]; skinny_dot<32>(sW, v, o);
        if (lane < 32) { float r = 0.f;
#pragma unroll
            for (int e = 0; e < 32; ++e) r = (lane == e) ? o[e] : r;
            LR[(size_t)row * 32 + lane] = r; }
    }
}

struct RouteLds { int e0[64], e1[64], lp0[64], lp1[64]; float w0[64], w1[64]; int cnt[16], base[16]; };
__device__ __forceinline__ void phase_rows_ln1(float* sW, LAS RouteLds* rl, const float* __restrict__ Z, const float* __restrict__ g, const float* __restrict__ b,
                               const float* __restrict__ w_router, const float* __restrict__ rbias,
                               float* __restrict__ X1, u16* __restrict__ XH, u32* __restrict__ gcnt, int* __restrict__ slot_tok, int* __restrict__ tinfo) {
    load_skinny<16>(sW, w_router, 16, 0);
    __syncthreads();
    const int tid = otid(); const int lane = tid & 63, wave = tid >> 6;
    for (int blk = blockIdx.x; blk < TOK / 64; blk += gridDim.x) {
        if (tid < 16) rl->cnt[tid] = 0;
        __syncthreads();
        for (int rr = 0; rr < 8; ++rr) {
            const int lr = wave * 8 + rr, row = blk * 64 + lr;
            float v[16]; load_row_f32(Z + (size_t)row * DM, v, lane);
            layer_norm_row(v, g, b, lane);
            store_row_f32(X1 + (size_t)row * DM, v, lane);
            store_row_bf16(XH + (size_t)row * DM, v, lane);
            float o[16]; skinny_dot<16>(sW, v, o);
            float aff[16], sel[16];
#pragma unroll
            for (int e = 0; e < 16; ++e) { aff[e] = 1.f / (1.f + expf(-o[e])); sel[e] = aff[e] + rbias[e]; }
            int bestg = 0; float bests = -1e30f;
#pragma unroll
            for (int gi = 0; gi < 4; ++gi) {
                float m1 = -1e30f, m2 = -1e30f;
#pragma unroll
                for (int j = 0; j < 4; ++j) { const float s = sel[gi * 4 + j]; if (s > m1) { m2 = m1; m1 = s; } else if (s > m2) m2 = s; }
                const float gs = m1 + m2;
                if (gs > bests) { bests = gs; bestg = gi; }
            }
            int i0 = 0, i1 = 0; float s0 = -1e30f, s1 = -1e30f, a0 = 0.f, a1 = 0.f;
#pragma unroll
            for (int e = 0; e < 16; ++e) {
                const bool in = (e >> 2) == bestg;
                const float s = sel[e];
                if (in) { if (s > s0) { s1 = s0; i1 = i0; a1 = a0; s0 = s; i0 = e; a0 = aff[e]; } else if (s > s1) { s1 = s; i1 = e; a1 = aff[e]; } }
            }
            if (lane == 0) { const float inv = 1.f / (a0 + a1); rl->e0[lr] = i0; rl->e1[lr] = i1; rl->w0[lr] = a0 * inv; rl->w1[lr] = a1 * inv; }
        }
        __syncthreads();
        if (tid < 64) { rl->lp0[tid] = atomicAdd((int*)&rl->cnt[rl->e0[tid]], 1); rl->lp1[tid] = atomicAdd((int*)&rl->cnt[rl->e1[tid]], 1); }
        __syncthreads();
        if (tid < 16) rl->base[tid] = (int)atomicAdd(gcnt + tid, (u32)rl->cnt[tid]);
        __syncthreads();
        if (tid < 64) {
            const int row = blk * 64 + tid;
            const int e0 = rl->e0[tid], e1 = rl->e1[tid];
            const int p0 = rl->base[e0] + rl->lp0[tid], p1 = rl->base[e1] + rl->lp1[tid];
            slot_tok[e0 * 16384 + p0] = row; slot_tok[e1 * 16384 + p1] = row;
            int4 a; a.x = e0; a.y = p0; a.z = e1; a.w = p1;
            *reinterpret_cast<int4*>(tinfo + (size_t)row * 8) = a;
            float2 w; w.x = rl->w0[tid]; w.y = rl->w1[tid];
            *reinterpret_cast<float2*>(tinfo + (size_t)row * 8 + 4) = w;
        }
        __syncthreads();
    }
}

__device__ __forceinline__ void phase_rows_ln2(float* sW, LAS MoeMap* mp, const u32* __restrict__ gcnt, const float* __restrict__ X1, const u16* __restrict__ Y, const int* __restrict__ tinfo,
                               const float* __restrict__ g, const float* __restrict__ b, float* __restrict__ X2, u16* __restrict__ XH,
                               const float* __restrict__ w_in_next, float* __restrict__ LR) {
    moe_build_map(mp, gcnt);
    if (w_in_next) { load_skinny<32>(sW, w_in_next, IN_COLS, 1536); __syncthreads(); }
    const int tid_ = otid(); const int lane = tid_ & 63, wave = tid_ >> 6;
    for (int row = blockIdx.x * 8 + wave; row < TOK; row += gridDim.x * 8) {
        const int4 a = *reinterpret_cast<const int4*>(tinfo + (size_t)row * 8);
        const float2 w = *reinterpret_cast<const float2*>(tinfo + (size_t)row * 8 + 4);
        const size_t r0 = (size_t)(mp->toff[a.x] * 256 + a.y), r1 = (size_t)(mp->toff[a.z] * 256 + a.w);
        float v[16]; load_row_f32(X1 + (size_t)row * DM, v, lane);
#pragma unroll
        for (int i = 0; i < 4; ++i) {
            const uint2 y0 = *reinterpret_cast<const uint2*>(Y + r0 * 1024 + i * 256 + lane * 4);
            const uint2 y1 = *reinterpret_cast<const uint2*>(Y + r1 * 1024 + i * 256 + lane * 4);
            v[i * 4 + 0] = ALPHA * v[i * 4 + 0] + w.x * bf2f((u16)(y0.x & 0xffff)) + w.y * bf2f((u16)(y1.x & 0xffff));
            v[i * 4 + 1] = ALPHA * v[i * 4 + 1] + w.x * bf2f((u16)(y0.x >> 16)) + w.y * bf2f((u16)(y1.x >> 16));
            v[i * 4 + 2] = ALPHA * v[i * 4 + 2] + w.x * bf2f((u16)(y0.y & 0xffff)) + w.y * bf2f((u16)(y1.y & 0xffff));
            v[i * 4 + 3] = ALPHA * v[i * 4 + 3] + w.x * bf2f((u16)(y0.y >> 16)) + w.y * bf2f((u16)(y1.y >> 16));
        }
        layer_norm_row(v, g, b, lane);
        store_row_f32(X2 + (size_t)row * DM, v, lane);
        store_row_bf16(XH + (size_t)row * DM, v, lane);
        if (w_in_next) {
            float o[32]; skinny_dot<32>(sW, v, o);
            if (lane < 32) { float r = 0.f;
#pragma unroll
                for (int e = 0; e < 32; ++e) r = (lane == e) ? o[e] : r;
                LR[(size_t)row * 32 + lane] = r; }
        }
    }
}

__device__ __forceinline__ void phase_rows_pool(const float* __restrict__ X, u16* __restrict__ MIX) {
    const int tid_ = otid(); const int lane = tid_ & 63, wave = tid_ >> 6;
    for (int row = blockIdx.x * 8 + wave; row < TOK; row += gridDim.x * 8) {
        const int pos = row & (SEQ - 1), rb = row - pos;
        float v[16];
#pragma unroll
        for (int i = 0; i < 4; ++i) {
            const int half = 1 << i;
            const int lo = max(pos - half, 0), hi = min(pos + half, SEQ);
            float4 s = make_float4(0.f, 0.f, 0.f, 0.f);
            for (int t = lo; t < hi; ++t) { const float4 q = *reinterpret_cast<const float4*>(X + (size_t)(rb + t) * DM + i * 256 + lane * 4); s.x += q.x; s.y += q.y; s.z += q.z; s.w += q.w; }
            const float4 c = *reinterpret_cast<const float4*>(X + (size_t)row * DM + i * 256 + lane * 4);
            const float inv = 1.f / (float)(hi - lo);
            v[i * 4] = s.x * inv - c.x; v[i * 4 + 1] = s.y * inv - c.y; v[i * 4 + 2] = s.z * inv - c.z; v[i * 4 + 3] = s.w * inv - c.w;
        }
        store_row_bf16(MIX + (size_t)row * DM, v, lane);
    }
}

__device__ __forceinline__ float log_sigmoid_(float x) { return fminf(x, 0.f) - log1pf(expf(-fabsf(x))); }
__device__ __forceinline__ void gla_gates(float* sb  , float* slr  , float* swg  ,
                          const float* __restrict__ LR, const float* __restrict__ wgg, const float* __restrict__ bgg, int t0, int hd) {
    const int tid = otid();
    for (int i = tid; i < 64 * 32; i += NTHR) slr[i] = LR[(size_t)t0 * 32 + i];
    for (int i = tid; i < 2 * 16 * 64; i += NTHR) { const int d = i >> 10, r = (i >> 6) & 15, kk = i & 63; swg[i] = wgg[(d * 16 + r) * 256 + hd * 64 + kk]; }
    if (tid < 128) swg[2048 + tid] = bgg[(tid >> 6) * 256 + hd * 64 + (tid & 63)];
    __syncthreads();
    for (int i = tid; i < 2 * 64 * 64; i += NTHR) {
        const int d = i >> 12, j = (i >> 6) & 63, kk = i & 63;
        float a = swg[2048 + d * 64 + kk];
#pragma unroll
        for (int r = 0; r < 16; ++r) a += slr[j * 32 + d * 16 + r] * swg[(d * 16 + r) * 64 + kk];
        sb[i] = log_sigmoid_(a) * (1.f / 16.f);
    }
    __syncthreads();
    if (tid < 128) {
        const int d = tid >> 6, kk = tid & 63;
        float run = 0.f;
        if (d == 0) { for (int j = 0; j < 64; ++j) { run += sb[j * 64 + kk]; sb[j * 64 + kk] = run; } }
        else { for (int j = 63; j >= 0; --j) { run += sb[4096 + j * 64 + kk]; sb[4096 + j * 64 + kk] = run; } }
    }
    __syncthreads();
}

__device__ __forceinline__ void phase_gla_g1(float* lds, const u16* __restrict__ Hb, const float* __restrict__ LR, const float* __restrict__ wgg, const float* __restrict__ bgg,
                             float* __restrict__ ST, float* __restrict__ DEC, int item_lo_stride_dummy) {
    float* sb = lds;
    float* slr = sb + 8192;
    float* swg = slr + 2048;
    float* sv = swg + 2304;
    float* skh = sv + 8192;
    const int tid = otid();
    for (int item = blockIdx.x; item < 1024; item += gridDim.x) {
        const int c = item & 31, hd = (item >> 5) & 3, b = item >> 7;
        const int t0 = b * SEQ + c * 64;
        gla_gates(sb, slr, swg, LR, wgg, bgg, t0, hd);
        for (int i = tid; i < 64 * 128; i += NTHR) { const int j = i >> 7, vv = i & 127; sv[i] = bf2f(Hb[(size_t)(t0 + j) * HC + 512 + hd * 128 + vv]); }
        for (int i = tid; i < 2 * 64 * 64; i += NTHR) {
            const int d = i >> 12, j = (i >> 6) & 63, kk = i & 63;
            const float kval = bf2f(Hb[(size_t)(t0 + j) * HC + 256 + hd * 64 + kk]);
            const float bend = d == 0 ? sb[63 * 64 + kk] : sb[4096 + kk];
            skh[i] = kval * expf(bend - sb[i]);
        }
        if (tid < 128) { const int d = tid >> 6, kk = tid & 63; DEC[((size_t)item * 2 + d) * 64 + kk] = expf(d == 0 ? sb[63 * 64 + kk] : sb[4096 + kk]); }
        __syncthreads();
        {
            const int d = tid >> 8, kb = (tid >> 4) & 15, vb = tid & 15;
            float acc[4][8];
#pragma unroll
            for (int a = 0; a < 4; ++a)
#pragma unroll
                for (int q = 0; q < 8; ++q) acc[a][q] = 0.f;
            for (int j = 0; j < 64; ++j) {
                const float4 kq = *reinterpret_cast<const float4*>(skh + d * 4096 + j * 64 + kb * 4);
                const float4 v0 = *reinterpret_cast<const float4*>(sv + j * 128 + vb * 8);
                const float4 v1 = *reinterpret_cast<const float4*>(sv + j * 128 + vb * 8 + 4);
                const float kk4[4] = {kq.x, kq.y, kq.z, kq.w};
                const float vv8[8] = {v0.x, v0.y, v0.z, v0.w, v1.x, v1.y, v1.z, v1.w};
#pragma unroll
                for (int a = 0; a < 4; ++a)
#pragma unroll
                    for (int q = 0; q < 8; ++q) acc[a][q] += kk4[a] * vv8[q];
            }
            float* dst = ST + ((size_t)item * 2 + d) * 8192;
#pragma unroll
            for (int a = 0; a < 4; ++a) {
                *reinterpret_cast<float4*>(dst + (kb * 4 + a) * 128 + vb * 8) = make_float4(acc[a][0], acc[a][1], acc[a][2], acc[a][3]);
                *reinterpret_cast<float4*>(dst + (kb * 4 + a) * 128 + vb * 8 + 4) = make_float4(acc[a][4], acc[a][5], acc[a][6], acc[a][7]);
            }
        }
        __syncthreads();
    }
}

__device__ __forceinline__ void phase_gla_g2(float* __restrict__ ST, const float* __restrict__ DEC) {
    const int nwork = 64 * 2048;
    for (int w = blockIdx.x * NTHR + otid(); w < nwork; w += gridDim.x * NTHR) {
        const int e4 = w & 2047, bhd = w >> 11, d = bhd & 1, bh = bhd >> 1;
        const int kk = e4 >> 5;
        float4 st = make_float4(0.f, 0.f, 0.f, 0.f);
        for (int s = 0; s < 32; ++s) {
            const int c = d == 0 ? s : 31 - s;
            const size_t item = (size_t)bh * 32 + c;
            float4* pp = reinterpret_cast<float4*>(ST + (item * 2 + d) * 8192) + e4;
            const float4 ds = *pp;
            const float dec = DEC[(item * 2 + d) * 64 + kk];
            *pp = st;
            st.x = dec * st.x + ds.x; st.y = dec * st.y + ds.y; st.z = dec * st.z + ds.z; st.w = dec * st.w + ds.w;
        }
    }
}

__device__ __forceinline__ void phase_gla_g3(float* lds, const u16* __restrict__ Hb, const float* __restrict__ LR, const float* __restrict__ wgg, const float* __restrict__ bgg,
                             const float* __restrict__ ST, const float* __restrict__ gnorm, u16* __restrict__ MIX) {
    float* sb = lds;
    float* slr = sb + 8192;
    float* swg = slr + 2048;
    float* sqt = slr;
    float* sq = swg + 2304;
    float* sk = sq + 4096;
    float* sv = sk + 4096;
    float* skt = sv + 8192;
    float* ssc = skt + 4352;
    const int tid = otid();
    for (int item = blockIdx.x; item < 1024; item += gridDim.x) {
        const int c = item & 31, hd = (item >> 5) & 3, b = item >> 7;
        const int t0 = b * SEQ + c * 64;
        gla_gates(sb, slr, swg, LR, wgg, bgg, t0, hd);
        for (int i = tid; i < 64 * 64; i += NTHR) { const int j = i >> 6, kk = i & 63;
            sq[i] = bf2f(Hb[(size_t)(t0 + j) * HC + hd * 64 + kk]) * 0.125f;
            sk[i] = bf2f(Hb[(size_t)(t0 + j) * HC + 256 + hd * 64 + kk]); }
        for (int i = tid; i < 64 * 128; i += NTHR) { const int j = i >> 7, vv = i & 127; sv[i] = bf2f(Hb[(size_t)(t0 + j) * HC + 512 + hd * 128 + vv]); }
        __syncthreads();
        const int ib = tid >> 5, vb = tid & 31;
        float o[4][4];
#pragma unroll
        for (int a = 0; a < 4; ++a)
#pragma unroll
            for (int q = 0; q < 4; ++q) o[a][q] = 0.f;
        for (int d = 0; d < 2; ++d) {
            const float* bd = sb + d * 4096;
            const int mid = d == 0 ? 31 : 32;
            for (int i = tid; i < 64 * 64; i += NTHR) { const int j = i >> 6, kk = i & 63;
                const float bm = bd[mid * 64 + kk], bj = bd[i];
                sqt[j * 68 + kk] = sq[i] * expf(bj - bm);
                skt[j * 68 + kk] = sk[i] * expf(bm - bj); }
            __syncthreads();
            {
                const int jb = tid & 31;
                float sc[4][2];
#pragma unroll
                for (int a = 0; a < 4; ++a) { sc[a][0] = 0.f; sc[a][1] = 0.f; }
#pragma unroll 1
                for (int k4 = 0; k4 < 64; k4 += 4) {
                    float4 qv[4], kv[2];
#pragma unroll
                    for (int a = 0; a < 4; ++a) qv[a] = *reinterpret_cast<const float4*>(sqt + (ib * 4 + a) * 68 + k4);
#pragma unroll
                    for (int q = 0; q < 2; ++q) kv[q] = *reinterpret_cast<const float4*>(skt + (jb * 2 + q) * 68 + k4);
#pragma unroll
                    for (int a = 0; a < 4; ++a)
#pragma unroll
                        for (int q = 0; q < 2; ++q) sc[a][q] += qv[a].x * kv[q].x + qv[a].y * kv[q].y + qv[a].z * kv[q].z + qv[a].w * kv[q].w;
                }
#pragma unroll
                for (int a = 0; a < 4; ++a)
#pragma unroll
                    for (int q = 0; q < 2; ++q) {
                        const int i = ib * 4 + a, j = jb * 2 + q;
                        const bool keep = d == 0 ? (j <= i) : (j > i);
                        ssc[i * 68 + j] = keep ? sc[a][q] : 0.f;
                    }
            }
            __syncthreads();
#pragma unroll 1
            for (int j4 = 0; j4 < 64; j4 += 4) {
                float4 sv4[4], vv4[4];
#pragma unroll
                for (int a = 0; a < 4; ++a) sv4[a] = *reinterpret_cast<const float4*>(ssc + (ib * 4 + a) * 68 + j4);
#pragma unroll
                for (int q = 0; q < 4; ++q) vv4[q] = *reinterpret_cast<const float4*>(sv + (j4 + q) * 128 + vb * 4);
#pragma unroll
                for (int a = 0; a < 4; ++a) {
                    o[a][0] += sv4[a].x * vv4[0].x + sv4[a].y * vv4[1].x + sv4[a].z * vv4[2].x + sv4[a].w * vv4[3].x;
                    o[a][1] += sv4[a].x * vv4[0].y + sv4[a].y * vv4[1].y + sv4[a].z * vv4[2].y + sv4[a].w * vv4[3].y;
                    o[a][2] += sv4[a].x * vv4[0].z + sv4[a].y * vv4[1].z + sv4[a].z * vv4[2].z + sv4[a].w * vv4[3].z;
                    o[a][3] += sv4[a].x * vv4[0].w + sv4[a].y * vv4[1].w + sv4[a].z * vv4[2].w + sv4[a].w * vv4[3].w;
                }
            }
            __syncthreads();
            float* sps = skt;
            for (int i = tid; i < 64 * 64; i += NTHR) { const int j = i >> 6, kk = i & 63; sqt[j * 68 + kk] = sq[i] * expf(bd[i]); }
            { const float4* src = reinterpret_cast<const float4*>(ST + ((size_t)item * 2 + d) * 8192);
              for (int i = tid; i < 2048; i += NTHR) reinterpret_cast<float4*>(sps)[i] = src[i]; }
            __syncthreads();
#pragma unroll 1
            for (int k4 = 0; k4 < 64; k4 += 4) {
                float4 qv[4], pv[4];
#pragma unroll
                for (int a = 0; a < 4; ++a) qv[a] = *reinterpret_cast<const float4*>(sqt + (ib * 4 + a) * 68 + k4);
#pragma unroll
                for (int q = 0; q < 4; ++q) pv[q] = *reinterpret_cast<const float4*>(sps + (k4 + q) * 128 + vb * 4);
#pragma unroll
                for (int a = 0; a < 4; ++a) {
                    o[a][0] += qv[a].x * pv[0].x + qv[a].y * pv[1].x + qv[a].z * pv[2].x + qv[a].w * pv[3].x;
                    o[a][1] += qv[a].x * pv[0].y + qv[a].y * pv[1].y + qv[a].z * pv[2].y + qv[a].w * pv[3].y;
                    o[a][2] += qv[a].x * pv[0].z + qv[a].y * pv[1].z + qv[a].z * pv[2].z + qv[a].w * pv[3].z;
                    o[a][3] += qv[a].x * pv[0].w + qv[a].y * pv[1].w + qv[a].z * pv[2].w + qv[a].w * pv[3].w;
                }
            }
            __syncthreads();
        }
        const float4 gn = *reinterpret_cast<const float4*>(gnorm + vb * 4);
#pragma unroll
        for (int a = 0; a < 4; ++a) {
            float ss = o[a][0] * o[a][0] + o[a][1] * o[a][1] + o[a][2] * o[a][2] + o[a][3] * o[a][3];
#pragma unroll
            for (int off = 16; off > 0; off >>= 1) ss += __shfl_xor(ss, off);
            const float rs = rsqrtf(ss * (1.f / 128.f) + RMS_EPS);
            const int t = t0 + ib * 4 + a;
            const uint2 gg = *reinterpret_cast<const uint2*>(Hb + (size_t)t * HC + 1024 + hd * 128 + vb * 4);
            const float g0 = bf2f((u16)(gg.x & 0xffff)), g1 = bf2f((u16)(gg.x >> 16)), g2 = bf2f((u16)(gg.y & 0xffff)), g3 = bf2f((u16)(gg.y >> 16));
            const float r0 = o[a][0] * rs * gn.x * (g0 * sigmoidf_(g0));
            const float r1 = o[a][1] * rs * gn.y * (g1 * sigmoidf_(g1));
            const float r2 = o[a][2] * rs * gn.z * (g2 * sigmoidf_(g2));
            const float r3 = o[a][3] * rs * gn.w * (g3 * sigmoidf_(g3));
            uint2 ov; ov.x = pack2(r0, r1); ov.y = pack2(r2, r3);
            *reinterpret_cast<uint2*>(MIX + (size_t)t * DM + hd * 128 + vb * 4) = ov;
        }
        __syncthreads();
    }
}

constexpr int KROW = 136, VROW = 72;
constexpr int ATT_KBYTES = 64 * KROW * 2, ATT_VBYTES = 128 * VROW * 2;
constexpr int ATT_BUF = ATT_KBYTES + ATT_VBYTES;
constexpr int ATT_TBL = 2 * ATT_BUF;
constexpr int ATT_MISC = ATT_TBL + 4096 * 4;
__device__ __forceinline__ int t5_bucket(int rel) {
    const int n = rel < 0 ? -rel : rel;
    int v;
    if (n < 8) v = n;
    else v = 8 + (n >= 12) + (n >= 16) + (n >= 23) + (n >= 32) + (n >= 46) + (n >= 64) + (n >= 91);
    return v + (rel > 0 ? 16 : 0);
}
__device__ __forceinline__ void phase_attn(char* lds, const u16* __restrict__ Hb, const u16* __restrict__ Vt, const float* __restrict__ relb, const float* __restrict__ dlam,
                           const float* __restrict__ dnorm, float lam_init, u16* __restrict__ MIX) {
    const int tid = otid(), lane = tid & 63, wave = tid >> 6, map = wave >> 2, qsub = wave & 3, lq = lane & 31, hh = lane >> 5;
    float* tbl = reinterpret_cast<float*>(lds + ATT_TBL);
    float* misc = reinterpret_cast<float*>(lds + ATT_MISC);
    const float LOG2E = 1.4426950408889634f;
    if (wave == 0) {
        float a = dlam[lane] * dlam[64 + lane], bq = dlam[128 + lane] * dlam[192 + lane];
        a = wave_sum(a); bq = wave_sum(bq);
        if (lane == 0) misc[0] = expf(a) - expf(bq) + lam_init;
    }
    __syncthreads();
    const float lam_full = misc[0];
    const int pi_lq = (lq & 0x13) | ((lq & 4) << 1) | ((lq & 8) >> 1);
    for (int item = blockIdx.x; item < 512; item += gridDim.x) {
        const int qb = item & 15, hd = (item >> 4) & 3, b = item >> 6;
        for (int i = tid; i < 4095; i += NTHR) tbl[i] = relb[t5_bucket(i - 2047) * 4 + hd] * LOG2E;
        const float c_lo = relb[15 * 4 + hd] * LOG2E, c_hi = relb[31 * 4 + hd] * LOG2E;
        const int q0 = qb * 128 + qsub * 32;
        const size_t trow = (size_t)b * SEQ;
        bf16x8 qf[4];
#pragma unroll
        for (int ks = 0; ks < 4; ++ks)
            qf[ks] = *reinterpret_cast<const bf16x8*>(Hb + (trow + q0 + lq) * HC + 1536 + hd * 128 + map * 64 + ks * 16 + hh * 8);
        f32x16 oacc[4];
#pragma unroll
        for (int db = 0; db < 4; ++db)
#pragma unroll
            for (int i = 0; i < 16; ++i) oacc[db][i] = 0.f;
        float m_run = -1e30f, l_run = 0.f;
        const u16* kbase = Hb + trow * HC + 2048 + hd * 128;
        const u16* vbase = Vt + ((size_t)(b * 4 + hd) * 128) * SEQ;
        uint4 kreg[2], vreg[2];
#define ATT_LOAD(k0) do { \
            for (int i_ = 0; i_ < 2; ++i_) { const int p_ = tid + i_ * 512; \
                kreg[i_] = *reinterpret_cast<const uint4*>(kbase + (size_t)((k0) + (p_ >> 4)) * HC + (p_ & 15) * 8); \
                vreg[i_] = *reinterpret_cast<const uint4*>(vbase + (size_t)(p_ >> 3) * SEQ + (k0) + (p_ & 7) * 8); } } while (0)
#define ATT_WRITE(buf) do { char* kb_ = lds + (buf) * ATT_BUF; char* vb_ = kb_ + ATT_KBYTES; \
            for (int i_ = 0; i_ < 2; ++i_) { const int p_ = tid + i_ * 512; \
                *reinterpret_cast<uint4*>(kb_ + ((p_ >> 4) * KROW + (p_ & 15) * 8) * 2) = kreg[i_]; \
                *reinterpret_cast<uint4*>(vb_ + ((p_ >> 3) * VROW + (p_ & 7) * 8) * 2) = vreg[i_]; } } while (0)
        ATT_LOAD(0);
        ATT_WRITE(0);
        __syncthreads();
        for (int kt = 0; kt < 32; ++kt) {
            const int k0 = kt * 64;
            if (kt + 1 < 32) ATT_LOAD(k0 + 64);
            const char* kb = lds + (kt & 1) * ATT_BUF;
            const char* vb = kb + ATT_KBYTES;
            f32x16 sacc[2];
#pragma unroll
            for (int st = 0; st < 2; ++st) {
#pragma unroll
                for (int i = 0; i < 16; ++i) sacc[st][i] = 0.f;
#pragma unroll
                for (int ks = 0; ks < 4; ++ks) {
                    const bf16x8 kf = *reinterpret_cast<const bf16x8*>(kb + ((st * 32 + pi_lq) * KROW + map * 64 + ks * 16 + hh * 8) * 2);
                    sacc[st] = __builtin_amdgcn_mfma_f32_32x32x16_bf16(kf, qf[ks], sacc[st], 0, 0, 0);
                }
            }
            const float c1 = 0.125f * LOG2E;
            float mx = -1e30f;
            const bool far_hi = (k0 - (q0 + 31)) >= 128, far_lo = (q0 - (k0 + 63)) >= 128;
            if (far_hi || far_lo) {
                const float cb = far_hi ? c_hi : c_lo;
#pragma unroll
                for (int st = 0; st < 2; ++st)
#pragma unroll
                    for (int i = 0; i < 16; ++i) { const float s = sacc[st][i] * c1 + cb; sacc[st][i] = s; mx = fmaxf(mx, s); }
            } else {
                const int rbase = k0 - (q0 + lq) + 2047 + 8 * hh;
#pragma unroll
                for (int st = 0; st < 2; ++st)
#pragma unroll
                    for (int i = 0; i < 16; ++i) {
                        const int koff = st * 32 + (i & 3) + 4 * ((i >> 2) & 1) + 16 * (i >> 3);
                        const float s = sacc[st][i] * c1 + tbl[rbase + koff];
                        sacc[st][i] = s; mx = fmaxf(mx, s);
                    }
            }
            mx = fmaxf(mx, __shfl_xor(mx, 32));
            const float m_new = fmaxf(m_run, mx);
            const float alpha = exp2f(m_run - m_new);
            m_run = m_new;
            float psum = 0.f;
            bf16x8 pf[4];
#pragma unroll
            for (int st = 0; st < 2; ++st)
#pragma unroll
                for (int s2 = 0; s2 < 2; ++s2) {
                    float pv[8];
#pragma unroll
                    for (int j = 0; j < 8; ++j) { pv[j] = exp2f(sacc[st][s2 * 8 + j] - m_new); psum += pv[j]; }
                    union { bf16x8 v; u32 w[4]; } cv;
                    cv.w[0] = pack2(pv[0], pv[1]); cv.w[1] = pack2(pv[2], pv[3]); cv.w[2] = pack2(pv[4], pv[5]); cv.w[3] = pack2(pv[6], pv[7]);
                    pf[st * 2 + s2] = cv.v;
                }
            l_run = l_run * alpha + psum;
#pragma unroll
            for (int db = 0; db < 4; ++db)
#pragma unroll
                for (int i = 0; i < 16; ++i) oacc[db][i] *= alpha;
#pragma unroll
            for (int db = 0; db < 4; ++db)
#pragma unroll
                for (int st = 0; st < 2; ++st)
#pragma unroll
                    for (int s2 = 0; s2 < 2; ++s2) {
                        const bf16x8 vf = *reinterpret_cast<const bf16x8*>(vb + ((db * 32 + lq) * VROW + st * 32 + s2 * 16 + hh * 8) * 2);
                        oacc[db] = __builtin_amdgcn_mfma_f32_32x32x16_bf16(vf, pf[st * 2 + s2], oacc[db], 0, 0, 0);
                    }
            if (kt + 1 < 32) ATT_WRITE((kt + 1) & 1);
            __syncthreads();
        }
        const float l_tot = l_run + __shfl_xor(l_run, 32);
        float* xch = reinterpret_cast<float*>(lds);
        const int qrow = qsub * 32 + lq;
        if (map == 1) {
            const float sc = lam_full / l_tot;
#pragma unroll
            for (int db = 0; db < 4; ++db)
#pragma unroll
                for (int g4 = 0; g4 < 4; ++g4) {
                    const int dv = db * 32 + g4 * 8 + hh * 4;
                    *reinterpret_cast<float4*>(xch + qrow * 132 + dv) = make_float4(oacc[db][g4 * 4] * sc, oacc[db][g4 * 4 + 1] * sc, oacc[db][g4 * 4 + 2] * sc, oacc[db][g4 * 4 + 3] * sc);
                }
        }
        __syncthreads();
        if (map == 0) {
            const float inv = 1.f / l_tot;
            float ss = 0.f;
#pragma unroll
            for (int db = 0; db < 4; ++db)
#pragma unroll
                for (int g4 = 0; g4 < 4; ++g4) {
                    const int dv = db * 32 + g4 * 8 + hh * 4;
                    const float4 o1 = *reinterpret_cast<const float4*>(xch + qrow * 132 + dv);
                    float v0 = oacc[db][g4 * 4] * inv - o1.x, v1 = oacc[db][g4 * 4 + 1] * inv - o1.y, v2 = oacc[db][g4 * 4 + 2] * inv - o1.z, v3 = oacc[db][g4 * 4 + 3] * inv - o1.w;
                    oacc[db][g4 * 4] = v0; oacc[db][g4 * 4 + 1] = v1; oacc[db][g4 * 4 + 2] = v2; oacc[db][g4 * 4 + 3] = v3;
                    ss += v0 * v0 + v1 * v1 + v2 * v2 + v3 * v3;
                }
            ss += __shfl_xor(ss, 32);
            const float rs = rsqrtf(ss * (1.f / 128.f) + RMS_EPS) * (1.f - lam_init);
            u16* dst = MIX + (trow + q0 + lq) * DM + 512 + hd * 128;
#pragma unroll
            for (int db = 0; db < 4; ++db)
#pragma unroll
                for (int g4 = 0; g4 < 4; ++g4) {
                    const int dv = db * 32 + g4 * 8 + hh * 4;
                    const float4 nw = *reinterpret_cast<const float4*>(dnorm + dv);
                    uint2 ov; ov.x = pack2(oacc[db][g4 * 4] * rs * nw.x, oacc[db][g4 * 4 + 1] * rs * nw.y);
                    ov.y = pack2(oacc[db][g4 * 4 + 2] * rs * nw.z, oacc[db][g4 * 4 + 3] * rs * nw.w);
                    *reinterpret_cast<uint2*>(dst + dv) = ov;
                }
        }
        __syncthreads();
    }
#undef ATT_LOAD
#undef ATT_WRITE
}

constexpr int NPHASE = 1 + 9 * NLAYER;
__global__ void __launch_bounds__(NTHR, 2) fwd_kernel(Params p) {
    extern __shared__ __attribute__((aligned(16))) unsigned char lds[];
    unsigned char* ws = p.ws;
    const int lo = p.ph_lo, hi = p.ph_hi;
    volatile LAS unsigned* barw = (volatile LAS unsigned*)(lds + LDS_BARW);
    if (threadIdx.x == 0) { barw[0] = 0u; barw[1] = 0u; barw[2] = 0u; barw[3] = 0u; }
    __syncthreads();
    XcdBarrier bar; bar.bar = (unsigned*)(ws + WS_CTL); bar.x = 0; bar.st = barw;
    const bool multi = (hi - lo) > 1;
    if (multi) bar = xcd_barrier_post((unsigned*)(ws + WS_CTL), barw);
#define IN(k) (lo <= (k) && (k) < hi)
#define SEAM(k) do { if (IN(k) && IN((k) + 1)) xcd_barrier(bar); } while (0)

    u16* shm = reinterpret_cast<u16*>(lds);
    float* ldsf = reinterpret_cast<float*>(lds);
    LAS MoeMap* mp = (LAS MoeMap*)(lds + LDS_MOEMAP);
    u16* Wt_in = (u16*)(ws + WS_WIN); u16* Wt_out = (u16*)(ws + WS_WOUT); u16* Wt_pool = (u16*)(ws + WS_WPOOL);
    u16* Wt_g = (u16*)(ws + WS_WG); u16* Wt_u = (u16*)(ws + WS_WU); u16* Wt_d = (u16*)(ws + WS_WD);
    float* XA = (float*)(ws + WS_XA); float* XB = (float*)(ws + WS_XB);
    u16* XH = (u16*)(ws + WS_XH); u16* MIX = (u16*)(ws + WS_MIXIN);
    float* LR = (float*)(ws + WS_LR); u16* Vt = (u16*)(ws + WS_VT);
    u16* Hb = (u16*)(ws + WS_R1); u16* Hmoe = (u16*)(ws + WS_R1);
    float* ST = (float*)(ws + WS_R2); float* Z = (float*)(ws + WS_R2); u16* Y = (u16*)(ws + WS_R2);
    int* slot_tok = (int*)(ws + WS_SLOT); int* tinfo = (int*)(ws + WS_TINFO); float* DEC = (float*)(ws + WS_DEC);
    u32* gcnt_all = (u32*)(ws + WS_CTL + CTL_CNT);

    if (IN(0)) {
        phase_convert(ldsf, p);
        __syncthreads();
        phase_rows_prologue(ldsf, p.in[I_X], p.in[I_WIN], XH, LR);
    }
    SEAM(0);
    for (int L = 0; L < NLAYER; ++L) {
        const int base = 1 + 9 * L;
        const bool even = (L & 1) == 0;
        const int i2 = L >> 1;
        const float* xin = (L == 0) ? p.in[I_X] : XA;
        float* xout = (L == NLAYER - 1) ? p.out : XA;
        u32* gcnt = gcnt_all + L * 16;
        if (even) {
            if (IN(base + 0)) phase_inproj(shm, XH, Wt_in + (size_t)i2 * 3072 * 1024, Hb, Vt);
            SEAM(base + 0);
            if (IN(base + 1)) {
                const float lam_init = 0.8f - 0.6f * expf(-0.3f * (float)L);
                phase_attn((char*)lds, Hb, Vt, p.in[I_RELB], p.in[I_DLAM] + i2 * 256, p.in[I_DNORM] + i2 * 128, lam_init, MIX);
                __syncthreads();
                phase_gla_g1(ldsf, Hb, LR, p.in[I_WGG] + i2 * 2 * 16 * 256, p.in[I_BGG] + i2 * 2 * 256, ST, DEC, 0);
            }
            SEAM(base + 1);
            if (IN(base + 2)) phase_gla_g2(ST, DEC);
            SEAM(base + 2);
            if (IN(base + 3)) phase_gla_g3(ldsf, Hb, LR, p.in[I_WGG] + i2 * 2 * 16 * 256, p.in[I_BGG] + i2 * 2 * 256, ST, p.in[I_GNORM] + i2 * 128, MIX);
            SEAM(base + 3);
            if (IN(base + 4)) phase_mixproj(shm, MIX, Wt_out + (size_t)i2 * 1048576, false, xin, nullptr, Z);
            SEAM(base + 4);
        } else {
            if (IN(base + 0)) phase_rows_pool(xin, MIX);
            if (IN(base + 0) && IN(base + 4)) xcd_barrier(bar);
            if (IN(base + 4)) phase_mixproj(shm, MIX, Wt_pool + (size_t)i2 * 4 * 65536, true, xin, p.in[I_PSCALE] + i2 * 1024, Z);
            SEAM(base + 4);
        }
        if (IN(base + 5)) phase_rows_ln1(ldsf, (LAS RouteLds*)(lds + 98304), Z, p.in[I_LNG] + (L * 2) * 1024, p.in[I_LNB] + (L * 2) * 1024,
                                         p.in[I_WR], p.in[I_RB], XB, XH, gcnt, slot_tok, tinfo);
        SEAM(base + 5);
        if (IN(base + 6)) phase_moe1(shm, mp, gcnt, slot_tok, XH, Wt_g + (size_t)L * 16 * 1048576, Wt_u + (size_t)L * 16 * 1048576, Hmoe);
        SEAM(base + 6);
        if (IN(base + 7)) phase_moe2(shm, mp, gcnt, Hmoe, Wt_d + (size_t)L * 16 * 1048576, Y);
        SEAM(base + 7);
        if (IN(base + 8)) phase_rows_ln2(ldsf, mp, gcnt, XB, Y, tinfo, p.in[I_LNG] + (L * 2 + 1) * 1024, p.in[I_LNB] + (L * 2 + 1) * 1024, xout, XH,
                                         (L + 1 < NLAYER && ((L + 1) & 1) == 0) ? p.in[I_WIN] + (size_t)((L + 1) >> 1) * 1024 * IN_COLS : nullptr, LR);
        SEAM(base + 8);
    }
#undef IN
#undef SEAM
}

extern "C" void kernel_launch(void* const* d_in, const int* in_sizes, int n_in, void* d_out, int out_size, void* d_ws, size_t ws_size, hipStream_t stream) {
    static int grid = 0;
    if (grid == 0) {
        if (n_in != 18 || ws_size < WS_END) { fprintf(stderr, "kernel_launch: unexpected inputs (n_in %d, ws %zu < %zu)\n", n_in, ws_size, (size_t)WS_END); grid = -1; return; }
        int dev = 0, cus = 0, per_cu = 0;
        hipGetDevice(&dev);
        hipDeviceGetAttribute(&cus, hipDeviceAttributeMultiprocessorCount, dev);
        if (hipFuncSetAttribute((const void*)fwd_kernel, hipFuncAttributeMaxDynamicSharedMemorySize, LDS_BYTES) != hipSuccess) { fprintf(stderr, "kernel_launch: hipFuncSetAttribute failed\n"); grid = -1; return; }
        if (hipOccupancyMaxActiveBlocksPerMultiprocessor(&per_cu, (const void*)fwd_kernel, NTHR, LDS_BYTES) != hipSuccess || per_cu < 1) {
            fprintf(stderr, "kernel_launch: occupancy query reports %d blocks per CU\n", per_cu); }
        (void)hipGetLastError();
        grid = cus;
    }
    if (grid < 0) return;
    hipMemsetAsync((char*)d_ws + WS_CTL, 0, CTL_BYTES, stream);
    Params p{};
    for (int i = 0; i < 18; ++i) p.in[i] = (const float*)d_in[i];
    p.out = (float*)d_out; p.ws = (unsigned char*)d_ws;
#if ONE_LAUNCH
    p.ph_lo = 0; p.ph_hi = NPHASE;
    hipLaunchKernelGGL(fwd_kernel, dim3(grid), dim3(NTHR), LDS_BYTES, stream, p);
#else
    for (int k = 0; k < NPHASE; ++k) {
        const int L = (k - 1) / 9, r = (k - 1) % 9;
        if (k > 0 && (L & 1) == 1 && (r == 1 || r == 2 || r == 3)) continue;
        p.ph_lo = k; p.ph_hi = k + 1;
        hipLaunchKernelGGL(fwd_kernel, dim3(grid), dim3(NTHR), LDS_BYTES, stream, p);
    }
#endif
}
```

```cpp
#include <hip/hip_runtime.h>
#include <stdint.h>
#include <stdio.h>

typedef unsigned short u16;
typedef unsigned int u32;
typedef __attribute__((ext_vector_type(8))) short bf16x8;
typedef __attribute__((ext_vector_type(4))) float f32x4;
typedef __attribute__((ext_vector_type(16))) float f32x16;
#define LAS __attribute__((address_space(3)))

#ifndef ONE_LAUNCH
#define ONE_LAUNCH 1
#endif
#ifndef REPMASK
#define REPMASK 0
#endif
#define REPS(kind) (1 + ((REPMASK >> (kind)) & 1))
#define REPEAT(kind) for (int rep_ = 0; rep_ < REPS(kind); ++rep_, __syncthreads())
enum { K_CONV = 0, K_INPROJ, K_ATTN, K_G1, K_G3, K_MIXPROJ, K_MOE1, K_MOE2, K_LN2, K_POOL, K_ROWSP };

constexpr int TOK = 16384, DM = 1024, SEQ = 2048, NBATCH = 8, NLAYER = 4;
constexpr int HC = 2560;
constexpr int NEXP = 16;
constexpr int IN_COLS = 3104;
constexpr float ALPHA = 1.681792830507429f;
constexpr float LN_EPS = 1e-5f, RMS_EPS = 1e-6f;
constexpr int NTHR = 512;
constexpr int LDS_BYTES = 163840 - 256;
constexpr int LDS_BARW = LDS_BYTES - 16;
constexpr int LDS_MOEMAP = LDS_BARW - 256;

constexpr size_t WS_CTL   = 0;
constexpr size_t CTL_BYTES = 65536;
constexpr size_t CTL_CNT  = 16384;
constexpr size_t WS_WIN   = WS_CTL + CTL_BYTES;
constexpr size_t WS_WOUT  = WS_WIN + (size_t)2 * 3072 * 1024 * 2;
constexpr size_t WS_WPOOL = WS_WOUT + (size_t)2 * 1024 * 1024 * 2;
constexpr size_t WS_WG    = WS_WPOOL + (size_t)2 * 4 * 256 * 256 * 2;
constexpr size_t WS_WU    = WS_WG + (size_t)64 * 1048576 * 2;
constexpr size_t WS_WD    = WS_WU + (size_t)64 * 1048576 * 2;
constexpr size_t WS_XA    = WS_WD + (size_t)64 * 1048576 * 2;
constexpr size_t WS_XB    = WS_XA + (size_t)TOK * DM * 4;
constexpr size_t WS_XH    = WS_XB + (size_t)TOK * DM * 4;
constexpr size_t WS_MIXIN = WS_XH + (size_t)TOK * DM * 2;
constexpr size_t WS_LR    = WS_MIXIN + (size_t)TOK * DM * 2;
constexpr size_t WS_VT    = WS_LR + (size_t)TOK * 32 * 4;
constexpr size_t WS_GVT   = WS_VT + (size_t)TOK * 512 * 2;
constexpr size_t WS_R1    = WS_GVT + (size_t)TOK * 512 * 2;
constexpr size_t R1_BYTES = (size_t)TOK * HC * 2;
constexpr size_t WS_R2    = WS_R1 + R1_BYTES;
constexpr size_t R2_BYTES = (size_t)96 * 1048576;
constexpr size_t R2_PS    = (size_t)64 * 1048576;
constexpr size_t WS_SLOT  = WS_R2 + R2_BYTES;
constexpr size_t WS_TINFO = WS_SLOT + (size_t)16 * 16384 * 4;
constexpr size_t WS_DEC   = WS_TINFO + (size_t)TOK * 32;
constexpr size_t WS_END   = WS_DEC + (size_t)1024 * 2 * 64 * 4;

typedef __attribute__((ext_vector_type(2))) __bf16 bf16x2_t;
__device__ __forceinline__ u16 f2bf(float f) { return __builtin_bit_cast(u16, (__bf16)f); }
__device__ __forceinline__ float bf2f(u16 h) { return __uint_as_float(((u32)h) << 16); }
__device__ __forceinline__ u32 pack2(float a, float b) { bf16x2_t v; v[0] = (__bf16)a; v[1] = (__bf16)b; return __builtin_bit_cast(u32, v); }
__device__ __forceinline__ float wave_sum(float v) {
#pragma unroll
    for (int o = 32; o > 0; o >>= 1) v += __shfl_xor(v, o);
    return v;
}
__device__ __forceinline__ int otid() { int t = threadIdx.x; asm volatile("" : "+v"(t)); return t; }
__device__ __forceinline__ float sigmoidf_(float x) { return 1.f / (1.f + __expf(-x)); }

#define XB_TMO      128
#define XB_XCNT(j)  (256  + 64 * (j))
#define XB_XSUB(j)  (1280 + 64 * (j))
#define XB_XGEN(j)  (2304 + 64 * (j))
#define XB_TOP      3328
#define XB_TOPGEN   3392
#define XCD_BAR_WORDS 3456
#define XB_SPIN_CAP (1u << 20)
__device__ __forceinline__ unsigned xb_ld(unsigned* p)              { return __hip_atomic_load(p, __ATOMIC_RELAXED, __HIP_MEMORY_SCOPE_AGENT); }
__device__ __forceinline__ unsigned xb_add(unsigned* p, unsigned v) { return __hip_atomic_fetch_add(p, v, __ATOMIC_RELAXED, __HIP_MEMORY_SCOPE_AGENT); }
__device__ __forceinline__ unsigned xb_xcc_id() { return (unsigned)__builtin_amdgcn_s_getreg((3 << 11) | 20) & 0xFu; }
#define XB_SPIN(cond, bar) do { unsigned _sp = 0; while (cond) { __builtin_amdgcn_s_sleep(1); \
    if ((++_sp & 255u) == 0u) { if (xb_ld(&(bar)[XB_TMO])) break; if (_sp > XB_SPIN_CAP) { atomicAdd(&(bar)[XB_TMO], 1u); break; } } } } while (0)
struct XcdBarrier { unsigned* bar; unsigned x; volatile LAS unsigned* st; };
__device__ __forceinline__ XcdBarrier xcd_barrier_post(unsigned* bar, volatile LAS unsigned* st) {
    XcdBarrier b; b.bar = bar; b.x = xb_xcc_id(); b.st = st;
    if (threadIdx.x == 0) (void)xb_add(&bar[XB_XCNT(b.x)], 1u);
    return b;
}
__device__ __forceinline__ void xcd_barrier_complete(unsigned* bar, unsigned x, unsigned& nloc, unsigned& nx) {
    const unsigned G = gridDim.x * gridDim.y * gridDim.z;
    unsigned sum, cnt, mine, sp = 0u;
    for (;;) {
        sum = 0u; cnt = 0u; mine = 0u;
#pragma unroll
        for (unsigned j = 0; j < 16; ++j) { const unsigned c = xb_ld(&bar[XB_XCNT(j)]); sum += c; cnt += (c > 0u) ? 1u : 0u; mine = (j == x) ? c : mine; }
        if (sum == G) break;
        __builtin_amdgcn_s_sleep(1);
        if ((++sp & 255u) == 0u) { if (xb_ld(&bar[XB_TMO])) break; if (sp > XB_SPIN_CAP) { atomicAdd(&bar[XB_TMO], 1u); break; } }
    }
    nloc = mine > 0u ? mine : 1u; nx = cnt > 0u ? cnt : 1u;
}
__device__ __forceinline__ void xcd_barrier(const XcdBarrier& b) {
    asm volatile("s_waitcnt vmcnt(0)" ::: "memory");
    __syncthreads();
    if (threadIdx.x == 0) {
        unsigned* bar = b.bar;
        __builtin_amdgcn_s_waitcnt(0);
        unsigned nloc = b.st[0], nx = b.st[1];
        if (nloc == 0u) { xcd_barrier_complete(bar, b.x, nloc, nx); b.st[0] = nloc; b.st[1] = nx; }
        const unsigned old = xb_add(&bar[XB_XSUB(b.x)], 1u);
        const unsigned gen = old / nloc;
        if (old + 1u == (gen + 1u) * nloc) {
            __builtin_amdgcn_fence(__ATOMIC_RELEASE, "agent");
            asm volatile("s_waitcnt vmcnt(0)" ::: "memory");
            const unsigned og = xb_add(&bar[XB_TOP], 1u);
            const unsigned tg = og / nx;
            if (og + 1u == (tg + 1u) * nx) xb_add(&bar[XB_TOPGEN], 1u);
            else XB_SPIN(xb_ld(&bar[XB_TOPGEN]) == tg, bar);
            __builtin_amdgcn_fence(__ATOMIC_ACQUIRE, "agent");
            xb_add(&bar[XB_XGEN(b.x)], 1u);
            asm volatile("s_waitcnt vmcnt(0)" ::: "memory");
        } else {
            XB_SPIN(xb_ld(&bar[XB_XGEN(b.x)]) == gen, bar);
            __builtin_amdgcn_fence(__ATOMIC_ACQUIRE, "agent");
            asm volatile("s_waitcnt vmcnt(0)" ::: "memory");
        }
    }
    __syncthreads();
}

struct Params {
    const float* in[18];
    float* out;
    unsigned char* ws;
    int ph_lo, ph_hi;
};
enum { I_X = 0, I_RELB, I_WIN, I_WGG, I_BGG, I_GNORM, I_DLAM, I_DNORM, I_WOUT, I_WPOOL, I_PSCALE, I_LNG, I_LNB, I_WR, I_RB, I_WG, I_WU, I_WD };

constexpr int BK = 64, HALF = 128, HT = HALF * BK;
__device__ __forceinline__ int lds_byte(int r, int c) {
    int st = (r >> 4) * 2 + (c >> 5), rr = r & 15, cc = c & 31, ob = rr * 64 + cc * 2;
    return st * 1024 + (ob ^ (((ob >> 9) & 1) << 5));
}
__device__ __forceinline__ void stage_rc(int b, int& R, int& C) {
    int st = b / 1024, sb = b % 1024, swz = sb ^ (((sb >> 9) & 1) << 5);
    R = (st >> 1) * 16 + swz / 64; C = (st & 1) * 32 + (swz % 64) / 2;
}

#define WAIT_V(n) asm volatile("s_waitcnt vmcnt(" #n ")" ::: "memory")
#define WAIT_L(n) asm volatile("s_waitcnt lgkmcnt(" #n ")" ::: "memory")
#define BAR __builtin_amdgcn_s_barrier()
#define SCHED __builtin_amdgcn_sched_barrier(0)

template <bool SWAP, bool GATHER>
__device__ __forceinline__ void gemm_core(u16* shm, const u16* __restrict__ A, const int (&aq)[4], int lda64,
                                          const u16* __restrict__ B0p, const u16* __restrict__ B1p, int bo, int ldb64,
                                          int nt, f32x4 (&acc)[2][2][4][2]) {
#define SA(b, h) (shm + ((b) * 2 + (h)) * HT)
#define SB(b, h) (shm + (4 + (b) * 2 + (h)) * HT)
#define GLDS(src, dst) __builtin_amdgcn_global_load_lds((const unsigned*)(src), (unsigned*)(dst), 16, 0, 0)
#define AOFF(q) (GATHER ? aq[q] : aq[0] + (q) * lda64)
#define GLDS_O(base, off, dst) do { int _o = (off); asm volatile("" : "+v"(_o)); GLDS((base) + _o, dst); } while (0)
#define STAGE_A(P, h, kt) do { const u16* _s = A + (kt) * BK; char* _d = (char*)(P) + tz * 16; \
        GLDS_O(_s, AOFF(2 * (h)), _d); GLDS_O(_s, AOFF(2 * (h) + 1), _d + 8192); } while (0)
#define STAGE_B(P, h, kt) do { const u16* _s = ((h) ? B1p : B0p) + (kt) * BK; char* _d = (char*)(P) + tz * 16; \
        GLDS_O(_s, bo, _d); GLDS_O(_s, bo + ldb64, _d + 8192); } while (0)
#define LDA(dst, b, h) _Pragma("unroll") for (int m = 0; m < 4; ++m) _Pragma("unroll") for (int k = 0; k < 2; ++k) \
        dst[m][k] = *reinterpret_cast<const bf16x8*>((char*)SA(b, h) + lds_byte(wr * 64 + m * 16 + fr, k * 32 + fq * 8))
#define LDB(dst, b, h) _Pragma("unroll") for (int n = 0; n < 2; ++n) _Pragma("unroll") for (int k = 0; k < 2; ++k) \
        dst[n][k] = *reinterpret_cast<const bf16x8*>((char*)SB(b, h) + lds_byte(wc * 32 + n * 16 + fr, k * 32 + fq * 8))
#define MMA(ai, bj, At, Bt) do { __builtin_amdgcn_s_setprio(1); \
        _Pragma("unroll") for (int m = 0; m < 4; ++m) _Pragma("unroll") for (int n = 0; n < 2; ++n) _Pragma("unroll") for (int k = 0; k < 2; ++k) \
            acc[ai][bj][m][n] = SWAP ? __builtin_amdgcn_mfma_f32_16x16x32_bf16(Bt[n][k], At[m][k], acc[ai][bj][m][n], 0, 0, 0) \
                                     : __builtin_amdgcn_mfma_f32_16x16x32_bf16(At[m][k], Bt[n][k], acc[ai][bj][m][n], 0, 0, 0); \
        __builtin_amdgcn_s_setprio(0); } while (0)
    int tz = otid();
    int wid = tz >> 6, lane = tz & 63, wr = wid >> 2, wc = wid & 3, fr = lane & 15, fq = lane >> 4;
    bf16x8 At[4][2], B0[2][2], B1[2][2];
    STAGE_B(SB(0, 0), 0, 0); STAGE_A(SA(0, 0), 0, 0);
    STAGE_B(SB(0, 1), 1, 0); STAGE_A(SA(0, 1), 1, 0);
    if (wr == 1) BAR;
    WAIT_V(4); BAR;
    STAGE_B(SB(1, 0), 0, 1); STAGE_A(SA(1, 0), 0, 1); STAGE_B(SB(1, 1), 1, 1);
    WAIT_V(6); BAR;
    for (int t = 0; t < nt - 2; t += 2) {
        LDB(B0, 0, 0); SCHED; LDA(At, 0, 0); STAGE_A(SA(1, 1), 1, t + 1);
        WAIT_L(8); BAR; WAIT_L(0); MMA(0, 0, At, B0); BAR; SCHED;
        LDB(B1, 0, 1); STAGE_B(SB(0, 0), 0, t + 2);
        BAR; WAIT_L(0); MMA(0, 1, At, B1); BAR;
        LDA(At, 0, 1); STAGE_A(SA(0, 0), 0, t + 2);
        BAR; WAIT_L(0); MMA(1, 0, At, B0); BAR; SCHED;
        STAGE_B(SB(0, 1), 1, t + 2);
        WAIT_V(6); BAR; MMA(1, 1, At, B1); BAR;
        LDB(B0, 1, 0); SCHED; LDA(At, 1, 0); STAGE_A(SA(0, 1), 1, t + 2);
        WAIT_L(8); BAR; WAIT_L(0); MMA(0, 0, At, B0); BAR; SCHED;
        LDB(B1, 1, 1); STAGE_B(SB(1, 0), 0, t + 3);
        BAR; WAIT_L(0); MMA(0, 1, At, B1); BAR;
        LDA(At, 1, 1); STAGE_A(SA(1, 0), 0, t + 3);
        BAR; WAIT_L(0); MMA(1, 0, At, B0); BAR; SCHED;
        STAGE_B(SB(1, 1), 1, t + 3);
        WAIT_V(6); BAR; MMA(1, 1, At, B1); BAR;
    }
    asm volatile("" : "+v"(tz)); wid = tz >> 6; lane = tz & 63; wr = wid >> 2; wc = wid & 3; fr = lane & 15; fq = lane >> 4;
    { LDB(B0, 0, 0); WAIT_V(0); LDA(At, 0, 0); STAGE_A(SA(1, 1), 1, nt - 1);
      BAR; WAIT_L(0); MMA(0, 0, At, B0); BAR;
      LDB(B1, 0, 1); BAR; WAIT_L(0); MMA(0, 1, At, B1); BAR;
      LDA(At, 0, 1); WAIT_V(4); BAR; WAIT_L(0); MMA(1, 0, At, B0); MMA(1, 1, At, B1); BAR; }
    { LDB(B0, 1, 0); LDA(At, 1, 0); WAIT_V(2); BAR; WAIT_L(0); MMA(0, 0, At, B0); BAR;
      LDB(B1, 1, 1); WAIT_V(0); BAR; WAIT_L(0); MMA(0, 1, At, B1); BAR;
      LDA(At, 1, 1); BAR; WAIT_L(0); MMA(1, 0, At, B0); MMA(1, 1, At, B1); BAR; }
    if (wr == 0) BAR;
#undef SA
#undef SB
#undef STAGE_A
#undef GLDS_O
#undef AOFF
#undef STAGE_B
#undef LDA
#undef LDB
#undef MMA
}

__device__ __forceinline__ void stage_geom(int& R0, int& C0) { stage_rc(otid() * 16, R0, C0); }

#define ACC_ZERO(acc) do { _Pragma("unroll") for (int a_ = 0; a_ < 2; ++a_) _Pragma("unroll") for (int b_ = 0; b_ < 2; ++b_) _Pragma("unroll") for (int m_ = 0; m_ < 4; ++m_) _Pragma("unroll") for (int n_ = 0; n_ < 2; ++n_) \
        acc[a_][b_][m_][n_] = f32x4{0.f, 0.f, 0.f, 0.f}; } while (0)

__device__ __forceinline__ void phase_inproj(u16* shm, const u16* __restrict__ XH, const u16* __restrict__ Wt, u16* __restrict__ Hb, u16* __restrict__ Vt, u16* __restrict__ GVt) {
    const int nunits = 64 * 12;
    for (int u = blockIdx.x; u < nunits; u += gridDim.x) {
        const int pm = u & 63, pn = u >> 6;
        const int brow = pm * 256, bcol = pn * 256;
        int R0, C0; stage_geom(R0, C0);
        const int aq[4] = {(brow + R0) * DM + C0, 0, 0, 0};
        const u16* B0p = Wt + (size_t)bcol * DM;
        const int bo = R0 * DM + C0;
        f32x4 acc[2][2][4][2]; ACC_ZERO(acc);
        const bool vtile = (pn == 2) | (pn == 3) | (pn >= 10);
        if (!vtile) {
            gemm_core<true, false>(shm, XH, aq, 64 * DM, B0p, B0p + (size_t)128 * DM, bo, 64 * DM, DM / BK, acc);
            int tz = otid();
            const int wid = tz >> 6, lane = tz & 63, wr = wid >> 2, wc = wid & 3, fr = lane & 15, fq = lane >> 4;
            _Pragma("unroll") for (int ai = 0; ai < 2; ++ai) _Pragma("unroll") for (int bj = 0; bj < 2; ++bj) _Pragma("unroll") for (int m = 0; m < 4; ++m) _Pragma("unroll") for (int n = 0; n < 2; ++n) {
                const int row = brow + ai * 128 + wr * 64 + m * 16 + fr;
                const int col = bcol + bj * 128 + wc * 32 + n * 16 + fq * 4;
                uint2 v; v.x = pack2(acc[ai][bj][m][n][0], acc[ai][bj][m][n][1]); v.y = pack2(acc[ai][bj][m][n][2], acc[ai][bj][m][n][3]);
                *reinterpret_cast<uint2*>(Hb + (size_t)row * HC + col) = v;
            }
        } else {
            gemm_core<false, false>(shm, XH, aq, 64 * DM, B0p, B0p + (size_t)128 * DM, bo, 64 * DM, DM / BK, acc);
            int tz = otid();
            const int wid = tz >> 6, lane = tz & 63, wr = wid >> 2, wc = wid & 3, fr = lane & 15, fq = lane >> 4;
            _Pragma("unroll") for (int ai = 0; ai < 2; ++ai) _Pragma("unroll") for (int bj = 0; bj < 2; ++bj) _Pragma("unroll") for (int m = 0; m < 4; ++m) _Pragma("unroll") for (int n = 0; n < 2; ++n) {
                const int row = brow + ai * 128 + wr * 64 + m * 16 + fq * 4;
                const int col = (pn & 1) * 256 + bj * 128 + wc * 32 + n * 16 + fr;
                const int b = row >> 11, s = row & 2047, hd = col >> 7, dv = col & 127;
                uint2 v; v.x = pack2(acc[ai][bj][m][n][0], acc[ai][bj][m][n][1]); v.y = pack2(acc[ai][bj][m][n][2], acc[ai][bj][m][n][3]);
                *reinterpret_cast<uint2*>((pn >= 10 ? Vt : GVt) + ((size_t)((b * 4 + hd) * 128 + dv)) * SEQ + s) = v;
            }
        }
    }
}

__device__ __forceinline__ void phase_mixproj(u16* shm, const u16* __restrict__ MIX, const u16* __restrict__ Wt, bool pool,
                              const float* __restrict__ xin, const float* __restrict__ scale, float* __restrict__ Z) {
    const int nunits = 64 * 4;
    for (int u = blockIdx.x; u < nunits; u += gridDim.x) {
        const int pm = u & 63, pn = u >> 6;
        const int brow = pm * 256, bcol = pn * 256;
        int R0, C0; stage_geom(R0, C0);
        const int ldb = pool ? 256 : 1024;
        const int aq[4] = {(brow + R0) * DM + C0 + (pool ? pn * 256 : 0), 0, 0, 0};
        const u16* B0p = pool ? (Wt + (size_t)pn * 65536) : (Wt + (size_t)bcol * DM);
        const int bo = R0 * ldb + C0;
        f32x4 acc[2][2][4][2]; ACC_ZERO(acc);
        gemm_core<true, false>(shm, MIX, aq, 64 * DM, B0p, B0p + (size_t)128 * ldb, bo, 64 * ldb, ldb / BK, acc);
        int tz = otid();
        const int wid = tz >> 6, lane = tz & 63, wr = wid >> 2, wc = wid & 3, fr = lane & 15, fq = lane >> 4;
        _Pragma("unroll") for (int ai = 0; ai < 2; ++ai) _Pragma("unroll") for (int bj = 0; bj < 2; ++bj) _Pragma("unroll") for (int m = 0; m < 4; ++m) _Pragma("unroll") for (int n = 0; n < 2; ++n) {
            const int row = brow + ai * 128 + wr * 64 + m * 16 + fr;
            const int col = bcol + bj * 128 + wc * 32 + n * 16 + fq * 4;
            const float4 xv = *reinterpret_cast<const float4*>(xin + (size_t)row * DM + col);
            float4 sc = make_float4(1.f, 1.f, 1.f, 1.f);
            if (pool) sc = *reinterpret_cast<const float4*>(scale + col);
            float4 o;
            o.x = ALPHA * xv.x + acc[ai][bj][m][n][0] * sc.x; o.y = ALPHA * xv.y + acc[ai][bj][m][n][1] * sc.y;
            o.z = ALPHA * xv.z + acc[ai][bj][m][n][2] * sc.z; o.w = ALPHA * xv.w + acc[ai][bj][m][n][3] * sc.w;
            *reinterpret_cast<float4*>(Z + (size_t)row * DM + col) = o;
        }
    }
}

struct MoeMap { int toff[17]; int cnt[16]; };
__device__ __forceinline__ void moe_build_map(LAS MoeMap* mp, const u32* __restrict__ gcnt) {
    if (otid() == 0) {
        int o = 0;
        for (int e = 0; e < 16; ++e) { int c = (int)__hip_atomic_load(gcnt + e, __ATOMIC_RELAXED, __HIP_MEMORY_SCOPE_AGENT); mp->cnt[e] = c; mp->toff[e] = o; o += (c + 255) >> 8; }
        mp->toff[16] = o;
    }
    __syncthreads();
}

__device__ __forceinline__ void phase_moe1(u16* shm, LAS MoeMap* mp, const u32* __restrict__ gcnt, const int* __restrict__ slot_tok, const u16* __restrict__ XH,
                           const u16* __restrict__ Wg, const u16* __restrict__ Wu, u16* __restrict__ Hout) {
    moe_build_map(mp, gcnt);
    const int RT = mp->toff[16];
    const int nunits = RT * 8;
    for (int u = blockIdx.x; u < nunits; u += gridDim.x) {
        const int rt = u >> 3, ft = u & 7;
        int e = 0;
        for (int i = 1; i < 16; ++i) e += (rt >= mp->toff[i]) ? 1 : 0;
        const int pos0 = (rt - mp->toff[e]) * 256, ne = mp->cnt[e];
        int R0, C0; stage_geom(R0, C0);
        int aq[4];
#pragma unroll
        for (int q = 0; q < 4; ++q) {
            const int p = pos0 + q * 64 + R0;
            const int tok = (p < ne) ? slot_tok[e * 16384 + p] : 0;
            aq[q] = tok * DM + C0;
        }
        const u16* B0p = Wg + ((size_t)e * 1024 + ft * 128) * DM;
        const u16* B1p = Wu + ((size_t)e * 1024 + ft * 128) * DM;
        const int bo = R0 * DM + C0;
        f32x4 acc[2][2][4][2]; ACC_ZERO(acc);
        gemm_core<true, true>(shm, XH, aq, 0, B0p, B1p, bo, 64 * DM, DM / BK, acc);
        int tz = otid();
        const int wid = tz >> 6, lane = tz & 63, wr = wid >> 2, wc = wid & 3, fr = lane & 15, fq = lane >> 4;
        _Pragma("unroll") for (int ai = 0; ai < 2; ++ai) _Pragma("unroll") for (int m = 0; m < 4; ++m) _Pragma("unroll") for (int n = 0; n < 2; ++n) {
            const int row = rt * 256 + ai * 128 + wr * 64 + m * 16 + fr;
            const int col = ft * 128 + wc * 32 + n * 16 + fq * 4;
            float hv[4];
#pragma unroll
            for (int j = 0; j < 4; ++j) { const float g = acc[ai][0][m][n][j], uu = acc[ai][1][m][n][j]; hv[j] = g * sigmoidf_(g) * uu; }
            uint2 v; v.x = pack2(hv[0], hv[1]); v.y = pack2(hv[2], hv[3]);
            *reinterpret_cast<uint2*>(Hout + (size_t)row * 1024 + col) = v;
        }
    }
}

__device__ __forceinline__ void phase_moe2(u16* shm, LAS MoeMap* mp, const u32* __restrict__ gcnt, const u16* __restrict__ Hin, const u16* __restrict__ Wd, u16* __restrict__ Y) {
    moe_build_map(mp, gcnt);
    const int RT = mp->toff[16];
    const int nunits = RT * 4;
    for (int u = blockIdx.x; u < nunits; u += gridDim.x) {
        const int rt = u >> 2, pn = u & 3;
        int e = 0;
        for (int i = 1; i < 16; ++i) e += (rt >= mp->toff[i]) ? 1 : 0;
        int R0, C0; stage_geom(R0, C0);
        const int aq[4] = {(rt * 256 + R0) * 1024 + C0, 0, 0, 0};
        const u16* B0p = Wd + ((size_t)e * 1024 + pn * 256) * 1024;
        const int bo = R0 * 1024 + C0;
        f32x4 acc[2][2][4][2]; ACC_ZERO(acc);
        gemm_core<true, false>(shm, Hin, aq, 64 * 1024, B0p, B0p + (size_t)128 * 1024, bo, 64 * 1024, 1024 / BK, acc);
        int tz = otid();
        const int wid = tz >> 6, lane = tz & 63, wr = wid >> 2, wc = wid & 3, fr = lane & 15, fq = lane >> 4;
        _Pragma("unroll") for (int ai = 0; ai < 2; ++ai) _Pragma("unroll") for (int bj = 0; bj < 2; ++bj) _Pragma("unroll") for (int m = 0; m < 4; ++m) _Pragma("unroll") for (int n = 0; n < 2; ++n) {
            const int row = rt * 256 + ai * 128 + wr * 64 + m * 16 + fr;
            const int col = pn * 256 + bj * 128 + wc * 32 + n * 16 + fq * 4;
            uint2 v; v.x = pack2(acc[ai][bj][m][n][0], acc[ai][bj][m][n][1]); v.y = pack2(acc[ai][bj][m][n][2], acc[ai][bj][m][n][3]);
            *reinterpret_cast<uint2*>(Y + (size_t)row * 1024 + col) = v;
        }
    }
}

__device__ __forceinline__ void conv_tile(float* sT, const float* __restrict__ src, int ld, int k0, int n0src, u16* __restrict__ dst, int K, int n0dst) {
    const int tid = otid();
    { const int r = tid >> 4, c4 = (tid & 15) * 4;
      const float4 a = *reinterpret_cast<const float4*>(src + (size_t)(k0 + r) * ld + n0src + c4);
      const float4 b = *reinterpret_cast<const float4*>(src + (size_t)(k0 + r + 32) * ld + n0src + c4);
      float* p = sT + r * 65 + c4; p[0] = a.x; p[1] = a.y; p[2] = a.z; p[3] = a.w;
      p = sT + (r + 32) * 65 + c4; p[0] = b.x; p[1] = b.y; p[2] = b.z; p[3] = b.w; }
    __syncthreads();
    { const int n = tid >> 3, k8 = (tid & 7) * 8;
      float v[8];
      for (int j = 0; j < 8; ++j) v[j] = sT[(k8 + j) * 65 + n];
      uint4 o; o.x = pack2(v[0], v[1]); o.y = pack2(v[2], v[3]); o.z = pack2(v[4], v[5]); o.w = pack2(v[6], v[7]);
      *reinterpret_cast<uint4*>(dst + (size_t)(n0dst + n) * K + k0 + k8) = o; }
    __syncthreads();
}
__device__ __forceinline__ void phase_convert(float* sT, const Params& p) {
    unsigned char* ws = p.ws;
    const int total = 2176 + 49152;
    for (int t = blockIdx.x; t < total; t += gridDim.x) {
        if (t < 1536) {
            const int i = t / 768, r = t % 768, kt = r / 48, ntl = r % 48;
            const int n0 = ntl * 64, n0src = n0 + (n0 >= 1536 ? 32 : 0);
            conv_tile(sT, p.in[I_WIN] + (size_t)i * 1024 * IN_COLS, IN_COLS, kt * 64, n0src, (u16*)(ws + WS_WIN) + (size_t)i * 3072 * 1024, 1024, n0);
        } else if (t < 2048) {
            const int q = t - 1536, i = q >> 8, r = q & 255, kt = r >> 4, ntl = r & 15;
            conv_tile(sT, p.in[I_WOUT] + (size_t)i * 1048576, 1024, kt * 64, ntl * 64, (u16*)(ws + WS_WOUT) + (size_t)i * 1048576, 1024, ntl * 64);
        } else if (t < 2176) {
            const int q = t - 2048, mtx = q >> 4, r = q & 15, kt = r >> 2, ntl = r & 3;
            conv_tile(sT, p.in[I_WPOOL] + (size_t)mtx * 65536, 256, kt * 64, ntl * 64, (u16*)(ws + WS_WPOOL) + (size_t)mtx * 65536, 256, ntl * 64);
        } else {
            const int q = t - 2176, which = q / 16384, r = q % 16384, mtx = r >> 8, tt = r & 255, kt = tt >> 4, ntl = tt & 15;
            const float* src = p.in[I_WG + which] + (size_t)mtx * 1048576;
            u16* dst = (u16*)(ws + (which == 0 ? WS_WG : (which == 1 ? WS_WU : WS_WD))) + (size_t)mtx * 1048576;
            conv_tile(sT, src, 1024, kt * 64, ntl * 64, dst, 1024, ntl * 64);
        }
    }
}

__device__ __forceinline__ int rho_of_k(int k) { return ((k >> 2) & 63) + 64 * ((k & 3) + 4 * (k >> 8)); }
template <int NO>
__device__ __forceinline__ void load_skinny(float* sW, const float* __restrict__ W, int ld, int c0) {
    for (int idx = otid(); idx < 1024 * (NO / 4); idx += NTHR) {
        const int k = idx / (NO / 4), c4 = (idx % (NO / 4)) * 4;
        const float4 v = *reinterpret_cast<const float4*>(W + (size_t)k * ld + c0 + c4);
        *reinterpret_cast<float4*>(sW + rho_of_k(k) * (NO + 4) + c4) = v;
    }
}
template <int NO>
__device__ __forceinline__ void skinny_dot(const float* sW, const float (&xv)[16], float (&o)[NO]) {
    const int lane = otid() & 63;
#pragma unroll
    for (int e = 0; e < NO; ++e) o[e] = 0.f;
#pragma unroll
    for (int i = 0; i < 4; ++i)
#pragma unroll
        for (int jj = 0; jj < 4; ++jj) {
            const float x = xv[i * 4 + jj];
            const float* wrow = sW + (lane + 64 * (jj + 4 * i)) * (NO + 4);
#pragma unroll
            for (int e4 = 0; e4 < NO; e4 += 4) {
                const float4 w = *reinterpret_cast<const float4*>(wrow + e4);
                o[e4] += x * w.x; o[e4 + 1] += x * w.y; o[e4 + 2] += x * w.z; o[e4 + 3] += x * w.w;
            }
            __builtin_amdgcn_sched_barrier(0);
        }
#pragma unroll
    for (int e = 0; e < NO; ++e) o[e] = wave_sum(o[e]);
}
__device__ __forceinline__ void store_row_bf16(u16* __restrict__ dst, const float (&v)[16], int lane) {
#pragma unroll
    for (int i = 0; i < 4; ++i) {
        uint2 o; o.x = pack2(v[i * 4], v[i * 4 + 1]); o.y = pack2(v[i * 4 + 2], v[i * 4 + 3]);
        *reinterpret_cast<uint2*>(dst + i * 256 + lane * 4) = o;
    }
}
__device__ __forceinline__ void store_row_f32(float* __restrict__ dst, const float (&v)[16], int lane) {
#pragma unroll
    for (int i = 0; i < 4; ++i) *reinterpret_cast<float4*>(dst + i * 256 + lane * 4) = make_float4(v[i * 4], v[i * 4 + 1], v[i * 4 + 2], v[i * 4 + 3]);
}
__device__ __forceinline__ void load_row_f32(const float* __restrict__ src, float (&v)[16], int lane) {
#pragma unroll
    for (int i = 0; i < 4; ++i) { const float4 t = *reinterpret_cast<const float4*>(src + i * 256 + lane * 4); v[i * 4] = t.x; v[i * 4 + 1] = t.y; v[i * 4 + 2] = t.z; v[i * 4 + 3] = t.w; }
}
__device__ __forceinline__ void layer_norm_row(float (&v)[16], const float* __restrict__ g, const float* __restrict__ b, int lane) {
    float s = 0.f;
#pragma unroll
    for (int i = 0; i < 16; ++i) s += v[i];
    const float mu = wave_sum(s) * (1.f / 1024.f);
    float q = 0.f;
#pragma unroll
    for (int i = 0; i < 16; ++i) { const float d = v[i] - mu; q += d * d; }
    const float rs = rsqrtf(wave_sum(q) * (1.f / 1024.f) + LN_EPS);
#pragma unroll
    for (int i = 0; i < 4; ++i) {
        const float4 gg = *reinterpret_cast<const float4*>(g + i * 256 + lane * 4);
        const float4 bb = *reinterpret_cast<const float4*>(b + i * 256 + lane * 4);
        v[i * 4] = (v[i * 4] - mu) * rs * gg.x + bb.x; v[i * 4 + 1] = (v[i * 4 + 1] - mu) * rs * gg.y + bb.y;
        v[i * 4 + 2] = (v[i * 4 + 2] - mu) * rs * gg.z + bb.z; v[i * 4 + 3] = (v[i * 4 + 3] - mu) * rs * gg.w + bb.w;
    }
}

__device__ __forceinline__ void phase_rows_prologue(float* sW, const float* __restrict__ x, const float* __restrict__ w_in0, u16* __restrict__ XH, float* __restrict__ LR) {
    load_skinny<32>(sW, w_in0, IN_COLS, 1536);
    __syncthreads();
    const int tid_ = otid(); const int lane = tid_ & 63, wave = tid_ >> 6;
    for (int row = blockIdx.x * 8 + wave; row < TOK; row += gridDim.x * 8) {
        float v[16]; load_row_f32(x + (size_t)row * DM, v, lane);
        store_row_bf16(XH + (size_t)row * DM, v, lane);
        float o[32]; skinny_dot<32>(sW, v, o);
        if (lane < 32) { float r = 0.f;
#pragma unroll
            for (int e = 0; e < 32; ++e) r = (lane == e) ? o[e] : r;
            LR[(size_t)row * 32 + lane] = r; }
    }
}

struct RouteLds { int e0[64], e1[64], lp0[64], lp1[64]; float w0[64], w1[64]; int cnt[16], base[16]; };
__device__ __forceinline__ void phase_rows_ln1(float* sW, LAS RouteLds* rl, const float* __restrict__ Z, const float* __restrict__ g, const float* __restrict__ b,
                               const float* __restrict__ w_router, const float* __restrict__ rbias,
                               float* __restrict__ X1, u16* __restrict__ XH, u32* __restrict__ gcnt, int* __restrict__ slot_tok, int* __restrict__ tinfo) {
    load_skinny<16>(sW, w_router, 16, 0);
    __syncthreads();
    const int tid = otid(); const int lane = tid & 63, wave = tid >> 6;
    for (int blk = blockIdx.x; blk < TOK / 64; blk += gridDim.x) {
        if (tid < 16) rl->cnt[tid] = 0;
        __syncthreads();
        for (int rr = 0; rr < 8; ++rr) {
            const int lr = wave * 8 + rr, row = blk * 64 + lr;
            float v[16]; load_row_f32(Z + (size_t)row * DM, v, lane);
            layer_norm_row(v, g, b, lane);
            store_row_f32(X1 + (size_t)row * DM, v, lane);
            store_row_bf16(XH + (size_t)row * DM, v, lane);
            float o[16]; skinny_dot<16>(sW, v, o);
            float aff[16], sel[16];
#pragma unroll
            for (int e = 0; e < 16; ++e) { aff[e] = 1.f / (1.f + expf(-o[e])); sel[e] = aff[e] + rbias[e]; }
            int bestg = 0; float bests = -1e30f;
#pragma unroll
            for (int gi = 0; gi < 4; ++gi) {
                float m1 = -1e30f, m2 = -1e30f;
#pragma unroll
                for (int j = 0; j < 4; ++j) { const float s = sel[gi * 4 + j]; if (s > m1) { m2 = m1; m1 = s; } else if (s > m2) m2 = s; }
                const float gs = m1 + m2;
                if (gs > bests) { bests = gs; bestg = gi; }
            }
            int i0 = 0, i1 = 0; float s0 = -1e30f, s1 = -1e30f, a0 = 0.f, a1 = 0.f;
#pragma unroll
            for (int e = 0; e < 16; ++e) {
                const bool in = (e >> 2) == bestg;
                const float s = sel[e];
                if (in) { if (s > s0) { s1 = s0; i1 = i0; a1 = a0; s0 = s; i0 = e; a0 = aff[e]; } else if (s > s1) { s1 = s; i1 = e; a1 = aff[e]; } }
            }
            if (lane == 0) { const float inv = 1.f / (a0 + a1); rl->e0[lr] = i0; rl->e1[lr] = i1; rl->w0[lr] = a0 * inv; rl->w1[lr] = a1 * inv; }
        }
        __syncthreads();
        if (tid < 64) { rl->lp0[tid] = atomicAdd((int*)&rl->cnt[rl->e0[tid]], 1); rl->lp1[tid] = atomicAdd((int*)&rl->cnt[rl->e1[tid]], 1); }
        __syncthreads();
        if (tid < 16) rl->base[tid] = (int)atomicAdd(gcnt + tid, (u32)rl->cnt[tid]);
        __syncthreads();
        if (tid < 64) {
            const int row = blk * 64 + tid;
            const int e0 = rl->e0[tid], e1 = rl->e1[tid];
            const int p0 = rl->base[e0] + rl->lp0[tid], p1 = rl->base[e1] + rl->lp1[tid];
            slot_tok[e0 * 16384 + p0] = row; slot_tok[e1 * 16384 + p1] = row;
            int4 a; a.x = e0; a.y = p0; a.z = e1; a.w = p1;
            *reinterpret_cast<int4*>(tinfo + (size_t)row * 8) = a;
            float2 w; w.x = rl->w0[tid]; w.y = rl->w1[tid];
            *reinterpret_cast<float2*>(tinfo + (size_t)row * 8 + 4) = w;
        }
        __syncthreads();
    }
}

__device__ __forceinline__ void phase_rows_ln2(float* sW, LAS MoeMap* mp, const u32* __restrict__ gcnt, const float* __restrict__ X1, const u16* __restrict__ Y, const int* __restrict__ tinfo,
                               const float* __restrict__ g, const float* __restrict__ b, float* __restrict__ X2, u16* __restrict__ XH,
                               const float* __restrict__ w_in_next, float* __restrict__ LR) {
    moe_build_map(mp, gcnt);
    if (w_in_next) { load_skinny<32>(sW, w_in_next, IN_COLS, 1536); __syncthreads(); }
    const int tid_ = otid(); const int lane = tid_ & 63, wave = tid_ >> 6;
    for (int row = blockIdx.x * 8 + wave; row < TOK; row += gridDim.x * 8) {
        const int4 a = *reinterpret_cast<const int4*>(tinfo + (size_t)row * 8);
        const float2 w = *reinterpret_cast<const float2*>(tinfo + (size_t)row * 8 + 4);
        const size_t r0 = (size_t)(mp->toff[a.x] * 256 + a.y), r1 = (size_t)(mp->toff[a.z] * 256 + a.w);
        float v[16]; load_row_f32(X1 + (size_t)row * DM, v, lane);
#pragma unroll
        for (int i = 0; i < 4; ++i) {
            const uint2 y0 = *reinterpret_cast<const uint2*>(Y + r0 * 1024 + i * 256 + lane * 4);
            const uint2 y1 = *reinterpret_cast<const uint2*>(Y + r1 * 1024 + i * 256 + lane * 4);
            v[i * 4 + 0] = ALPHA * v[i * 4 + 0] + w.x * bf2f((u16)(y0.x & 0xffff)) + w.y * bf2f((u16)(y1.x & 0xffff));
            v[i * 4 + 1] = ALPHA * v[i * 4 + 1] + w.x * bf2f((u16)(y0.x >> 16)) + w.y * bf2f((u16)(y1.x >> 16));
            v[i * 4 + 2] = ALPHA * v[i * 4 + 2] + w.x * bf2f((u16)(y0.y & 0xffff)) + w.y * bf2f((u16)(y1.y & 0xffff));
            v[i * 4 + 3] = ALPHA * v[i * 4 + 3] + w.x * bf2f((u16)(y0.y >> 16)) + w.y * bf2f((u16)(y1.y >> 16));
        }
        layer_norm_row(v, g, b, lane);
        store_row_f32(X2 + (size_t)row * DM, v, lane);
        store_row_bf16(XH + (size_t)row * DM, v, lane);
        if (w_in_next) {
            float o[32]; skinny_dot<32>(sW, v, o);
            if (lane < 32) { float r = 0.f;
#pragma unroll
                for (int e = 0; e < 32; ++e) r = (lane == e) ? o[e] : r;
                LR[(size_t)row * 32 + lane] = r; }
        }
    }
}

__device__ __forceinline__ void phase_rows_pool(const float* __restrict__ X, u16* __restrict__ MIX) {
    const int tid_ = otid(); const int lane = tid_ & 63, wave = tid_ >> 6;
    for (int row = blockIdx.x * 8 + wave; row < TOK; row += gridDim.x * 8) {
        const int pos = row & (SEQ - 1), rb = row - pos;
        float v[16];
#pragma unroll
        for (int i = 0; i < 4; ++i) {
            const int half = 1 << i;
            const int lo = max(pos - half, 0), hi = min(pos + half, SEQ);
            float4 s = make_float4(0.f, 0.f, 0.f, 0.f);
            for (int t = lo; t < hi; ++t) { const float4 q = *reinterpret_cast<const float4*>(X + (size_t)(rb + t) * DM + i * 256 + lane * 4); s.x += q.x; s.y += q.y; s.z += q.z; s.w += q.w; }
            const float4 c = *reinterpret_cast<const float4*>(X + (size_t)row * DM + i * 256 + lane * 4);
            const float inv = 1.f / (float)(hi - lo);
            v[i * 4] = s.x * inv - c.x; v[i * 4 + 1] = s.y * inv - c.y; v[i * 4 + 2] = s.z * inv - c.z; v[i * 4 + 3] = s.w * inv - c.w;
        }
        store_row_bf16(MIX + (size_t)row * DM, v, lane);
    }
}

__device__ __forceinline__ float log_sigmoid_(float x) { return fminf(x, 0.f) - log1pf(expf(-fabsf(x))); }
constexpr int GROW = 72;
constexpr int GL_SB = 0;
constexpr int GL_LR = GL_SB + 32768;
constexpr int GL_TOT = GL_LR + 8192;
constexpr int GL_T0 = GL_TOT + 2048;
constexpr int GL_VT = GL_T0 + 3 * 9216;
constexpr int GL_PT = GL_VT + 18432;
constexpr int GL_RED = GL_PT + 18432;
constexpr int GL_END = GL_RED + 1024;
__device__ __forceinline__ void gla_gates(char* lds, const float* __restrict__ LR, const float* __restrict__ wgg, const float* __restrict__ bgg, int t0, int hd) {
    float* sb = reinterpret_cast<float*>(lds + GL_SB);
    float* slr = reinterpret_cast<float*>(lds + GL_LR);
    float* stot = reinterpret_cast<float*>(lds + GL_TOT);
    const int tid = otid();
    { const float4 v = *reinterpret_cast<const float4*>(LR + (size_t)t0 * 32 + tid * 4); *reinterpret_cast<float4*>(slr + tid * 4) = v; }
    const int d = tid >> 8, jq = (tid >> 6) & 3, kk = tid & 63;
    float w[16];
#pragma unroll
    for (int r = 0; r < 16; ++r) w[r] = wgg[(d * 16 + r) * 256 + hd * 64 + kk];
    const float bias = bgg[d * 256 + hd * 64 + kk];
    __syncthreads();
    float la[16];
#pragma unroll
    for (int jj = 0; jj < 16; ++jj) {
        const float* lrow = slr + (jq * 16 + jj) * 32 + d * 16;
        float a = bias;
#pragma unroll
        for (int r4 = 0; r4 < 16; r4 += 4) { const float4 l4 = *reinterpret_cast<const float4*>(lrow + r4); a += l4.x * w[r4] + l4.y * w[r4 + 1] + l4.z * w[r4 + 2] + l4.w * w[r4 + 3]; }
        la[jj] = log_sigmoid_(a) * (1.f / 16.f);
    }
    if (d == 0) {
#pragma unroll
        for (int jj = 1; jj < 16; ++jj) la[jj] += la[jj - 1];
        stot[(d * 4 + jq) * 64 + kk] = la[15];
    } else {
#pragma unroll
        for (int jj = 14; jj >= 0; --jj) la[jj] += la[jj + 1];
        stot[(d * 4 + jq) * 64 + kk] = la[0];
    }
    __syncthreads();
    float off = 0.f;
#pragma unroll
    for (int q = 0; q < 4; ++q) { const float tq = stot[(d * 4 + q) * 64 + kk]; off += ((d == 0) ? (q < jq) : (q > jq)) ? tq : 0.f; }
#pragma unroll
    for (int jj = 0; jj < 16; ++jj) sb[d * 4096 + (jq * 16 + jj) * 64 + kk] = la[jj] + off;
    __syncthreads();
}
__device__ __forceinline__ void gla_load_tile128(char* dst, const u16* __restrict__ src, size_t src_ld) {
    const int tid = otid();
#pragma unroll
    for (int i = 0; i < 2; ++i) { const int p = tid + i * 512, row = p >> 3, c = (p & 7) * 8;
        const uint4 v = *reinterpret_cast<const uint4*>(src + (size_t)row * src_ld + c);
        *reinterpret_cast<uint4*>(dst + (row * GROW + c) * 2) = v; }
}

__device__ __forceinline__ void phase_gla_g1(char* lds, const u16* __restrict__ Hb, const u16* __restrict__ GVt, const float* __restrict__ LR,
                                             const float* __restrict__ wgg, const float* __restrict__ bgg, float* __restrict__ ST, float* __restrict__ DEC) {
    const int tid = otid(), lane = tid & 63, wave = tid >> 6, lq = lane & 31, hh = lane >> 5;
    const float* sb = reinterpret_cast<const float*>(lds + GL_SB);
    for (int item = blockIdx.x; item < 1024; item += gridDim.x) {
        const int c = item & 31, hd = (item >> 5) & 3, b = item >> 7;
        const int t0 = b * SEQ + c * 64;
        gla_gates(lds, LR, wgg, bgg, t0, hd);
        gla_load_tile128(lds + GL_VT, GVt + ((size_t)(b * 4 + hd) * 128) * SEQ + c * 64, SEQ);
        {
            const int kk = tid & 63, jg = tid >> 6;
#pragma unroll
            for (int d = 0; d < 2; ++d) {
                const float bend = d == 0 ? sb[63 * 64 + kk] : sb[4096 + kk];
                u16* dstT = reinterpret_cast<u16*>(lds + GL_T0 + d * 9216) + kk * GROW + jg * 8;
                float v[8];
#pragma unroll
                for (int jj = 0; jj < 8; ++jj) { const int j = jg * 8 + jj;
                    v[jj] = bf2f(Hb[(size_t)(t0 + j) * HC + 256 + hd * 64 + kk]) * __expf(bend - sb[d * 4096 + j * 64 + kk]); }
                uint4 o; o.x = pack2(v[0], v[1]); o.y = pack2(v[2], v[3]); o.z = pack2(v[4], v[5]); o.w = pack2(v[6], v[7]);
                *reinterpret_cast<uint4*>(dstT) = o;
                if (jg == 0) DEC[((size_t)item * 2 + d) * 64 + kk] = __expf(bend);
            }
        }
        __syncthreads();
        {
            const int d = wave >> 2, vb = wave & 3;
            f32x16 acc[2];
#pragma unroll
            for (int kt = 0; kt < 2; ++kt)
#pragma unroll
                for (int i = 0; i < 16; ++i) acc[kt][i] = 0.f;
            const char* khT = lds + GL_T0 + d * 9216;
            const char* vT = lds + GL_VT;
#pragma unroll
            for (int ks = 0; ks < 4; ++ks) {
                const bf16x8 bf = *reinterpret_cast<const bf16x8*>(vT + ((vb * 32 + lq) * GROW + ks * 16 + hh * 8) * 2);
#pragma unroll
                for (int kt = 0; kt < 2; ++kt) {
                    const bf16x8 af = *reinterpret_cast<const bf16x8*>(khT + ((kt * 32 + lq) * GROW + ks * 16 + hh * 8) * 2);
                    acc[kt] = __builtin_amdgcn_mfma_f32_32x32x16_bf16(af, bf, acc[kt], 0, 0, 0);
                }
            }
            float* dst = ST + ((size_t)item * 2 + d) * 8192 + (size_t)(vb * 32 + lq) * 64;
#pragma unroll
            for (int kt = 0; kt < 2; ++kt)
#pragma unroll
                for (int g4 = 0; g4 < 4; ++g4)
                    *reinterpret_cast<float4*>(dst + kt * 32 + g4 * 8 + hh * 4) = make_float4(acc[kt][g4 * 4], acc[kt][g4 * 4 + 1], acc[kt][g4 * 4 + 2], acc[kt][g4 * 4 + 3]);
        }
        __syncthreads();
    }
}

__device__ __forceinline__ void phase_gla_g2(const float* __restrict__ ST, const float* __restrict__ DEC, u16* __restrict__ PS) {
    const int nwork = 64 * 2048;
    for (int w = blockIdx.x * NTHR + otid(); w < nwork; w += gridDim.x * NTHR) {
        const int e4 = w & 2047, bhd = w >> 11, d = bhd & 1, bh = bhd >> 1;
        const int kk4 = (e4 & 15) * 4;
        float4 st = make_float4(0.f, 0.f, 0.f, 0.f);
#pragma unroll 4
        for (int s = 0; s < 32; ++s) {
            const int c = d == 0 ? s : 31 - s;
            const size_t item = (size_t)bh * 32 + c;
            const float4 ds = *(reinterpret_cast<const float4*>(ST + (item * 2 + d) * 8192) + e4);
            const float4 dec = *reinterpret_cast<const float4*>(DEC + (item * 2 + d) * 64 + kk4);
            uint2 o; o.x = pack2(st.x, st.y); o.y = pack2(st.z, st.w);
            *(reinterpret_cast<uint2*>(PS + (item * 2 + d) * 8192) + e4) = o;
            st.x = dec.x * st.x + ds.x; st.y = dec.y * st.y + ds.y; st.z = dec.z * st.z + ds.z; st.w = dec.w * st.w + ds.w;
        }
    }
}

__device__ __forceinline__ void phase_gla_g3(char* lds, const u16* __restrict__ Hb, const u16* __restrict__ GVt, const float* __restrict__ LR,
                                             const float* __restrict__ wgg, const float* __restrict__ bgg, const u16* __restrict__ PS,
                                             const float* __restrict__ gnorm, u16* __restrict__ MIX) {
    const int tid = otid(), lane = tid & 63, wave = tid >> 6, lq = lane & 31, hh = lane >> 5;
    const int ib = wave & 1, vb = wave >> 1;
    const int pi_lq = (lq & 0x13) | ((lq & 4) << 1) | ((lq & 8) >> 1);
    const float* sb = reinterpret_cast<const float*>(lds + GL_SB);
    float* red = reinterpret_cast<float*>(lds + GL_RED);
    u16* tQt = reinterpret_cast<u16*>(lds + GL_T0);
    u16* tKt = reinterpret_cast<u16*>(lds + GL_T0 + 9216);
    u16* tQh = reinterpret_cast<u16*>(lds + GL_T0 + 2 * 9216);
    for (int item = blockIdx.x; item < 1024; item += gridDim.x) {
        const int c = item & 31, hd = (item >> 5) & 3, b = item >> 7;
        const int t0 = b * SEQ + c * 64;
        gla_gates(lds, LR, wgg, bgg, t0, hd);
        gla_load_tile128(lds + GL_VT, GVt + ((size_t)(b * 4 + hd) * 128) * SEQ + c * 64, SEQ);
        f32x16 oacc;
#pragma unroll
        for (int i = 0; i < 16; ++i) oacc[i] = 0.f;
#pragma unroll 1
        for (int d = 0; d < 2; ++d) {
            {
                const int kk = (tid & 31) * 2, jr = tid >> 5;
                const float* bd = sb + d * 4096;
                const int mid = d == 0 ? 31 : 32;
                const float bm0 = bd[mid * 64 + kk], bm1 = bd[mid * 64 + kk + 1];
                const float em0 = __expf(bm0), em1 = __expf(bm1);
#pragma unroll
                for (int ps = 0; ps < 4; ++ps) {
                    const int j = jr + ps * 16;
                    const u32 qraw = *reinterpret_cast<const u32*>(Hb + (size_t)(t0 + j) * HC + hd * 64 + kk);
                    const u32 kraw = *reinterpret_cast<const u32*>(Hb + (size_t)(t0 + j) * HC + 256 + hd * 64 + kk);
                    const float2 bj = *reinterpret_cast<const float2*>(bd + j * 64 + kk);
                    const float e0 = __expf(bj.x - bm0), e1 = __expf(bj.y - bm1);
                    const float q0 = bf2f((u16)(qraw & 0xffff)) * 0.125f * e0, q1 = bf2f((u16)(qraw >> 16)) * 0.125f * e1;
                    const float k0 = bf2f((u16)(kraw & 0xffff)) / e0, k1 = bf2f((u16)(kraw >> 16)) / e1;
                    *reinterpret_cast<u32*>(tQt + j * GROW + kk) = pack2(q0, q1);
                    *reinterpret_cast<u32*>(tKt + j * GROW + kk) = pack2(k0, k1);
                    *reinterpret_cast<u32*>(tQh + j * GROW + kk) = pack2(q0 * em0, q1 * em1);
                }
            }
            gla_load_tile128(lds + GL_PT, PS + ((size_t)item * 2 + d) * 8192, 64);
            __syncthreads();
            f32x16 sacc[2];
#pragma unroll
            for (int jt = 0; jt < 2; ++jt) {
#pragma unroll
                for (int i = 0; i < 16; ++i) sacc[jt][i] = 0.f;
#pragma unroll
                for (int ks = 0; ks < 4; ++ks) {
                    const bf16x8 af = *reinterpret_cast<const bf16x8*>(reinterpret_cast<const char*>(tKt) + ((jt * 32 + pi_lq) * GROW + ks * 16 + hh * 8) * 2);
                    const bf16x8 bf = *reinterpret_cast<const bf16x8*>(reinterpret_cast<const char*>(tQt) + ((ib * 32 + lq) * GROW + ks * 16 + hh * 8) * 2);
                    sacc[jt] = __builtin_amdgcn_mfma_f32_32x32x16_bf16(af, bf, sacc[jt], 0, 0, 0);
                }
            }
            const int iq = ib * 32 + lq;
            bf16x8 pf[4];
#pragma unroll
            for (int jt = 0; jt < 2; ++jt)
#pragma unroll
                for (int s2 = 0; s2 < 2; ++s2) {
                    float pv[8];
#pragma unroll
                    for (int jj = 0; jj < 8; ++jj) {
                        const int j = jt * 32 + s2 * 16 + hh * 8 + jj;
                        const bool keep = d == 0 ? (j <= iq) : (j > iq);
                        pv[jj] = keep ? sacc[jt][s2 * 8 + jj] : 0.f;
                    }
                    union { bf16x8 v; u32 w[4]; } cv;
                    cv.w[0] = pack2(pv[0], pv[1]); cv.w[1] = pack2(pv[2], pv[3]); cv.w[2] = pack2(pv[4], pv[5]); cv.w[3] = pack2(pv[6], pv[7]);
                    pf[jt * 2 + s2] = cv.v;
                }
            const char* vT = lds + GL_VT;
            const char* pT = lds + GL_PT;
#pragma unroll
            for (int jt = 0; jt < 2; ++jt)
#pragma unroll
                for (int s2 = 0; s2 < 2; ++s2) {
                    const bf16x8 af = *reinterpret_cast<const bf16x8*>(vT + ((vb * 32 + lq) * GROW + jt * 32 + s2 * 16 + hh * 8) * 2);
                    oacc = __builtin_amdgcn_mfma_f32_32x32x16_bf16(af, pf[jt * 2 + s2], oacc, 0, 0, 0);
                }
#pragma unroll
            for (int ks = 0; ks < 4; ++ks) {
                const bf16x8 af = *reinterpret_cast<const bf16x8*>(pT + ((vb * 32 + lq) * GROW + ks * 16 + hh * 8) * 2);
                const bf16x8 bf = *reinterpret_cast<const bf16x8*>(reinterpret_cast<const char*>(tQh) + ((ib * 32 + lq) * GROW + ks * 16 + hh * 8) * 2);
                oacc = __builtin_amdgcn_mfma_f32_32x32x16_bf16(af, bf, oacc, 0, 0, 0);
            }
            __syncthreads();
        }
        float ss = 0.f;
#pragma unroll
        for (int i = 0; i < 16; ++i) ss += oacc[i] * oacc[i];
        ss += __shfl_xor(ss, 32);
        if (hh == 0) red[vb * 64 + ib * 32 + lq] = ss;
        __syncthreads();
        const int iq = ib * 32 + lq;
        const float tot = red[iq] + red[64 + iq] + red[128 + iq] + red[192 + iq];
        const float rs = rsqrtf(tot * (1.f / 128.f) + RMS_EPS);
        const int t = t0 + iq;
#pragma unroll
        for (int g4 = 0; g4 < 4; ++g4) {
            const int vv = vb * 32 + g4 * 8 + hh * 4;
            const float4 gn = *reinterpret_cast<const float4*>(gnorm + vv);
            const uint2 gg = *reinterpret_cast<const uint2*>(Hb + (size_t)t * HC + 1024 + hd * 128 + vv);
            const float g0 = bf2f((u16)(gg.x & 0xffff)), g1 = bf2f((u16)(gg.x >> 16)), g2 = bf2f((u16)(gg.y & 0xffff)), g3 = bf2f((u16)(gg.y >> 16));
            uint2 ov;
            ov.x = pack2(oacc[g4 * 4] * rs * gn.x * (g0 * sigmoidf_(g0)), oacc[g4 * 4 + 1] * rs * gn.y * (g1 * sigmoidf_(g1)));
            ov.y = pack2(oacc[g4 * 4 + 2] * rs * gn.z * (g2 * sigmoidf_(g2)), oacc[g4 * 4 + 3] * rs * gn.w * (g3 * sigmoidf_(g3)));
            *reinterpret_cast<uint2*>(MIX + (size_t)t * DM + hd * 128 + vv) = ov;
        }
        __syncthreads();
    }
}

constexpr int KROW = 136, VROW = 72;
constexpr int ATT_KBYTES = 64 * KROW * 2, ATT_VBYTES = 128 * VROW * 2;
constexpr int ATT_BUF = ATT_KBYTES + ATT_VBYTES;
constexpr int ATT_TBL = 2 * ATT_BUF;
constexpr int ATT_MISC = ATT_TBL + 4096 * 4;
__device__ __forceinline__ int t5_bucket(int rel) {
    const int n = rel < 0 ? -rel : rel;
    int v;
    if (n < 8) v = n;
    else v = 8 + (n >= 12) + (n >= 16) + (n >= 23) + (n >= 32) + (n >= 46) + (n >= 64) + (n >= 91);
    return v + (rel > 0 ? 16 : 0);
}
__device__ __forceinline__ void phase_attn(char* lds, const u16* __restrict__ Hb, const u16* __restrict__ Vt, const float* __restrict__ relb, const float* __restrict__ dlam,
                           const float* __restrict__ dnorm, float lam_init, u16* __restrict__ MIX) {
    const int tid = otid(), lane = tid & 63, wave = tid >> 6, map = wave >> 2, qsub = wave & 3, lq = lane & 31, hh = lane >> 5;
    float* tbl = reinterpret_cast<float*>(lds + ATT_TBL);
    float* misc = reinterpret_cast<float*>(lds + ATT_MISC);
    const float LOG2E = 1.4426950408889634f;
    if (wave == 0) {
        float a = dlam[lane] * dlam[64 + lane], bq = dlam[128 + lane] * dlam[192 + lane];
        a = wave_sum(a); bq = wave_sum(bq);
        if (lane == 0) misc[0] = expf(a) - expf(bq) + lam_init;
    }
    __syncthreads();
    const float lam_full = misc[0];
    const int pi_lq = (lq & 0x13) | ((lq & 4) << 1) | ((lq & 8) >> 1);
    for (int item = blockIdx.x; item < 512; item += gridDim.x) {
        const int qb = item & 15, hd = (item >> 4) & 3, b = item >> 6;
        for (int i = tid; i < 4095; i += NTHR) tbl[i] = relb[t5_bucket(i - 2047) * 4 + hd] * LOG2E;
        const float c_lo = relb[15 * 4 + hd] * LOG2E, c_hi = relb[31 * 4 + hd] * LOG2E;
        const int q0 = qb * 128 + qsub * 32;
        const size_t trow = (size_t)b * SEQ;
        bf16x8 qf[4];
#pragma unroll
        for (int ks = 0; ks < 4; ++ks)
            qf[ks] = *reinterpret_cast<const bf16x8*>(Hb + (trow + q0 + lq) * HC + 1536 + hd * 128 + map * 64 + ks * 16 + hh * 8);
        f32x16 oacc[4];
#pragma unroll
        for (int db = 0; db < 4; ++db)
#pragma unroll
            for (int i = 0; i < 16; ++i) oacc[db][i] = 0.f;
        float m_run = -1e30f, l_run = 0.f;
        const u16* kbase = Hb + trow * HC + 2048 + hd * 128;
        const u16* vbase = Vt + ((size_t)(b * 4 + hd) * 128) * SEQ;
        uint4 kreg[2], vreg[2];
#define ATT_LOAD(k0) do { \
            for (int i_ = 0; i_ < 2; ++i_) { const int p_ = tid + i_ * 512; \
                kreg[i_] = *reinterpret_cast<const uint4*>(kbase + (size_t)((k0) + (p_ >> 4)) * HC + (p_ & 15) * 8); \
                vreg[i_] = *reinterpret_cast<const uint4*>(vbase + (size_t)(p_ >> 3) * SEQ + (k0) + (p_ & 7) * 8); } } while (0)
#define ATT_WRITE(buf) do { char* kb_ = lds + (buf) * ATT_BUF; char* vb_ = kb_ + ATT_KBYTES; \
            for (int i_ = 0; i_ < 2; ++i_) { const int p_ = tid + i_ * 512; \
                *reinterpret_cast<uint4*>(kb_ + ((p_ >> 4) * KROW + (p_ & 15) * 8) * 2) = kreg[i_]; \
                *reinterpret_cast<uint4*>(vb_ + ((p_ >> 3) * VROW + (p_ & 7) * 8) * 2) = vreg[i_]; } } while (0)
        ATT_LOAD(0);
        ATT_WRITE(0);
        __syncthreads();
        for (int kt = 0; kt < 32; ++kt) {
            const int k0 = kt * 64;
            if (kt + 1 < 32) ATT_LOAD(k0 + 64);
            const char* kb = lds + (kt & 1) * ATT_BUF;
            const char* vb = kb + ATT_KBYTES;
            f32x16 sacc[2];
#pragma unroll
            for (int st = 0; st < 2; ++st) {
#pragma unroll
                for (int i = 0; i < 16; ++i) sacc[st][i] = 0.f;
#pragma unroll
                for (int ks = 0; ks < 4; ++ks) {
                    const bf16x8 kf = *reinterpret_cast<const bf16x8*>(kb + ((st * 32 + pi_lq) * KROW + map * 64 + ks * 16 + hh * 8) * 2);
                    sacc[st] = __builtin_amdgcn_mfma_f32_32x32x16_bf16(kf, qf[ks], sacc[st], 0, 0, 0);
                }
            }
            const float c1 = 0.125f * LOG2E;
            float mx = -1e30f;
            const bool far_hi = (k0 - (q0 + 31)) >= 128, far_lo = (q0 - (k0 + 63)) >= 128;
            if (far_hi || far_lo) {
                const float cb = far_hi ? c_hi : c_lo;
#pragma unroll
                for (int st = 0; st < 2; ++st)
#pragma unroll
                    for (int i = 0; i < 16; ++i) { const float s = sacc[st][i] * c1 + cb; sacc[st][i] = s; mx = fmaxf(mx, s); }
            } else {
                const int rbase = k0 - (q0 + lq) + 2047 + 8 * hh;
#pragma unroll
                for (int st = 0; st < 2; ++st)
#pragma unroll
                    for (int i = 0; i < 16; ++i) {
                        const int koff = st * 32 + (i & 3) + 4 * ((i >> 2) & 1) + 16 * (i >> 3);
                        const float s = sacc[st][i] * c1 + tbl[rbase + koff];
                        sacc[st][i] = s; mx = fmaxf(mx, s);
                    }
            }
            mx = fmaxf(mx, __shfl_xor(mx, 32));
            if (!__all(mx - m_run <= 8.f)) {
                const float m_new = fmaxf(m_run, mx);
                const float alpha = __builtin_amdgcn_exp2f(m_run - m_new);
                m_run = m_new; l_run *= alpha;
#pragma unroll
                for (int db = 0; db < 4; ++db)
#pragma unroll
                    for (int i = 0; i < 16; ++i) oacc[db][i] *= alpha;
            }
            float psum = 0.f;
            bf16x8 pf[4];
#pragma unroll
            for (int st = 0; st < 2; ++st)
#pragma unroll
                for (int s2 = 0; s2 < 2; ++s2) {
                    float pv[8];
#pragma unroll
                    for (int j = 0; j < 8; ++j) { pv[j] = __builtin_amdgcn_exp2f(sacc[st][s2 * 8 + j] - m_run); psum += pv[j]; }
                    union { bf16x8 v; u32 w[4]; } cv;
                    cv.w[0] = pack2(pv[0], pv[1]); cv.w[1] = pack2(pv[2], pv[3]); cv.w[2] = pack2(pv[4], pv[5]); cv.w[3] = pack2(pv[6], pv[7]);
                    pf[st * 2 + s2] = cv.v;
                }
            l_run += psum;
#pragma unroll
            for (int db = 0; db < 4; ++db)
#pragma unroll
                for (int st = 0; st < 2; ++st)
#pragma unroll
                    for (int s2 = 0; s2 < 2; ++s2) {
                        const bf16x8 vf = *reinterpret_cast<const bf16x8*>(vb + ((db * 32 + lq) * VROW + st * 32 + s2 * 16 + hh * 8) * 2);
                        oacc[db] = __builtin_amdgcn_mfma_f32_32x32x16_bf16(vf, pf[st * 2 + s2], oacc[db], 0, 0, 0);
                    }
            if (kt + 1 < 32) ATT_WRITE((kt + 1) & 1);
            __syncthreads();
        }
        const float l_tot = l_run + __shfl_xor(l_run, 32);
        float* xch = reinterpret_cast<float*>(lds);
        const int qrow = qsub * 32 + lq;
        if (map == 1) {
            const float sc = lam_full / l_tot;
#pragma unroll
            for (int db = 0; db < 4; ++db)
#pragma unroll
                for (int g4 = 0; g4 < 4; ++g4) {
                    const int dv = db * 32 + g4 * 8 + hh * 4;
                    *reinterpret_cast<float4*>(xch + qrow * 132 + dv) = make_float4(oacc[db][g4 * 4] * sc, oacc[db][g4 * 4 + 1] * sc, oacc[db][g4 * 4 + 2] * sc, oacc[db][g4 * 4 + 3] * sc);
                }
        }
        __syncthreads();
        if (map == 0) {
            const float inv = 1.f / l_tot;
            float ss = 0.f;
#pragma unroll
            for (int db = 0; db < 4; ++db)
#pragma unroll
                for (int g4 = 0; g4 < 4; ++g4) {
                    const int dv = db * 32 + g4 * 8 + hh * 4;
                    const float4 o1 = *reinterpret_cast<const float4*>(xch + qrow * 132 + dv);
                    float v0 = oacc[db][g4 * 4] * inv - o1.x, v1 = oacc[db][g4 * 4 + 1] * inv - o1.y, v2 = oacc[db][g4 * 4 + 2] * inv - o1.z, v3 = oacc[db][g4 * 4 + 3] * inv - o1.w;
                    oacc[db][g4 * 4] = v0; oacc[db][g4 * 4 + 1] = v1; oacc[db][g4 * 4 + 2] = v2; oacc[db][g4 * 4 + 3] = v3;
                    ss += v0 * v0 + v1 * v1 + v2 * v2 + v3 * v3;
                }
            ss += __shfl_xor(ss, 32);
            const float rs = rsqrtf(ss * (1.f / 128.f) + RMS_EPS) * (1.f - lam_init);
            u16* dst = MIX + (trow + q0 + lq) * DM + 512 + hd * 128;
#pragma unroll
            for (int db = 0; db < 4; ++db)
#pragma unroll
                for (int g4 = 0; g4 < 4; ++g4) {
                    const int dv = db * 32 + g4 * 8 + hh * 4;
                    const float4 nw = *reinterpret_cast<const float4*>(dnorm + dv);
                    uint2 ov; ov.x = pack2(oacc[db][g4 * 4] * rs * nw.x, oacc[db][g4 * 4 + 1] * rs * nw.y);
                    ov.y = pack2(oacc[db][g4 * 4 + 2] * rs * nw.z, oacc[db][g4 * 4 + 3] * rs * nw.w);
                    *reinterpret_cast<uint2*>(dst + dv) = ov;
                }
        }
        __syncthreads();
    }
#undef ATT_LOAD
#undef ATT_WRITE
}

constexpr int NPHASE = 1 + 9 * NLAYER;
__global__ void __launch_bounds__(NTHR, 2) fwd_kernel(Params p) {
    extern __shared__ __attribute__((aligned(16))) unsigned char lds[];
    unsigned char* ws = p.ws;
    const int lo = p.ph_lo, hi = p.ph_hi;
    volatile LAS unsigned* barw = (volatile LAS unsigned*)(lds + LDS_BARW);
    if (threadIdx.x == 0) { barw[0] = 0u; barw[1] = 0u; barw[2] = 0u; barw[3] = 0u; }
    __syncthreads();
    XcdBarrier bar; bar.bar = (unsigned*)(ws + WS_CTL); bar.x = 0; bar.st = barw;
    const bool multi = (hi - lo) > 1;
    if (multi) bar = xcd_barrier_post((unsigned*)(ws + WS_CTL), barw);
#define IN(k) (lo <= (k) && (k) < hi)
#define SEAM(k) do { if (IN(k) && IN((k) + 1)) xcd_barrier(bar); } while (0)

    u16* shm = reinterpret_cast<u16*>(lds);
    float* ldsf = reinterpret_cast<float*>(lds);
    LAS MoeMap* mp = (LAS MoeMap*)(lds + LDS_MOEMAP);
    u16* Wt_in = (u16*)(ws + WS_WIN); u16* Wt_out = (u16*)(ws + WS_WOUT); u16* Wt_pool = (u16*)(ws + WS_WPOOL);
    u16* Wt_g = (u16*)(ws + WS_WG); u16* Wt_u = (u16*)(ws + WS_WU); u16* Wt_d = (u16*)(ws + WS_WD);
    float* XA = (float*)(ws + WS_XA); float* XB = (float*)(ws + WS_XB);
    u16* XH = (u16*)(ws + WS_XH); u16* MIX = (u16*)(ws + WS_MIXIN);
    float* LR = (float*)(ws + WS_LR); u16* Vt = (u16*)(ws + WS_VT); u16* GVt = (u16*)(ws + WS_GVT); u16* PS = (u16*)(ws + WS_R2 + R2_PS);
    u16* Hb = (u16*)(ws + WS_R1); u16* Hmoe = (u16*)(ws + WS_R1);
    float* ST = (float*)(ws + WS_R2); float* Z = (float*)(ws + WS_R2); u16* Y = (u16*)(ws + WS_R2);
    int* slot_tok = (int*)(ws + WS_SLOT); int* tinfo = (int*)(ws + WS_TINFO); float* DEC = (float*)(ws + WS_DEC);
    u32* gcnt_all = (u32*)(ws + WS_CTL + CTL_CNT);

    if (IN(0)) {
        REPEAT(K_CONV) phase_convert(ldsf, p);
        __syncthreads();
        REPEAT(K_ROWSP) phase_rows_prologue(ldsf, p.in[I_X], p.in[I_WIN], XH, LR);
    }
    SEAM(0);
    for (int L = 0; L < NLAYER; ++L) {
        const int base = 1 + 9 * L;
        const bool even = (L & 1) == 0;
        const int i2 = L >> 1;
        const float* xin = (L == 0) ? p.in[I_X] : XA;
        float* xout = (L == NLAYER - 1) ? p.out : XA;
        u32* gcnt = gcnt_all + L * 16;
        if (even) {
            if (IN(base + 0)) REPEAT(K_INPROJ) phase_inproj(shm, XH, Wt_in + (size_t)i2 * 3072 * 1024, Hb, Vt, GVt);
            SEAM(base + 0);
            if (IN(base + 1)) {
                const float lam_init = 0.8f - 0.6f * expf(-0.3f * (float)L);
                REPEAT(K_ATTN) phase_attn((char*)lds, Hb, Vt, p.in[I_RELB], p.in[I_DLAM] + i2 * 256, p.in[I_DNORM] + i2 * 128, lam_init, MIX);
                __syncthreads();
                REPEAT(K_G1) phase_gla_g1((char*)lds, Hb, GVt, LR, p.in[I_WGG] + i2 * 2 * 16 * 256, p.in[I_BGG] + i2 * 2 * 256, ST, DEC);
            }
            SEAM(base + 1);
            if (IN(base + 2)) phase_gla_g2(ST, DEC, PS);
            SEAM(base + 2);
            if (IN(base + 3)) REPEAT(K_G3) phase_gla_g3((char*)lds, Hb, GVt, LR, p.in[I_WGG] + i2 * 2 * 16 * 256, p.in[I_BGG] + i2 * 2 * 256, PS, p.in[I_GNORM] + i2 * 128, MIX);
            SEAM(base + 3);
            if (IN(base + 4)) REPEAT(K_MIXPROJ) phase_mixproj(shm, MIX, Wt_out + (size_t)i2 * 1048576, false, xin, nullptr, Z);
            SEAM(base + 4);
        } else {
            if (IN(base + 0)) REPEAT(K_POOL) phase_rows_pool(xin, MIX);
            if (IN(base + 0) && IN(base + 4)) xcd_barrier(bar);
            if (IN(base + 4)) REPEAT(K_MIXPROJ) phase_mixproj(shm, MIX, Wt_pool + (size_t)i2 * 4 * 65536, true, xin, p.in[I_PSCALE] + i2 * 1024, Z);
            SEAM(base + 4);
        }
        if (IN(base + 5)) phase_rows_ln1(ldsf, (LAS RouteLds*)(lds + 98304), Z, p.in[I_LNG] + (L * 2) * 1024, p.in[I_LNB] + (L * 2) * 1024,
                                         p.in[I_WR], p.in[I_RB], XB, XH, gcnt, slot_tok, tinfo);
        SEAM(base + 5);
        if (IN(base + 6)) REPEAT(K_MOE1) phase_moe1(shm, mp, gcnt, slot_tok, XH, Wt_g + (size_t)L * 16 * 1048576, Wt_u + (size_t)L * 16 * 1048576, Hmoe);
        SEAM(base + 6);
        if (IN(base + 7)) REPEAT(K_MOE2) phase_moe2(shm, mp, gcnt, Hmoe, Wt_d + (size_t)L * 16 * 1048576, Y);
        SEAM(base + 7);
        if (IN(base + 8)) REPEAT(K_LN2) phase_rows_ln2(ldsf, mp, gcnt, XB, Y, tinfo, p.in[I_LNG] + (L * 2 + 1) * 1024, p.in[I_LNB] + (L * 2 + 1) * 1024, xout, XH,
                                         (L + 1 < NLAYER && ((L + 1) & 1) == 0) ? p.in[I_WIN] + (size_t)((L + 1) >> 1) * 1024 * IN_COLS : nullptr, LR);
        SEAM(base + 8);
    }
#undef IN
#undef SEAM
}

extern "C" void kernel_launch(void* const* d_in, const int* in_sizes, int n_in, void* d_out, int out_size, void* d_ws, size_t ws_size, hipStream_t stream) {
    static int grid = 0;
    if (grid == 0) {
        if (n_in != 18 || ws_size < WS_END) { fprintf(stderr, "kernel_launch: unexpected inputs (n_in %d, ws %zu < %zu)\n", n_in, ws_size, (size_t)WS_END); grid = -1; return; }
        int dev = 0, cus = 0, per_cu = 0;
        hipGetDevice(&dev);
        hipDeviceGetAttribute(&cus, hipDeviceAttributeMultiprocessorCount, dev);
        if (hipFuncSetAttribute((const void*)fwd_kernel, hipFuncAttributeMaxDynamicSharedMemorySize, LDS_BYTES) != hipSuccess) { fprintf(stderr, "kernel_launch: hipFuncSetAttribute failed\n"); grid = -1; return; }
        if (hipOccupancyMaxActiveBlocksPerMultiprocessor(&per_cu, (const void*)fwd_kernel, NTHR, LDS_BYTES) != hipSuccess || per_cu < 1) {
            fprintf(stderr, "kernel_launch: occupancy query reports %d blocks per CU\n", per_cu); }
        (void)hipGetLastError();
        grid = cus;
    }
    if (grid < 0) return;
    hipMemsetAsync((char*)d_ws + WS_CTL, 0, CTL_BYTES, stream);
    Params p{};
    for (int i = 0; i < 18; ++i) p.in[i] = (const float*)d_in[i];
    p.out = (float*)d_out; p.ws = (unsigned char*)d_ws;
#if ONE_LAUNCH
    p.ph_lo = 0; p.ph_hi = NPHASE;
    hipLaunchKernelGGL(fwd_kernel, dim3(grid), dim3(NTHR), LDS_BYTES, stream, p);
#else
    for (int k = 0; k < NPHASE; ++k) {
        const int L = (k - 1) / 9, r = (k - 1) % 9;
        if (k > 0 && (L & 1) == 1 && (r == 1 || r == 2 || r == 3)) continue;
        p.ph_lo = k; p.ph_hi = k + 1;
        hipLaunchKernelGGL(fwd_kernel, dim3(grid), dim3(NTHR), LDS_BYTES, stream, p);
    }
#endif
}
```

```cpp
#include <hip/hip_runtime.h>
#include <stdint.h>
#include <stdio.h>

typedef unsigned short u16;
typedef unsigned int u32;
typedef __attribute__((ext_vector_type(8))) short bf16x8;
typedef __attribute__((ext_vector_type(4))) float f32x4;
typedef __attribute__((ext_vector_type(16))) float f32x16;
typedef __attribute__((ext_vector_type(4))) unsigned u32x4;
#define LAS __attribute__((address_space(3)))

#ifndef ONE_LAUNCH
#define ONE_LAUNCH 1
#endif
#ifndef REPMASK
#define REPMASK 0
#endif
#define REPS(kind) (1 + ((REPMASK >> (kind)) & 1))
#define REPEAT(kind) for (int rep_ = 0; rep_ < REPS(kind); ++rep_, __syncthreads())
enum { K_CONV = 0, K_INPROJ, K_ATTN, K_G1, K_G3, K_MIXPROJ, K_MOE1, K_MOE2, K_LN2, K_POOL, K_ROWSP };

constexpr int TOK = 16384, DM = 1024, SEQ = 2048, NBATCH = 8, NLAYER = 4;
constexpr int HC = 2560;
constexpr int NEXP = 16;
constexpr int IN_COLS = 3104;
constexpr float ALPHA = 1.681792830507429f;
constexpr float LN_EPS = 1e-5f, RMS_EPS = 1e-6f;
constexpr int NTHR = 512;
constexpr int LDS_BYTES = 163840 - 256;
constexpr int LDS_BARW = LDS_BYTES - 16;
constexpr int LDS_MOEMAP = LDS_BARW - 256;

constexpr size_t WS_CTL   = 0;
constexpr size_t CTL_BYTES = 65536;
constexpr size_t CTL_CNT  = 16384;
constexpr size_t WS_WIN   = WS_CTL + CTL_BYTES;
constexpr size_t WS_WOUT  = WS_WIN + (size_t)2 * 3072 * 1024 * 2;
constexpr size_t WS_WPOOL = WS_WOUT + (size_t)2 * 1024 * 1024 * 2;
constexpr size_t WS_WG    = WS_WPOOL + (size_t)2 * 4 * 256 * 256 * 2;
constexpr size_t WS_WU    = WS_WG + (size_t)64 * 1048576 * 2;
constexpr size_t WS_WD    = WS_WU + (size_t)64 * 1048576 * 2;
constexpr size_t WS_XA    = WS_WD + (size_t)64 * 1048576 * 2;
constexpr size_t WS_XB    = WS_XA + (size_t)TOK * DM * 4;
constexpr size_t WS_XH    = WS_XB + (size_t)TOK * DM * 4;
constexpr size_t WS_MIXIN = WS_XH + (size_t)TOK * DM * 2;
constexpr size_t WS_LR    = WS_MIXIN + (size_t)TOK * DM * 2;
constexpr size_t WS_VT    = WS_LR + (size_t)TOK * 32 * 4;
constexpr size_t WS_GVT   = WS_VT + (size_t)TOK * 512 * 2;
constexpr size_t WS_R1    = WS_GVT + (size_t)TOK * 512 * 2;
constexpr size_t R1_BYTES = (size_t)TOK * HC * 2;
constexpr size_t WS_R2    = WS_R1 + R1_BYTES;
constexpr size_t YH_ELEMS = (size_t)36864 * 1024;
constexpr size_t R2_BYTES = (size_t)2 * YH_ELEMS * 2;
constexpr size_t R2_PS    = (size_t)64 * 1048576;
constexpr size_t WS_SLOT  = WS_R2 + R2_BYTES;
constexpr size_t WS_TINFO = WS_SLOT + (size_t)16 * 16384 * 4;
constexpr size_t WS_DEC   = WS_TINFO + (size_t)TOK * 32;
constexpr size_t WS_END   = WS_DEC + (size_t)1024 * 2 * 64 * 4;

typedef __attribute__((ext_vector_type(2))) __bf16 bf16x2_t;
__device__ __forceinline__ u16 f2bf(float f) { return __builtin_bit_cast(u16, (__bf16)f); }
__device__ __forceinline__ float bf2f(u16 h) { return __uint_as_float(((u32)h) << 16); }
__device__ __forceinline__ u32 pack2(float a, float b) { bf16x2_t v; v[0] = (__bf16)a; v[1] = (__bf16)b; return __builtin_bit_cast(u32, v); }
__device__ __forceinline__ float wave_sum(float v) {
#pragma unroll
    for (int o = 32; o > 0; o >>= 1) v += __shfl_xor(v, o);
    return v;
}
__device__ __forceinline__ int otid() { int t = threadIdx.x; asm volatile("" : "+v"(t)); return t; }
__device__ __forceinline__ float sigmoidf_(float x) { return 1.f / (1.f + __expf(-x)); }

#define XB_TMO      128
#define XB_XCNT(j)  (256  + 64 * (j))
#define XB_XSUB(j)  (1280 + 64 * (j))
#define XB_XGEN(j)  (2304 + 64 * (j))
#define XB_TOP      3328
#define XB_TOPGEN   3392
#define XCD_BAR_WORDS 3456
#define XB_SPIN_CAP (1u << 20)
__device__ __forceinline__ unsigned xb_ld(unsigned* p)              { return __hip_atomic_load(p, __ATOMIC_RELAXED, __HIP_MEMORY_SCOPE_AGENT); }
__device__ __forceinline__ unsigned xb_add(unsigned* p, unsigned v) { return __hip_atomic_fetch_add(p, v, __ATOMIC_RELAXED, __HIP_MEMORY_SCOPE_AGENT); }
__device__ __forceinline__ unsigned xb_xcc_id() { return (unsigned)__builtin_amdgcn_s_getreg((3 << 11) | 20) & 0xFu; }
#define XB_SPIN(cond, bar) do { unsigned _sp = 0; while (cond) { __builtin_amdgcn_s_sleep(1); \
    if ((++_sp & 255u) == 0u) { if (xb_ld(&(bar)[XB_TMO])) break; if (_sp > XB_SPIN_CAP) { atomicAdd(&(bar)[XB_TMO], 1u); break; } } } } while (0)
struct XcdBarrier { unsigned* bar; unsigned x; volatile LAS unsigned* st; };
__device__ __forceinline__ XcdBarrier xcd_barrier_post(unsigned* bar, volatile LAS unsigned* st) {
    XcdBarrier b; b.bar = bar; b.x = xb_xcc_id(); b.st = st;
    if (threadIdx.x == 0) (void)xb_add(&bar[XB_XCNT(b.x)], 1u);
    return b;
}
__device__ __forceinline__ void xcd_barrier_complete(unsigned* bar, unsigned x, unsigned& nloc, unsigned& nx) {
    const unsigned G = gridDim.x * gridDim.y * gridDim.z;
    unsigned sum, cnt, mine, sp = 0u;
    for (;;) {
        sum = 0u; cnt = 0u; mine = 0u;
#pragma unroll
        for (unsigned j = 0; j < 16; ++j) { const unsigned c = xb_ld(&bar[XB_XCNT(j)]); sum += c; cnt += (c > 0u) ? 1u : 0u; mine = (j == x) ? c : mine; }
        if (sum == G) break;
        __builtin_amdgcn_s_sleep(1);
        if ((++sp & 255u) == 0u) { if (xb_ld(&bar[XB_TMO])) break; if (sp > XB_SPIN_CAP) { atomicAdd(&bar[XB_TMO], 1u); break; } }
    }
    nloc = mine > 0u ? mine : 1u; nx = cnt > 0u ? cnt : 1u;
}
__device__ __forceinline__ void xcd_barrier(const XcdBarrier& b) {
    asm volatile("s_waitcnt vmcnt(0)" ::: "memory");
    __syncthreads();
    if (threadIdx.x == 0) {
        unsigned* bar = b.bar;
        __builtin_amdgcn_s_waitcnt(0);
        unsigned nloc = b.st[0], nx = b.st[1];
        if (nloc == 0u) { xcd_barrier_complete(bar, b.x, nloc, nx); b.st[0] = nloc; b.st[1] = nx; }
        const unsigned old = xb_add(&bar[XB_XSUB(b.x)], 1u);
        const unsigned gen = old / nloc;
        if (old + 1u == (gen + 1u) * nloc) {
            __builtin_amdgcn_fence(__ATOMIC_RELEASE, "agent");
            asm volatile("s_waitcnt vmcnt(0)" ::: "memory");
            const unsigned og = xb_add(&bar[XB_TOP], 1u);
            const unsigned tg = og / nx;
            if (og + 1u == (tg + 1u) * nx) xb_add(&bar[XB_TOPGEN], 1u);
            else XB_SPIN(xb_ld(&bar[XB_TOPGEN]) == tg, bar);
            __builtin_amdgcn_fence(__ATOMIC_ACQUIRE, "agent");
            xb_add(&bar[XB_XGEN(b.x)], 1u);
            asm volatile("s_waitcnt vmcnt(0)" ::: "memory");
        } else {
            XB_SPIN(xb_ld(&bar[XB_XGEN(b.x)]) == gen, bar);
            __builtin_amdgcn_fence(__ATOMIC_ACQUIRE, "agent");
            asm volatile("s_waitcnt vmcnt(0)" ::: "memory");
        }
    }
    __syncthreads();
}

struct Params {
    const float* in[18];
    float* out;
    unsigned char* ws;
    int ph_lo, ph_hi;
};
enum { I_X = 0, I_RELB, I_WIN, I_WGG, I_BGG, I_GNORM, I_DLAM, I_DNORM, I_WOUT, I_WPOOL, I_PSCALE, I_LNG, I_LNB, I_WR, I_RB, I_WG, I_WU, I_WD };

constexpr int BK = 64, HALF = 128, HT = HALF * BK;
__device__ __forceinline__ int lds_byte(int r, int c) {
    int st = (r >> 4) * 2 + (c >> 5), rr = r & 15, cc = c & 31, ob = rr * 64 + cc * 2;
    return st * 1024 + (ob ^ (((ob >> 9) & 1) << 5));
}
__device__ __forceinline__ void stage_rc(int b, int& R, int& C) {
    int st = b / 1024, sb = b % 1024, swz = sb ^ (((sb >> 9) & 1) << 5);
    R = (st >> 1) * 16 + swz / 64; C = (st & 1) * 32 + (swz % 64) / 2;
}

#define WAIT_V(n) asm volatile("s_waitcnt vmcnt(" #n ")" ::: "memory")
#define WAIT_L(n) asm volatile("s_waitcnt lgkmcnt(" #n ")" ::: "memory")
#define BAR __builtin_amdgcn_s_barrier()
#define SCHED __builtin_amdgcn_sched_barrier(0)

template <bool SWAP, bool GATHER>
__device__ __forceinline__ void gemm_core(u16* shm, const u16* __restrict__ A, const int (&aq)[4], int lda64,
                                          const u16* __restrict__ B0p, const u16* __restrict__ B1p, int bo, int ldb64,
                                          int nt, f32x4 (&acc)[2][2][4][2]) {
#define SA(b, h) (shm + ((b) * 2 + (h)) * HT)
#define SB(b, h) (shm + (4 + (b) * 2 + (h)) * HT)
#define GLDS(src, dst) __builtin_amdgcn_global_load_lds((const unsigned*)(src), (unsigned*)(dst), 16, 0, 0)
#define AOFF(q) (GATHER ? aq[q] : aq[0] + (q) * lda64)
#define GLDS_O(base, off, dst) do { int _o = (off); asm volatile("" : "+v"(_o)); GLDS((base) + _o, dst); } while (0)
#define STAGE_A(P, h, kt) do { const u16* _s = A + (kt) * BK; char* _d = (char*)(P) + tz * 16; \
        GLDS_O(_s, AOFF(2 * (h)), _d); GLDS_O(_s, AOFF(2 * (h) + 1), _d + 8192); } while (0)
#define STAGE_B(P, h, kt) do { const u16* _s = ((h) ? B1p : B0p) + (kt) * BK; char* _d = (char*)(P) + tz * 16; \
        GLDS_O(_s, bo, _d); GLDS_O(_s, bo + ldb64, _d + 8192); } while (0)
#define LDA(dst, b, h) _Pragma("unroll") for (int m = 0; m < 4; ++m) _Pragma("unroll") for (int k = 0; k < 2; ++k) \
        dst[m][k] = *reinterpret_cast<const bf16x8*>((char*)SA(b, h) + lds_byte(wr * 64 + m * 16 + fr, k * 32 + fq * 8))
#define LDB(dst, b, h) _Pragma("unroll") for (int n = 0; n < 2; ++n) _Pragma("unroll") for (int k = 0; k < 2; ++k) \
        dst[n][k] = *reinterpret_cast<const bf16x8*>((char*)SB(b, h) + lds_byte(wc * 32 + n * 16 + fr, k * 32 + fq * 8))
#define MMA(ai, bj, At, Bt) do { __builtin_amdgcn_s_setprio(1); \
        _Pragma("unroll") for (int m = 0; m < 4; ++m) _Pragma("unroll") for (int n = 0; n < 2; ++n) _Pragma("unroll") for (int k = 0; k < 2; ++k) \
            acc[ai][bj][m][n] = SWAP ? __builtin_amdgcn_mfma_f32_16x16x32_bf16(Bt[n][k], At[m][k], acc[ai][bj][m][n], 0, 0, 0) \
                                     : __builtin_amdgcn_mfma_f32_16x16x32_bf16(At[m][k], Bt[n][k], acc[ai][bj][m][n], 0, 0, 0); \
        __builtin_amdgcn_s_setprio(0); } while (0)
    int tz = otid();
    int wid = tz >> 6, lane = tz & 63, wr = wid >> 2, wc = wid & 3, fr = lane & 15, fq = lane >> 4;
    bf16x8 At[4][2], B0[2][2], B1[2][2];
    STAGE_B(SB(0, 0), 0, 0); STAGE_A(SA(0, 0), 0, 0);
    STAGE_B(SB(0, 1), 1, 0); STAGE_A(SA(0, 1), 1, 0);
    if (wr == 1) BAR;
    WAIT_V(4); BAR;
    STAGE_B(SB(1, 0), 0, 1); STAGE_A(SA(1, 0), 0, 1); STAGE_B(SB(1, 1), 1, 1);
    WAIT_V(6); BAR;
    for (int t = 0; t < nt - 2; t += 2) {
        LDB(B0, 0, 0); SCHED; LDA(At, 0, 0); STAGE_A(SA(1, 1), 1, t + 1);
        WAIT_L(8); BAR; WAIT_L(0); MMA(0, 0, At, B0); BAR; SCHED;
        LDB(B1, 0, 1); STAGE_B(SB(0, 0), 0, t + 2);
        BAR; WAIT_L(0); MMA(0, 1, At, B1); BAR;
        LDA(At, 0, 1); STAGE_A(SA(0, 0), 0, t + 2);
        BAR; WAIT_L(0); MMA(1, 0, At, B0); BAR; SCHED;
        STAGE_B(SB(0, 1), 1, t + 2);
        WAIT_V(6); BAR; MMA(1, 1, At, B1); BAR;
        LDB(B0, 1, 0); SCHED; LDA(At, 1, 0); STAGE_A(SA(0, 1), 1, t + 2);
        WAIT_L(8); BAR; WAIT_L(0); MMA(0, 0, At, B0); BAR; SCHED;
        LDB(B1, 1, 1); STAGE_B(SB(1, 0), 0, t + 3);
        BAR; WAIT_L(0); MMA(0, 1, At, B1); BAR;
        LDA(At, 1, 1); STAGE_A(SA(1, 0), 0, t + 3);
        BAR; WAIT_L(0); MMA(1, 0, At, B0); BAR; SCHED;
        STAGE_B(SB(1, 1), 1, t + 3);
        WAIT_V(6); BAR; MMA(1, 1, At, B1); BAR;
    }
    asm volatile("" : "+v"(tz)); wid = tz >> 6; lane = tz & 63; wr = wid >> 2; wc = wid & 3; fr = lane & 15; fq = lane >> 4;
    { LDB(B0, 0, 0); WAIT_V(0); LDA(At, 0, 0); STAGE_A(SA(1, 1), 1, nt - 1);
      BAR; WAIT_L(0); MMA(0, 0, At, B0); BAR;
      LDB(B1, 0, 1); BAR; WAIT_L(0); MMA(0, 1, At, B1); BAR;
      LDA(At, 0, 1); WAIT_V(4); BAR; WAIT_L(0); MMA(1, 0, At, B0); MMA(1, 1, At, B1); BAR; }
    { LDB(B0, 1, 0); LDA(At, 1, 0); WAIT_V(2); BAR; WAIT_L(0); MMA(0, 0, At, B0); BAR;
      LDB(B1, 1, 1); WAIT_V(0); BAR; WAIT_L(0); MMA(0, 1, At, B1); BAR;
      LDA(At, 1, 1); BAR; WAIT_L(0); MMA(1, 0, At, B0); MMA(1, 1, At, B1); BAR; }
    if (wr == 0) BAR;
#undef SA
#undef SB
#undef STAGE_A
#undef GLDS_O
#undef AOFF
#undef STAGE_B
#undef LDA
#undef LDB
#undef MMA
}

__device__ __forceinline__ void stage_geom(int& R0, int& C0) { stage_rc(otid() * 16, R0, C0); }

#define ACC_ZERO(acc) do { _Pragma("unroll") for (int a_ = 0; a_ < 2; ++a_) _Pragma("unroll") for (int b_ = 0; b_ < 2; ++b_) _Pragma("unroll") for (int m_ = 0; m_ < 4; ++m_) _Pragma("unroll") for (int n_ = 0; n_ < 2; ++n_) \
        acc[a_][b_][m_][n_] = f32x4{0.f, 0.f, 0.f, 0.f}; } while (0)

__device__ __forceinline__ void phase_inproj(u16* shm, const u16* __restrict__ XH, const u16* __restrict__ Wt, u16* __restrict__ Hb, u16* __restrict__ Vt, u16* __restrict__ GVt) {
    const int nunits = 64 * 12;
    for (int u = blockIdx.x; u < nunits; u += gridDim.x) {
        const int pm = u & 63, pn = u >> 6;
        const int brow = pm * 256, bcol = pn * 256;
        int R0, C0; stage_geom(R0, C0);
        const int aq[4] = {(brow + R0) * DM + C0, 0, 0, 0};
        const u16* B0p = Wt + (size_t)bcol * DM;
        const int bo = R0 * DM + C0;
        f32x4 acc[2][2][4][2]; ACC_ZERO(acc);
        const bool vtile = (pn == 2) | (pn == 3) | (pn >= 10);
        if (!vtile) {
            gemm_core<true, false>(shm, XH, aq, 64 * DM, B0p, B0p + (size_t)128 * DM, bo, 64 * DM, DM / BK, acc);
            int tz = otid();
            const int wid = tz >> 6, lane = tz & 63, wr = wid >> 2, wc = wid & 3, fr = lane & 15, fq = lane >> 4;
            _Pragma("unroll") for (int ai = 0; ai < 2; ++ai) _Pragma("unroll") for (int bj = 0; bj < 2; ++bj) _Pragma("unroll") for (int m = 0; m < 4; ++m) _Pragma("unroll") for (int n = 0; n < 2; ++n) {
                const int row = brow + ai * 128 + wr * 64 + m * 16 + fr;
                const int col = bcol + bj * 128 + wc * 32 + n * 16 + fq * 4;
                uint2 v; v.x = pack2(acc[ai][bj][m][n][0], acc[ai][bj][m][n][1]); v.y = pack2(acc[ai][bj][m][n][2], acc[ai][bj][m][n][3]);
                *reinterpret_cast<uint2*>(Hb + (size_t)row * HC + col) = v;
            }
        } else {
            gemm_core<false, false>(shm, XH, aq, 64 * DM, B0p, B0p + (size_t)128 * DM, bo, 64 * DM, DM / BK, acc);
            int tz = otid();
            const int wid = tz >> 6, lane = tz & 63, wr = wid >> 2, wc = wid & 3, fr = lane & 15, fq = lane >> 4;
            _Pragma("unroll") for (int ai = 0; ai < 2; ++ai) _Pragma("unroll") for (int bj = 0; bj < 2; ++bj) _Pragma("unroll") for (int m = 0; m < 4; ++m) _Pragma("unroll") for (int n = 0; n < 2; ++n) {
                const int row = brow + ai * 128 + wr * 64 + m * 16 + fq * 4;
                const int col = (pn & 1) * 256 + bj * 128 + wc * 32 + n * 16 + fr;
                const int b = row >> 11, s = row & 2047, hd = col >> 7, dv = col & 127;
                uint2 v; v.x = pack2(acc[ai][bj][m][n][0], acc[ai][bj][m][n][1]); v.y = pack2(acc[ai][bj][m][n][2], acc[ai][bj][m][n][3]);
                *reinterpret_cast<uint2*>((pn >= 10 ? Vt : GVt) + ((size_t)((b * 4 + hd) * 128 + dv)) * SEQ + s) = v;
            }
        }
    }
}

__device__ __forceinline__ void phase_mixproj(u16* shm, const u16* __restrict__ MIX, const u16* __restrict__ Wt, bool pool,
                              const float* __restrict__ xin, const float* __restrict__ scale, float* __restrict__ Z) {
    const int nunits = 64 * 4;
    for (int u = blockIdx.x; u < nunits; u += gridDim.x) {
        const int pm = u & 63, pn = u >> 6;
        const int brow = pm * 256, bcol = pn * 256;
        int R0, C0; stage_geom(R0, C0);
        const int ldb = pool ? 256 : 1024;
        const int aq[4] = {(brow + R0) * DM + C0 + (pool ? pn * 256 : 0), 0, 0, 0};
        const u16* B0p = pool ? (Wt + (size_t)pn * 65536) : (Wt + (size_t)bcol * DM);
        const int bo = R0 * ldb + C0;
        f32x4 acc[2][2][4][2]; ACC_ZERO(acc);
        gemm_core<true, false>(shm, MIX, aq, 64 * DM, B0p, B0p + (size_t)128 * ldb, bo, 64 * ldb, ldb / BK, acc);
        int tz = otid();
        const int wid = tz >> 6, lane = tz & 63, wr = wid >> 2, wc = wid & 3, fr = lane & 15, fq = lane >> 4;
        _Pragma("unroll") for (int ai = 0; ai < 2; ++ai) _Pragma("unroll") for (int bj = 0; bj < 2; ++bj) _Pragma("unroll") for (int m = 0; m < 4; ++m) _Pragma("unroll") for (int n = 0; n < 2; ++n) {
            const int row = brow + ai * 128 + wr * 64 + m * 16 + fr;
            const int col = bcol + bj * 128 + wc * 32 + n * 16 + fq * 4;
            const float4 xv = *reinterpret_cast<const float4*>(xin + (size_t)row * DM + col);
            float4 sc = make_float4(1.f, 1.f, 1.f, 1.f);
            if (pool) sc = *reinterpret_cast<const float4*>(scale + col);
            float4 o;
            o.x = ALPHA * xv.x + acc[ai][bj][m][n][0] * sc.x; o.y = ALPHA * xv.y + acc[ai][bj][m][n][1] * sc.y;
            o.z = ALPHA * xv.z + acc[ai][bj][m][n][2] * sc.z; o.w = ALPHA * xv.w + acc[ai][bj][m][n][3] * sc.w;
            *reinterpret_cast<float4*>(Z + (size_t)row * DM + col) = o;
        }
    }
}

struct MoeMap { int toff[17]; int cnt[16]; };
__device__ __forceinline__ void moe_build_map(LAS MoeMap* mp, const u32* __restrict__ gcnt) {
    if (otid() == 0) {
        int o = 0;
        for (int e = 0; e < 16; ++e) { int c = (int)__hip_atomic_load(gcnt + e, __ATOMIC_RELAXED, __HIP_MEMORY_SCOPE_AGENT); mp->cnt[e] = c; mp->toff[e] = o; o += (c + 255) >> 8; }
        mp->toff[16] = o;
    }
    __syncthreads();
}

__device__ __forceinline__ void phase_moe1(u16* shm, LAS MoeMap* mp, const u32* __restrict__ gcnt, const int* __restrict__ slot_tok, const u16* __restrict__ XH,
                           const u16* __restrict__ Wg, const u16* __restrict__ Wu, u16* __restrict__ Hout) {
    moe_build_map(mp, gcnt);
    const int RT = mp->toff[16];
    const int nunits = RT * 8;
    for (int u = blockIdx.x; u < nunits; u += gridDim.x) {
        const int rt = u >> 3, ft = u & 7;
        int e = 0;
        for (int i = 1; i < 16; ++i) e += (rt >= mp->toff[i]) ? 1 : 0;
        const int pos0 = (rt - mp->toff[e]) * 256, ne = mp->cnt[e];
        int R0, C0; stage_geom(R0, C0);
        int aq[4];
#pragma unroll
        for (int q = 0; q < 4; ++q) {
            const int p = pos0 + q * 64 + R0;
            const int tok = (p < ne) ? slot_tok[e * 16384 + p] : 0;
            aq[q] = tok * DM + C0;
        }
        const u16* B0p = Wg + ((size_t)e * 1024 + ft * 128) * DM;
        const u16* B1p = Wu + ((size_t)e * 1024 + ft * 128) * DM;
        const int bo = R0 * DM + C0;
        f32x4 acc[2][2][4][2]; ACC_ZERO(acc);
        gemm_core<true, true>(shm, XH, aq, 0, B0p, B1p, bo, 64 * DM, DM / BK, acc);
        int tz = otid();
        const int wid = tz >> 6, lane = tz & 63, wr = wid >> 2, wc = wid & 3, fr = lane & 15, fq = lane >> 4;
        _Pragma("unroll") for (int ai = 0; ai < 2; ++ai) _Pragma("unroll") for (int m = 0; m < 4; ++m) _Pragma("unroll") for (int n = 0; n < 2; ++n) {
            const int row = rt * 256 + ai * 128 + wr * 64 + m * 16 + fr;
            const int col = ft * 128 + wc * 32 + n * 16 + fq * 4;
            float hv[4];
#pragma unroll
            for (int j = 0; j < 4; ++j) { const float g = acc[ai][0][m][n][j], uu = acc[ai][1][m][n][j]; hv[j] = g * sigmoidf_(g) * uu; }
            uint2 v; v.x = pack2(hv[0], hv[1]); v.y = pack2(hv[2], hv[3]);
            *reinterpret_cast<uint2*>(Hout + (size_t)row * 1024 + col) = v;
        }
    }
}

__device__ __forceinline__ void phase_moe2(u16* shm, LAS MoeMap* mp, const u32* __restrict__ gcnt, const u16* __restrict__ Hin, const u16* __restrict__ Wd, u16* __restrict__ Y) {
    moe_build_map(mp, gcnt);
    const int RT = mp->toff[16];
    const int nunits = RT * 4;
    for (int u = blockIdx.x; u < nunits; u += gridDim.x) {
        const int rt = u >> 2, pn = u & 3;
        int e = 0;
        for (int i = 1; i < 16; ++i) e += (rt >= mp->toff[i]) ? 1 : 0;
        int R0, C0; stage_geom(R0, C0);
        const int aq[4] = {(rt * 256 + R0) * 1024 + C0, 0, 0, 0};
        const u16* B0p = Wd + ((size_t)e * 1024 + pn * 256) * 1024;
        const int bo = R0 * 1024 + C0;
        f32x4 acc[2][2][4][2]; ACC_ZERO(acc);
        gemm_core<true, false>(shm, Hin, aq, 64 * 1024, B0p, B0p + (size_t)128 * 1024, bo, 64 * 1024, 1024 / BK, acc);
        int tz = otid();
        const int wid = tz >> 6, lane = tz & 63, wr = wid >> 2, wc = wid & 3, fr = lane & 15, fq = lane >> 4;
        _Pragma("unroll") for (int ai = 0; ai < 2; ++ai) _Pragma("unroll") for (int bj = 0; bj < 2; ++bj) _Pragma("unroll") for (int m = 0; m < 4; ++m) _Pragma("unroll") for (int n = 0; n < 2; ++n) {
            const int row = rt * 256 + ai * 128 + wr * 64 + m * 16 + fr;
            const int col = pn * 256 + bj * 128 + wc * 32 + n * 16 + fq * 4;
            uint2 v; v.x = pack2(acc[ai][bj][m][n][0], acc[ai][bj][m][n][1]); v.y = pack2(acc[ai][bj][m][n][2], acc[ai][bj][m][n][3]);
            *reinterpret_cast<uint2*>(Y + (size_t)row * 1024 + col) = v;
        }
    }
}

struct ConvDesc { const float* src; u16* dst; int ld, K; };
__device__ __forceinline__ void conv_desc(const Params& p, int t, ConvDesc& d) {
    unsigned char* ws = p.ws;
    if (t < 384) {
        const int i = t / 192, r = t % 192, kt = r / 24, ntl = r % 24;
        const int n0 = ntl * 128, n0src = n0 + (n0 >= 1536 ? 32 : 0);
        d.src = p.in[I_WIN] + (size_t)i * 1024 * IN_COLS + (size_t)(kt * 128) * IN_COLS + n0src; d.ld = IN_COLS; d.K = 1024;
        d.dst = (u16*)(ws + WS_WIN) + (size_t)i * 3072 * 1024 + (size_t)n0 * 1024 + kt * 128;
    } else if (t < 512) {
        const int q = t - 384, i = q >> 6, r = q & 63, kt = r >> 3, ntl = r & 7;
        d.src = p.in[I_WOUT] + (size_t)i * 1048576 + (size_t)(kt * 128) * 1024 + ntl * 128; d.ld = 1024; d.K = 1024;
        d.dst = (u16*)(ws + WS_WOUT) + (size_t)i * 1048576 + (size_t)(ntl * 128) * 1024 + kt * 128;
    } else if (t < 544) {
        const int q = t - 512, mtx = q >> 2, r = q & 3, kt = r >> 1, ntl = r & 1;
        d.src = p.in[I_WPOOL] + (size_t)mtx * 65536 + (size_t)(kt * 128) * 256 + ntl * 128; d.ld = 256; d.K = 256;
        d.dst = (u16*)(ws + WS_WPOOL) + (size_t)mtx * 65536 + (size_t)(ntl * 128) * 256 + kt * 128;
    } else {
        const int q = t - 544, which = q / 4096, r = q % 4096, mtx = r >> 6, tt = r & 63, kt = tt >> 3, ntl = tt & 7;
        d.src = p.in[I_WG + which] + (size_t)mtx * 1048576 + (size_t)(kt * 128) * 1024 + ntl * 128; d.ld = 1024; d.K = 1024;
        d.dst = (u16*)(ws + (which == 0 ? WS_WG : (which == 1 ? WS_WU : WS_WD))) + (size_t)mtx * 1048576 + (size_t)(ntl * 128) * 1024 + kt * 128;
    }
}
__device__ __forceinline__ void conv_issue(const ConvDesc& d, float (&v)[4][8]) {
    const int tid = otid(), n = tid & 127, kq = tid >> 7;
#pragma unroll
    for (int i = 0; i < 4; ++i)
#pragma unroll
        for (int j = 0; j < 8; ++j) v[i][j] = __builtin_nontemporal_load(d.src + (size_t)((kq + 4 * i) * 8 + j) * d.ld + n);
}
__device__ __forceinline__ void phase_convert(char* lds, const Params& p) {
    const int total = 544 + 12288;
    const int tid = otid();
    int t = blockIdx.x;
    ConvDesc cur; float v[4][8];
    if (t < total) { conv_desc(p, t, cur); conv_issue(cur, v); }
    while (t < total) {
        { const int n = tid & 127, kq = tid >> 7;
#pragma unroll
          for (int i = 0; i < 4; ++i) {
              u32x4 o; o[0] = pack2(v[i][0], v[i][1]); o[1] = pack2(v[i][2], v[i][3]); o[2] = pack2(v[i][4], v[i][5]); o[3] = pack2(v[i][6], v[i][7]);
              *reinterpret_cast<u32x4*>(lds + (n * 136 + (kq + 4 * i) * 8) * 2) = o;
          } }
        __syncthreads();
        u16* dst = cur.dst; const int K = cur.K;
        const int tn = t + gridDim.x;
        if (tn < total) { conv_desc(p, tn, cur); conv_issue(cur, v); }
        { const int k16 = tid & 15, nr = tid >> 4;
#pragma unroll
          for (int pz = 0; pz < 4; ++pz) {
              const int n = nr + 32 * pz;
              const u32x4 o = *reinterpret_cast<const u32x4*>(lds + (n * 136 + k16 * 8) * 2);
              *reinterpret_cast<u32x4*>(dst + (size_t)n * K + k16 * 8) = o;
          } }
        __syncthreads();
        t = tn;
    }
}

__device__ __forceinline__ int rho_of_k(int k) { return ((k >> 2) & 63) + 64 * ((k & 3) + 4 * (k >> 8)); }
template <int NO>
__device__ __forceinline__ void load_skinny(float* sW, const float* __restrict__ W, int ld, int c0) {
    for (int idx = otid(); idx < 1024 * (NO / 4); idx += NTHR) {
        const int k = idx / (NO / 4), c4 = (idx % (NO / 4)) * 4;
        const float4 v = *reinterpret_cast<const float4*>(W + (size_t)k * ld + c0 + c4);
        *reinterpret_cast<float4*>(sW + rho_of_k(k) * (NO + 4) + c4) = v;
    }
}
template <int NO>
__device__ __forceinline__ void skinny_dot(const float* sW, const float (&xv)[16], float (&o)[NO]) {
    const int lane = otid() & 63;
#pragma unroll
    for (int e = 0; e < NO; ++e) o[e] = 0.f;
#pragma unroll
    for (int i = 0; i < 4; ++i)
#pragma unroll
        for (int jj = 0; jj < 4; ++jj) {
            const float x = xv[i * 4 + jj];
            const float* wrow = sW + (lane + 64 * (jj + 4 * i)) * (NO + 4);
#pragma unroll
            for (int e4 = 0; e4 < NO; e4 += 4) {
                const float4 w = *reinterpret_cast<const float4*>(wrow + e4);
                o[e4] += x * w.x; o[e4 + 1] += x * w.y; o[e4 + 2] += x * w.z; o[e4 + 3] += x * w.w;
            }
            __builtin_amdgcn_sched_barrier(0);
        }
#pragma unroll
    for (int e = 0; e < NO; ++e) o[e] = wave_sum(o[e]);
}
__device__ __forceinline__ void store_row_bf16(u16* __restrict__ dst, const float (&v)[16], int lane) {
#pragma unroll
    for (int i = 0; i < 4; ++i) {
        uint2 o; o.x = pack2(v[i * 4], v[i * 4 + 1]); o.y = pack2(v[i * 4 + 2], v[i * 4 + 3]);
        *reinterpret_cast<uint2*>(dst + i * 256 + lane * 4) = o;
    }
}
__device__ __forceinline__ void store_row_f32(float* __restrict__ dst, const float (&v)[16], int lane) {
#pragma unroll
    for (int i = 0; i < 4; ++i) *reinterpret_cast<float4*>(dst + i * 256 + lane * 4) = make_float4(v[i * 4], v[i * 4 + 1], v[i * 4 + 2], v[i * 4 + 3]);
}
__device__ __forceinline__ void load_row_f32(const float* __restrict__ src, float (&v)[16], int lane) {
#pragma unroll
    for (int i = 0; i < 4; ++i) { const float4 t = *reinterpret_cast<const float4*>(src + i * 256 + lane * 4); v[i * 4] = t.x; v[i * 4 + 1] = t.y; v[i * 4 + 2] = t.z; v[i * 4 + 3] = t.w; }
}
__device__ __forceinline__ void layer_norm_row(float (&v)[16], const float* __restrict__ g, const float* __restrict__ b, int lane) {
    float s = 0.f;
#pragma unroll
    for (int i = 0; i < 16; ++i) s += v[i];
    const float mu = wave_sum(s) * (1.f / 1024.f);
    float q = 0.f;
#pragma unroll
    for (int i = 0; i < 16; ++i) { const float d = v[i] - mu; q += d * d; }
    const float rs = rsqrtf(wave_sum(q) * (1.f / 1024.f) + LN_EPS);
#pragma unroll
    for (int i = 0; i < 4; ++i) {
        const float4 gg = *reinterpret_cast<const float4*>(g + i * 256 + lane * 4);
        const float4 bb = *reinterpret_cast<const float4*>(b + i * 256 + lane * 4);
        v[i * 4] = (v[i * 4] - mu) * rs * gg.x + bb.x; v[i * 4 + 1] = (v[i * 4 + 1] - mu) * rs * gg.y + bb.y;
        v[i * 4 + 2] = (v[i * 4 + 2] - mu) * rs * gg.z + bb.z; v[i * 4 + 3] = (v[i * 4 + 3] - mu) * rs * gg.w + bb.w;
    }
}

__device__ __forceinline__ void phase_rows_prologue(float* sW, const float* __restrict__ x, const float* __restrict__ w_in0, u16* __restrict__ XH, float* __restrict__ LR) {
    load_skinny<32>(sW, w_in0, IN_COLS, 1536);
    __syncthreads();
    const int tid_ = otid(); const int lane = tid_ & 63, wave = tid_ >> 6;
    for (int row = blockIdx.x * 8 + wave; row < TOK; row += gridDim.x * 8) {
        float v[16]; load_row_f32(x + (size_t)row * DM, v, lane);
        store_row_bf16(XH + (size_t)row * DM, v, lane);
        float o[32]; skinny_dot<32>(sW, v, o);
        if (lane < 32) { float r = 0.f;
#pragma unroll
            for (int e = 0; e < 32; ++e) r = (lane == e) ? o[e] : r;
            LR[(size_t)row * 32 + lane] = r; }
    }
}

struct RouteLds { int e0[64], e1[64], lp0[64], lp1[64]; float w0[64], w1[64]; int cnt[16], base[16]; };
__device__ __forceinline__ void phase_rows_ln1(float* sW, LAS RouteLds* rl, const float* __restrict__ Z, const float* __restrict__ g, const float* __restrict__ b,
                               const float* __restrict__ w_router, const float* __restrict__ rbias,
                               float* __restrict__ X1, u16* __restrict__ XH, u32* __restrict__ gcnt, int* __restrict__ slot_tok, int* __restrict__ tinfo) {
    load_skinny<16>(sW, w_router, 16, 0);
    __syncthreads();
    const int tid = otid(); const int lane = tid & 63, wave = tid >> 6;
    for (int blk = blockIdx.x; blk < TOK / 64; blk += gridDim.x) {
        if (tid < 16) rl->cnt[tid] = 0;
        __syncthreads();
        for (int rr = 0; rr < 8; ++rr) {
            const int lr = wave * 8 + rr, row = blk * 64 + lr;
            float v[16]; load_row_f32(Z + (size_t)row * DM, v, lane);
            layer_norm_row(v, g, b, lane);
            store_row_f32(X1 + (size_t)row * DM, v, lane);
            store_row_bf16(XH + (size_t)row * DM, v, lane);
            float o[16]; skinny_dot<16>(sW, v, o);
            float aff[16], sel[16];
#pragma unroll
            for (int e = 0; e < 16; ++e) { aff[e] = 1.f / (1.f + expf(-o[e])); sel[e] = aff[e] + rbias[e]; }
            int bestg = 0; float bests = -1e30f;
#pragma unroll
            for (int gi = 0; gi < 4; ++gi) {
                float m1 = -1e30f, m2 = -1e30f;
#pragma unroll
                for (int j = 0; j < 4; ++j) { const float s = sel[gi * 4 + j]; if (s > m1) { m2 = m1; m1 = s; } else if (s > m2) m2 = s; }
                const float gs = m1 + m2;
                if (gs > bests) { bests = gs; bestg = gi; }
            }
            int i0 = 0, i1 = 0; float s0 = -1e30f, s1 = -1e30f, a0 = 0.f, a1 = 0.f;
#pragma unroll
            for (int e = 0; e < 16; ++e) {
                const bool in = (e >> 2) == bestg;
                const float s = sel[e];
                if (in) { if (s > s0) { s1 = s0; i1 = i0; a1 = a0; s0 = s; i0 = e; a0 = aff[e]; } else if (s > s1) { s1 = s; i1 = e; a1 = aff[e]; } }
            }
            if (lane == 0) { const float inv = 1.f / (a0 + a1); rl->e0[lr] = i0; rl->e1[lr] = i1; rl->w0[lr] = a0 * inv; rl->w1[lr] = a1 * inv; }
        }
        __syncthreads();
        if (tid < 64) { rl->lp0[tid] = atomicAdd((int*)&rl->cnt[rl->e0[tid]], 1); rl->lp1[tid] = atomicAdd((int*)&rl->cnt[rl->e1[tid]], 1); }
        __syncthreads();
        if (tid < 16) rl->base[tid] = (int)atomicAdd(gcnt + tid, (u32)rl->cnt[tid]);
        __syncthreads();
        if (tid < 64) {
            const int row = blk * 64 + tid;
            const int e0 = rl->e0[tid], e1 = rl->e1[tid];
            const int p0 = rl->base[e0] + rl->lp0[tid], p1 = rl->base[e1] + rl->lp1[tid];
            slot_tok[e0 * 16384 + p0] = row; slot_tok[e1 * 16384 + p1] = row;
            int4 a; a.x = e0; a.y = p0; a.z = e1; a.w = p1;
            *reinterpret_cast<int4*>(tinfo + (size_t)row * 8) = a;
            float2 w; w.x = rl->w0[tid]; w.y = rl->w1[tid];
            *reinterpret_cast<float2*>(tinfo + (size_t)row * 8 + 4) = w;
        }
        __syncthreads();
    }
}

__device__ __forceinline__ void phase_rows_ln2(float* sW, LAS MoeMap* mp, const u32* __restrict__ gcnt, const float* __restrict__ X1, const u16* __restrict__ Y, const int* __restrict__ tinfo,
                               const float* __restrict__ g, const float* __restrict__ b, float* __restrict__ X2, u16* __restrict__ XH,
                               const float* __restrict__ w_in_next, float* __restrict__ LR) {
    moe_build_map(mp, gcnt);
    if (w_in_next) { load_skinny<32>(sW, w_in_next, IN_COLS, 1536); __syncthreads(); }
    const int tid_ = otid(); const int lane = tid_ & 63, wave = tid_ >> 6;
    for (int row = blockIdx.x * 8 + wave; row < TOK; row += gridDim.x * 8) {
        const int4 a = *reinterpret_cast<const int4*>(tinfo + (size_t)row * 8);
        const float2 w = *reinterpret_cast<const float2*>(tinfo + (size_t)row * 8 + 4);
        const size_t r0 = (size_t)(mp->toff[a.x] * 256 + a.y), r1 = (size_t)(mp->toff[a.z] * 256 + a.w);
        float v[16]; load_row_f32(X1 + (size_t)row * DM, v, lane);
#pragma unroll
        for (int i = 0; i < 4; ++i) {
            const uint2 y0 = *reinterpret_cast<const uint2*>(Y + r0 * 1024 + i * 256 + lane * 4);
            const uint2 y1 = *reinterpret_cast<const uint2*>(Y + r1 * 1024 + i * 256 + lane * 4);
            v[i * 4 + 0] = ALPHA * v[i * 4 + 0] + w.x * bf2f((u16)(y0.x & 0xffff)) + w.y * bf2f((u16)(y1.x & 0xffff));
            v[i * 4 + 1] = ALPHA * v[i * 4 + 1] + w.x * bf2f((u16)(y0.x >> 16)) + w.y * bf2f((u16)(y1.x >> 16));
            v[i * 4 + 2] = ALPHA * v[i * 4 + 2] + w.x * bf2f((u16)(y0.y & 0xffff)) + w.y * bf2f((u16)(y1.y & 0xffff));
            v[i * 4 + 3] = ALPHA * v[i * 4 + 3] + w.x * bf2f((u16)(y0.y >> 16)) + w.y * bf2f((u16)(y1.y >> 16));
        }
        layer_norm_row(v, g, b, lane);
        store_row_f32(X2 + (size_t)row * DM, v, lane);
        store_row_bf16(XH + (size_t)row * DM, v, lane);
        if (w_in_next) {
            float o[32]; skinny_dot<32>(sW, v, o);
            if (lane < 32) { float r = 0.f;
#pragma unroll
                for (int e = 0; e < 32; ++e) r = (lane == e) ? o[e] : r;
                LR[(size_t)row * 32 + lane] = r; }
        }
    }
}

__device__ __forceinline__ void phase_rows_pool(const float* __restrict__ X, u16* __restrict__ MIX) {
    const int tid_ = otid(); const int lane = tid_ & 63, wave = tid_ >> 6;
    for (int row = blockIdx.x * 8 + wave; row < TOK; row += gridDim.x * 8) {
        const int pos = row & (SEQ - 1), rb = row - pos;
        float v[16];
#pragma unroll
        for (int i = 0; i < 4; ++i) {
            const int half = 1 << i;
            const int lo = max(pos - half, 0), hi = min(pos + half, SEQ);
            float4 s = make_float4(0.f, 0.f, 0.f, 0.f);
            for (int t = lo; t < hi; ++t) { const float4 q = *reinterpret_cast<const float4*>(X + (size_t)(rb + t) * DM + i * 256 + lane * 4); s.x += q.x; s.y += q.y; s.z += q.z; s.w += q.w; }
            const float4 c = *reinterpret_cast<const float4*>(X + (size_t)row * DM + i * 256 + lane * 4);
            const float inv = 1.f / (float)(hi - lo);
            v[i * 4] = s.x * inv - c.x; v[i * 4 + 1] = s.y * inv - c.y; v[i * 4 + 2] = s.z * inv - c.z; v[i * 4 + 3] = s.w * inv - c.w;
        }
        store_row_bf16(MIX + (size_t)row * DM, v, lane);
    }
}

__device__ __forceinline__ float log_sigmoid_(float x) {
    return fminf(x, 0.f) - 0.6931471805599453f * __builtin_amdgcn_logf(1.f + __builtin_amdgcn_exp2f(-1.4426950408889634f * fabsf(x))); }
constexpr int GROW = 72;
constexpr int GL_SB = 0;
constexpr int GL_LR = GL_SB + 32768;
constexpr int GL_TOT = GL_LR + 8192;
constexpr int GL_T0 = GL_TOT + 2048;
constexpr int GL_VT = GL_T0 + 3 * 9216;
constexpr int GL_PT = GL_VT + 18432;
constexpr int GL_RED = GL_PT + 18432;
constexpr int GL_END = GL_RED + 1024;
struct GateRegs { float4 lr4; float w[16]; float bias; };
__device__ __forceinline__ void gla_gates_issue(GateRegs& g, const float* __restrict__ LR, const float* __restrict__ wgg, const float* __restrict__ bgg, int t0, int hd) {
    const int tid = otid();
    g.lr4 = *reinterpret_cast<const float4*>(LR + (size_t)t0 * 32 + tid * 4);
    const int d = tid >> 8, kk = tid & 63;
#pragma unroll
    for (int r = 0; r < 16; ++r) g.w[r] = wgg[(d * 16 + r) * 256 + hd * 64 + kk];
    g.bias = bgg[d * 256 + hd * 64 + kk];
}
__device__ __forceinline__ void gla_gates(char* lds, const GateRegs& g) {
    float* sb = reinterpret_cast<float*>(lds + GL_SB);
    float* slr = reinterpret_cast<float*>(lds + GL_LR);
    float* stot = reinterpret_cast<float*>(lds + GL_TOT);
    const int tid = otid();
    *reinterpret_cast<float4*>(slr + tid * 4) = g.lr4;
    const int d = tid >> 8, jq = (tid >> 6) & 3, kk = tid & 63;
    __syncthreads();
    float la[16];
#pragma unroll
    for (int jj = 0; jj < 16; ++jj) {
        const float* lrow = slr + (jq * 16 + jj) * 32 + d * 16;
        float a = g.bias;
#pragma unroll
        for (int r4 = 0; r4 < 16; r4 += 4) { const float4 l4 = *reinterpret_cast<const float4*>(lrow + r4); a += l4.x * g.w[r4] + l4.y * g.w[r4 + 1] + l4.z * g.w[r4 + 2] + l4.w * g.w[r4 + 3]; }
        la[jj] = log_sigmoid_(a) * (1.f / 16.f);
    }
    if (d == 0) {
#pragma unroll
        for (int jj = 1; jj < 16; ++jj) la[jj] += la[jj - 1];
        stot[(d * 4 + jq) * 64 + kk] = la[15];
    } else {
#pragma unroll
        for (int jj = 14; jj >= 0; --jj) la[jj] += la[jj + 1];
        stot[(d * 4 + jq) * 64 + kk] = la[0];
    }
    __syncthreads();
    float off = 0.f;
#pragma unroll
    for (int q = 0; q < 4; ++q) { const float tq = stot[(d * 4 + q) * 64 + kk]; off += ((d == 0) ? (q < jq) : (q > jq)) ? tq : 0.f; }
#pragma unroll
    for (int jj = 0; jj < 16; ++jj) sb[d * 4096 + (jq * 16 + jj) * 64 + kk] = la[jj] + off;
    __syncthreads();
}
__device__ __forceinline__ void gla_tile128_issue(u32x4 (&r)[2], const u16* __restrict__ src, size_t src_ld) {
    const int tid = otid();
#pragma unroll
    for (int i = 0; i < 2; ++i) { const int p = tid + i * 512, row = p >> 3, c = (p & 7) * 8; r[i] = *reinterpret_cast<const u32x4*>(src + (size_t)row * src_ld + c); }
}
__device__ __forceinline__ void gla_tile128_write(char* dst, const u32x4 (&r)[2]) {
    const int tid = otid();
#pragma unroll
    for (int i = 0; i < 2; ++i) { const int p = tid + i * 512, row = p >> 3, c = (p & 7) * 8; *reinterpret_cast<u32x4*>(dst + (row * GROW + c) * 2) = r[i]; }
}
__device__ __forceinline__ void phase_gla_g1(char* lds, const u16* __restrict__ Hb, const u16* __restrict__ GVt, const float* __restrict__ LR,
                                             const float* __restrict__ wgg, const float* __restrict__ bgg, float* __restrict__ ST, float* __restrict__ DEC) {
    const int tid = otid(), lane = tid & 63, wave = tid >> 6, lq = lane & 31, hh = lane >> 5;
    const float* sb = reinterpret_cast<const float*>(lds + GL_SB);
    for (int item = blockIdx.x; item < 1024; item += gridDim.x) {
        const int c = item & 31, hd = (item >> 5) & 3, b = item >> 7;
        const int t0 = b * SEQ + c * 64;
        GateRegs gr; gla_gates_issue(gr, LR, wgg, bgg, t0, hd);
        u32x4 vreg[2]; gla_tile128_issue(vreg, GVt + ((size_t)(b * 4 + hd) * 128) * SEQ + c * 64, SEQ);
        const int kk = tid & 63, jg = tid >> 6;
        u16 kraw[8];
#pragma unroll
        for (int jj = 0; jj < 8; ++jj) kraw[jj] = Hb[(size_t)(t0 + jg * 8 + jj) * HC + 256 + hd * 64 + kk];
        gla_gates(lds, gr);
        gla_tile128_write(lds + GL_VT, vreg);
#pragma unroll
        for (int d = 0; d < 2; ++d) {
            const float bend = d == 0 ? sb[63 * 64 + kk] : sb[4096 + kk];
            u16* dstT = reinterpret_cast<u16*>(lds + GL_T0 + d * 9216) + kk * GROW + jg * 8;
            float v[8];
#pragma unroll
            for (int jj = 0; jj < 8; ++jj) v[jj] = bf2f(kraw[jj]) * __expf(bend - sb[d * 4096 + (jg * 8 + jj) * 64 + kk]);
            uint4 o; o.x = pack2(v[0], v[1]); o.y = pack2(v[2], v[3]); o.z = pack2(v[4], v[5]); o.w = pack2(v[6], v[7]);
            *reinterpret_cast<uint4*>(dstT) = o;
            if (jg == 0) DEC[((size_t)item * 2 + d) * 64 + kk] = __expf(bend);
        }
        __syncthreads();
        {
            const int d = wave >> 2, vb = wave & 3;
            f32x16 acc[2];
#pragma unroll
            for (int kt = 0; kt < 2; ++kt)
#pragma unroll
                for (int i = 0; i < 16; ++i) acc[kt][i] = 0.f;
            const char* khT = lds + GL_T0 + d * 9216;
            const char* vT = lds + GL_VT;
#pragma unroll
            for (int ks = 0; ks < 4; ++ks) {
                const bf16x8 bf = *reinterpret_cast<const bf16x8*>(vT + ((vb * 32 + lq) * GROW + ks * 16 + hh * 8) * 2);
#pragma unroll
                for (int kt = 0; kt < 2; ++kt) {
                    const bf16x8 af = *reinterpret_cast<const bf16x8*>(khT + ((kt * 32 + lq) * GROW + ks * 16 + hh * 8) * 2);
                    acc[kt] = __builtin_amdgcn_mfma_f32_32x32x16_bf16(af, bf, acc[kt], 0, 0, 0);
                }
            }
            float* dst = ST + ((size_t)item * 2 + d) * 8192 + (size_t)(vb * 32 + lq) * 64;
#pragma unroll
            for (int kt = 0; kt < 2; ++kt)
#pragma unroll
                for (int g4 = 0; g4 < 4; ++g4)
                    *reinterpret_cast<float4*>(dst + kt * 32 + g4 * 8 + hh * 4) = make_float4(acc[kt][g4 * 4], acc[kt][g4 * 4 + 1], acc[kt][g4 * 4 + 2], acc[kt][g4 * 4 + 3]);
        }
        __syncthreads();
    }
}

__device__ __forceinline__ void phase_gla_g2(const float* __restrict__ ST, const float* __restrict__ DEC, u16* __restrict__ PS) {
    const int nwork = 64 * 2048;
    for (int w = blockIdx.x * NTHR + otid(); w < nwork; w += gridDim.x * NTHR) {
        const int e4 = w & 2047, bhd = w >> 11, d = bhd & 1, bh = bhd >> 1;
        const int kk4 = (e4 & 15) * 4;
        float4 st = make_float4(0.f, 0.f, 0.f, 0.f);
#pragma unroll 4
        for (int s = 0; s < 32; ++s) {
            const int c = d == 0 ? s : 31 - s;
            const size_t item = (size_t)bh * 32 + c;
            const float4 ds = *(reinterpret_cast<const float4*>(ST + (item * 2 + d) * 8192) + e4);
            const float4 dec = *reinterpret_cast<const float4*>(DEC + (item * 2 + d) * 64 + kk4);
            uint2 o; o.x = pack2(st.x, st.y); o.y = pack2(st.z, st.w);
            *(reinterpret_cast<uint2*>(PS + (item * 2 + d) * 8192) + e4) = o;
            st.x = dec.x * st.x + ds.x; st.y = dec.y * st.y + ds.y; st.z = dec.z * st.z + ds.z; st.w = dec.w * st.w + ds.w;
        }
    }
}

__device__ __forceinline__ void phase_gla_g3(char* lds, const u16* __restrict__ Hb, const u16* __restrict__ GVt, const float* __restrict__ LR,
                                             const float* __restrict__ wgg, const float* __restrict__ bgg, const u16* __restrict__ PS,
                                             const float* __restrict__ gnorm, u16* __restrict__ MIX) {
    const int tid = otid(), lane = tid & 63, wave = tid >> 6, lq = lane & 31, hh = lane >> 5;
    const int ib = wave & 1, vb = wave >> 1;
    const int pi_lq = (lq & 0x13) | ((lq & 4) << 1) | ((lq & 8) >> 1);
    const float* sb = reinterpret_cast<const float*>(lds + GL_SB);
    float* red = reinterpret_cast<float*>(lds + GL_RED);
    u16* tQt = reinterpret_cast<u16*>(lds + GL_T0);
    u16* tKt = reinterpret_cast<u16*>(lds + GL_T0 + 9216);
    u16* tQh = reinterpret_cast<u16*>(lds + GL_T0 + 2 * 9216);
    for (int item = blockIdx.x; item < 1024; item += gridDim.x) {
        const int c = item & 31, hd = (item >> 5) & 3, b = item >> 7;
        const int t0 = b * SEQ + c * 64;
        GateRegs gr; gla_gates_issue(gr, LR, wgg, bgg, t0, hd);
        u32x4 vreg[2], preg0[2], preg1[2];
        gla_tile128_issue(vreg, GVt + ((size_t)(b * 4 + hd) * 128) * SEQ + c * 64, SEQ);
        gla_tile128_issue(preg0, PS + ((size_t)item * 2 + 0) * 8192, 64);
        gla_tile128_issue(preg1, PS + ((size_t)item * 2 + 1) * 8192, 64);
        const int kk = (tid & 31) * 2, jr = tid >> 5;
        u32 qraw[4], kraw[4];
#pragma unroll
        for (int ps = 0; ps < 4; ++ps) {
            qraw[ps] = *reinterpret_cast<const u32*>(Hb + (size_t)(t0 + jr + ps * 16) * HC + hd * 64 + kk);
            kraw[ps] = *reinterpret_cast<const u32*>(Hb + (size_t)(t0 + jr + ps * 16) * HC + 256 + hd * 64 + kk);
        }
        uint2 graw[4];
#pragma unroll
        for (int g4 = 0; g4 < 4; ++g4) graw[g4] = *reinterpret_cast<const uint2*>(Hb + (size_t)(t0 + ib * 32 + lq) * HC + 1024 + hd * 128 + vb * 32 + g4 * 8 + hh * 4);
        gla_gates(lds, gr);
        gla_tile128_write(lds + GL_VT, vreg);
        f32x16 oacc;
#pragma unroll
        for (int i = 0; i < 16; ++i) oacc[i] = 0.f;
#pragma unroll
        for (int d = 0; d < 2; ++d) {
            {
                const float* bd = sb + d * 4096;
                const int mid = d == 0 ? 31 : 32;
                const float bm0 = bd[mid * 64 + kk], bm1 = bd[mid * 64 + kk + 1];
                const float em0 = __expf(bm0), em1 = __expf(bm1);
#pragma unroll
                for (int ps = 0; ps < 4; ++ps) {
                    const int j = jr + ps * 16;
                    const float2 bj = *reinterpret_cast<const float2*>(bd + j * 64 + kk);
                    const float e0 = __expf(bj.x - bm0), e1 = __expf(bj.y - bm1);
                    const float q0 = bf2f((u16)(qraw[ps] & 0xffff)) * 0.125f * e0, q1 = bf2f((u16)(qraw[ps] >> 16)) * 0.125f * e1;
                    const float k0 = bf2f((u16)(kraw[ps] & 0xffff)) * __builtin_amdgcn_rcpf(e0), k1 = bf2f((u16)(kraw[ps] >> 16)) * __builtin_amdgcn_rcpf(e1);
                    *reinterpret_cast<u32*>(tQt + j * GROW + kk) = pack2(q0, q1);
                    *reinterpret_cast<u32*>(tKt + j * GROW + kk) = pack2(k0, k1);
                    *reinterpret_cast<u32*>(tQh + j * GROW + kk) = pack2(q0 * em0, q1 * em1);
                }
            }
            if (d == 0) gla_tile128_write(lds + GL_PT, preg0); else gla_tile128_write(lds + GL_PT, preg1);
            __syncthreads();
            f32x16 sacc[2];
#pragma unroll
            for (int jt = 0; jt < 2; ++jt) {
#pragma unroll
                for (int i = 0; i < 16; ++i) sacc[jt][i] = 0.f;
#pragma unroll
                for (int ks = 0; ks < 4; ++ks) {
                    const bf16x8 af = *reinterpret_cast<const bf16x8*>(reinterpret_cast<const char*>(tKt) + ((jt * 32 + pi_lq) * GROW + ks * 16 + hh * 8) * 2);
                    const bf16x8 bf = *reinterpret_cast<const bf16x8*>(reinterpret_cast<const char*>(tQt) + ((ib * 32 + lq) * GROW + ks * 16 + hh * 8) * 2);
                    sacc[jt] = __builtin_amdgcn_mfma_f32_32x32x16_bf16(af, bf, sacc[jt], 0, 0, 0);
                }
            }
            const int iq = ib * 32 + lq;
            bf16x8 pf[4];
#pragma unroll
            for (int jt = 0; jt < 2; ++jt)
#pragma unroll
                for (int s2 = 0; s2 < 2; ++s2) {
                    float pv[8];
#pragma unroll
                    for (int jj = 0; jj < 8; ++jj) {
                        const int j = jt * 32 + s2 * 16 + hh * 8 + jj;
                        const bool keep = d == 0 ? (j <= iq) : (j > iq);
                        pv[jj] = keep ? sacc[jt][s2 * 8 + jj] : 0.f;
                    }
                    union { bf16x8 v; u32 w[4]; } cv;
                    cv.w[0] = pack2(pv[0], pv[1]); cv.w[1] = pack2(pv[2], pv[3]); cv.w[2] = pack2(pv[4], pv[5]); cv.w[3] = pack2(pv[6], pv[7]);
                    pf[jt * 2 + s2] = cv.v;
                }
            const char* vT = lds + GL_VT;
            const char* pT = lds + GL_PT;
#pragma unroll
            for (int jt = 0; jt < 2; ++jt)
#pragma unroll
                for (int s2 = 0; s2 < 2; ++s2) {
                    const bf16x8 af = *reinterpret_cast<const bf16x8*>(vT + ((vb * 32 + lq) * GROW + jt * 32 + s2 * 16 + hh * 8) * 2);
                    oacc = __builtin_amdgcn_mfma_f32_32x32x16_bf16(af, pf[jt * 2 + s2], oacc, 0, 0, 0);
                }
#pragma unroll
            for (int ks = 0; ks < 4; ++ks) {
                const bf16x8 af = *reinterpret_cast<const bf16x8*>(pT + ((vb * 32 + lq) * GROW + ks * 16 + hh * 8) * 2);
                const bf16x8 bf = *reinterpret_cast<const bf16x8*>(reinterpret_cast<const char*>(tQh) + ((ib * 32 + lq) * GROW + ks * 16 + hh * 8) * 2);
                oacc = __builtin_amdgcn_mfma_f32_32x32x16_bf16(af, bf, oacc, 0, 0, 0);
            }
            __syncthreads();
        }
        float ss = 0.f;
#pragma unroll
        for (int i = 0; i < 16; ++i) ss += oacc[i] * oacc[i];
        ss += __shfl_xor(ss, 32);
        if (hh == 0) red[vb * 64 + ib * 32 + lq] = ss;
        __syncthreads();
        const int iq = ib * 32 + lq;
        const float tot = red[iq] + red[64 + iq] + red[128 + iq] + red[192 + iq];
        const float rs = rsqrtf(tot * (1.f / 128.f) + RMS_EPS);
        const int t = t0 + iq;
#pragma unroll
        for (int g4 = 0; g4 < 4; ++g4) {
            const int vv = vb * 32 + g4 * 8 + hh * 4;
            const float4 gn = *reinterpret_cast<const float4*>(gnorm + vv);
            const uint2 gg = graw[g4];
            const float g0 = bf2f((u16)(gg.x & 0xffff)), g1 = bf2f((u16)(gg.x >> 16)), g2 = bf2f((u16)(gg.y & 0xffff)), g3 = bf2f((u16)(gg.y >> 16));
            uint2 ov;
            ov.x = pack2(oacc[g4 * 4] * rs * gn.x * (g0 * sigmoidf_(g0)), oacc[g4 * 4 + 1] * rs * gn.y * (g1 * sigmoidf_(g1)));
            ov.y = pack2(oacc[g4 * 4 + 2] * rs * gn.z * (g2 * sigmoidf_(g2)), oacc[g4 * 4 + 3] * rs * gn.w * (g3 * sigmoidf_(g3)));
            *reinterpret_cast<uint2*>(MIX + (size_t)t * DM + hd * 128 + vv) = ov;
        }
        __syncthreads();
    }
}

constexpr int KROW = 136, VROW = 72;
constexpr int ATT_KBYTES = 64 * KROW * 2, ATT_VBYTES = 128 * VROW * 2;
constexpr int ATT_BUF = ATT_KBYTES + ATT_VBYTES;
constexpr int ATT_TBL = 2 * ATT_BUF;
constexpr int ATT_MISC = ATT_TBL + 4096 * 4;
__device__ __forceinline__ int t5_bucket(int rel) {
    const int n = rel < 0 ? -rel : rel;
    int v;
    if (n < 8) v = n;
    else v = 8 + (n >= 12) + (n >= 16) + (n >= 23) + (n >= 32) + (n >= 46) + (n >= 64) + (n >= 91);
    return v + (rel > 0 ? 16 : 0);
}
__device__ __forceinline__ void phase_attn(char* lds, const u16* __restrict__ Hb, const u16* __restrict__ Vt, const float* __restrict__ relb, const float* __restrict__ dlam,
                           const float* __restrict__ dnorm, float lam_init, u16* __restrict__ MIX) {
    const int tid = otid(), lane = tid & 63, wave = tid >> 6, map = wave >> 2, qsub = wave & 3, lq = lane & 31, hh = lane >> 5;
    float* tbl = reinterpret_cast<float*>(lds + ATT_TBL);
    float* misc = reinterpret_cast<float*>(lds + ATT_MISC);
    const float LOG2E = 1.4426950408889634f;
    if (wave == 0) {
        float a = dlam[lane] * dlam[64 + lane], bq = dlam[128 + lane] * dlam[192 + lane];
        a = wave_sum(a); bq = wave_sum(bq);
        if (lane == 0) misc[0] = expf(a) - expf(bq) + lam_init;
    }
    __syncthreads();
    const float lam_full = misc[0];
    const int pi_lq = (lq & 0x13) | ((lq & 4) << 1) | ((lq & 8) >> 1);
    for (int item = blockIdx.x; item < 512; item += gridDim.x) {
        const int qb = item & 15, hd = (item >> 4) & 3, b = item >> 6;
        for (int i = tid; i < 4095; i += NTHR) tbl[i] = relb[t5_bucket(i - 2047) * 4 + hd] * LOG2E;
        const float c_lo = relb[15 * 4 + hd] * LOG2E, c_hi = relb[31 * 4 + hd] * LOG2E;
        const int q0 = qb * 128 + qsub * 32;
        const size_t trow = (size_t)b * SEQ;
        bf16x8 qf[4];
#pragma unroll
        for (int ks = 0; ks < 4; ++ks)
            qf[ks] = *reinterpret_cast<const bf16x8*>(Hb + (trow + q0 + lq) * HC + 1536 + hd * 128 + map * 64 + ks * 16 + hh * 8);
        f32x16 oacc[4];
#pragma unroll
        for (int db = 0; db < 4; ++db)
#pragma unroll
            for (int i = 0; i < 16; ++i) oacc[db][i] = 0.f;
        float m_run = -1e30f, l_run = 0.f;
        const u16* kbase = Hb + trow * HC + 2048 + hd * 128;
        const u16* vbase = Vt + ((size_t)(b * 4 + hd) * 128) * SEQ;
        uint4 kreg[2], vreg[2];
#define ATT_LOAD(k0) do { \
            for (int i_ = 0; i_ < 2; ++i_) { const int p_ = tid + i_ * 512; \
                kreg[i_] = *reinterpret_cast<const uint4*>(kbase + (size_t)((k0) + (p_ >> 4)) * HC + (p_ & 15) * 8); \
                vreg[i_] = *reinterpret_cast<const uint4*>(vbase + (size_t)(p_ >> 3) * SEQ + (k0) + (p_ & 7) * 8); } } while (0)
#define ATT_WRITE(buf) do { char* kb_ = lds + (buf) * ATT_BUF; char* vb_ = kb_ + ATT_KBYTES; \
            for (int i_ = 0; i_ < 2; ++i_) { const int p_ = tid + i_ * 512; \
                *reinterpret_cast<uint4*>(kb_ + ((p_ >> 4) * KROW + (p_ & 15) * 8) * 2) = kreg[i_]; \
                *reinterpret_cast<uint4*>(vb_ + ((p_ >> 3) * VROW + (p_ & 7) * 8) * 2) = vreg[i_]; } } while (0)
        ATT_LOAD(0);
        ATT_WRITE(0);
        __syncthreads();
        for (int kt = 0; kt < 32; ++kt) {
            const int k0 = kt * 64;
            if (kt + 1 < 32) ATT_LOAD(k0 + 64);
            const char* kb = lds + (kt & 1) * ATT_BUF;
            const char* vb = kb + ATT_KBYTES;
            f32x16 sacc[2];
#pragma unroll
            for (int st = 0; st < 2; ++st) {
#pragma unroll
                for (int i = 0; i < 16; ++i) sacc[st][i] = 0.f;
#pragma unroll
                for (int ks = 0; ks < 4; ++ks) {
                    const bf16x8 kf = *reinterpret_cast<const bf16x8*>(kb + ((st * 32 + pi_lq) * KROW + map * 64 + ks * 16 + hh * 8) * 2);
                    sacc[st] = __builtin_amdgcn_mfma_f32_32x32x16_bf16(kf, qf[ks], sacc[st], 0, 0, 0);
                }
            }
            const float c1 = 0.125f * LOG2E;
            float mx = -1e30f;
            const bool far_hi = (k0 - (q0 + 31)) >= 128, far_lo = (q0 - (k0 + 63)) >= 128;
            if (far_hi || far_lo) {
                const float cb = far_hi ? c_hi : c_lo;
#pragma unroll
                for (int st = 0; st < 2; ++st)
#pragma unroll
                    for (int i = 0; i < 16; ++i) { const float s = sacc[st][i] * c1 + cb; sacc[st][i] = s; mx = fmaxf(mx, s); }
            } else {
                const int rbase = k0 - (q0 + lq) + 2047 + 8 * hh;
#pragma unroll
                for (int st = 0; st < 2; ++st)
#pragma unroll
                    for (int i = 0; i < 16; ++i) {
                        const int koff = st * 32 + (i & 3) + 4 * ((i >> 2) & 1) + 16 * (i >> 3);
                        const float s = sacc[st][i] * c1 + tbl[rbase + koff];
                        sacc[st][i] = s; mx = fmaxf(mx, s);
                    }
            }
            mx = fmaxf(mx, __shfl_xor(mx, 32));
            if (!__all(mx - m_run <= 8.f)) {
                const float m_new = fmaxf(m_run, mx);
                const float alpha = __builtin_amdgcn_exp2f(m_run - m_new);
                m_run = m_new; l_run *= alpha;
#pragma unroll
                for (int db = 0; db < 4; ++db)
#pragma unroll
                    for (int i = 0; i < 16; ++i) oacc[db][i] *= alpha;
            }
            float psum = 0.f;
            bf16x8 pf[4];
#pragma unroll
            for (int st = 0; st < 2; ++st)
#pragma unroll
                for (int s2 = 0; s2 < 2; ++s2) {
                    float pv[8];
#pragma unroll
                    for (int j = 0; j < 8; ++j) { pv[j] = __builtin_amdgcn_exp2f(sacc[st][s2 * 8 + j] - m_run); psum += pv[j]; }
                    union { bf16x8 v; u32 w[4]; } cv;
                    cv.w[0] = pack2(pv[0], pv[1]); cv.w[1] = pack2(pv[2], pv[3]); cv.w[2] = pack2(pv[4], pv[5]); cv.w[3] = pack2(pv[6], pv[7]);
                    pf[st * 2 + s2] = cv.v;
                }
            l_run += psum;
#pragma unroll
            for (int db = 0; db < 4; ++db)
#pragma unroll
                for (int st = 0; st < 2; ++st)
#pragma unroll
                    for (int s2 = 0; s2 < 2; ++s2) {
                        const bf16x8 vf = *reinterpret_cast<const bf16x8*>(vb + ((db * 32 + lq) * VROW + st * 32 + s2 * 16 + hh * 8) * 2);
                        oacc[db] = __builtin_amdgcn_mfma_f32_32x32x16_bf16(vf, pf[st * 2 + s2], oacc[db], 0, 0, 0);
                    }
            if (kt + 1 < 32) ATT_WRITE((kt + 1) & 1);
            __syncthreads();
        }
        const float l_tot = l_run + __shfl_xor(l_run, 32);
        float* xch = reinterpret_cast<float*>(lds);
        const int qrow = qsub * 32 + lq;
        if (map == 1) {
            const float sc = lam_full / l_tot;
#pragma unroll
            for (int db = 0; db < 4; ++db)
#pragma unroll
                for (int g4 = 0; g4 < 4; ++g4) {
                    const int dv = db * 32 + g4 * 8 + hh * 4;
                    *reinterpret_cast<float4*>(xch + qrow * 132 + dv) = make_float4(oacc[db][g4 * 4] * sc, oacc[db][g4 * 4 + 1] * sc, oacc[db][g4 * 4 + 2] * sc, oacc[db][g4 * 4 + 3] * sc);
                }
        }
        __syncthreads();
        if (map == 0) {
            const float inv = 1.f / l_tot;
            float ss = 0.f;
#pragma unroll
            for (int db = 0; db < 4; ++db)
#pragma unroll
                for (int g4 = 0; g4 < 4; ++g4) {
                    const int dv = db * 32 + g4 * 8 + hh * 4;
                    const float4 o1 = *reinterpret_cast<const float4*>(xch + qrow * 132 + dv);
                    float v0 = oacc[db][g4 * 4] * inv - o1.x, v1 = oacc[db][g4 * 4 + 1] * inv - o1.y, v2 = oacc[db][g4 * 4 + 2] * inv - o1.z, v3 = oacc[db][g4 * 4 + 3] * inv - o1.w;
                    oacc[db][g4 * 4] = v0; oacc[db][g4 * 4 + 1] = v1; oacc[db][g4 * 4 + 2] = v2; oacc[db][g4 * 4 + 3] = v3;
                    ss += v0 * v0 + v1 * v1 + v2 * v2 + v3 * v3;
                }
            ss += __shfl_xor(ss, 32);
            const float rs = rsqrtf(ss * (1.f / 128.f) + RMS_EPS) * (1.f - lam_init);
            u16* dst = MIX + (trow + q0 + lq) * DM + 512 + hd * 128;
#pragma unroll
            for (int db = 0; db < 4; ++db)
#pragma unroll
                for (int g4 = 0; g4 < 4; ++g4) {
                    const int dv = db * 32 + g4 * 8 + hh * 4;
                    const float4 nw = *reinterpret_cast<const float4*>(dnorm + dv);
                    uint2 ov; ov.x = pack2(oacc[db][g4 * 4] * rs * nw.x, oacc[db][g4 * 4 + 1] * rs * nw.y);
                    ov.y = pack2(oacc[db][g4 * 4 + 2] * rs * nw.z, oacc[db][g4 * 4 + 3] * rs * nw.w);
                    *reinterpret_cast<uint2*>(dst + dv) = ov;
                }
        }
        __syncthreads();
    }
#undef ATT_LOAD
#undef ATT_WRITE
}

constexpr int NPHASE = 1 + 9 * NLAYER;
__global__ void __launch_bounds__(NTHR, 2) fwd_kernel(Params p) {
    extern __shared__ __attribute__((aligned(16))) unsigned char lds[];
    unsigned char* ws = p.ws;
    const int lo = p.ph_lo, hi = p.ph_hi;
    volatile LAS unsigned* barw = (volatile LAS unsigned*)(lds + LDS_BARW);
    if (threadIdx.x == 0) { barw[0] = 0u; barw[1] = 0u; barw[2] = 0u; barw[3] = 0u; }
    __syncthreads();
    XcdBarrier bar; bar.bar = (unsigned*)(ws + WS_CTL); bar.x = 0; bar.st = barw;
    const bool multi = (hi - lo) > 1;
    if (multi) bar = xcd_barrier_post((unsigned*)(ws + WS_CTL), barw);
#define IN(k) (lo <= (k) && (k) < hi)
#define SEAM(k) do { if (IN(k) && IN((k) + 1)) xcd_barrier(bar); } while (0)

    u16* shm = reinterpret_cast<u16*>(lds);
    float* ldsf = reinterpret_cast<float*>(lds);
    LAS MoeMap* mp = (LAS MoeMap*)(lds + LDS_MOEMAP);
    u16* Wt_in = (u16*)(ws + WS_WIN); u16* Wt_out = (u16*)(ws + WS_WOUT); u16* Wt_pool = (u16*)(ws + WS_WPOOL);
    u16* Wt_g = (u16*)(ws + WS_WG); u16* Wt_u = (u16*)(ws + WS_WU); u16* Wt_d = (u16*)(ws + WS_WD);
    float* XA = (float*)(ws + WS_XA); float* XB = (float*)(ws + WS_XB);
    u16* XH = (u16*)(ws + WS_XH); u16* MIX = (u16*)(ws + WS_MIXIN);
    float* LR = (float*)(ws + WS_LR); u16* Vt = (u16*)(ws + WS_VT); u16* GVt = (u16*)(ws + WS_GVT); u16* PS = (u16*)(ws + WS_R2 + R2_PS);
    u16* Hb = (u16*)(ws + WS_R1); u16* Hmoe = (u16*)(ws + WS_R1);
    float* ST = (float*)(ws + WS_R2); float* Z = (float*)(ws + WS_R2); u16* Y = (u16*)(ws + WS_R2);
    int* slot_tok = (int*)(ws + WS_SLOT); int* tinfo = (int*)(ws + WS_TINFO); float* DEC = (float*)(ws + WS_DEC);
    u32* gcnt_all = (u32*)(ws + WS_CTL + CTL_CNT);

    if (IN(0)) {
        REPEAT(K_CONV) phase_convert((char*)lds, p);
        __syncthreads();
        REPEAT(K_ROWSP) phase_rows_prologue(ldsf, p.in[I_X], p.in[I_WIN], XH, LR);
    }
    SEAM(0);
    for (int L = 0; L < NLAYER; ++L) {
        const int base = 1 + 9 * L;
        const bool even = (L & 1) == 0;
        const int i2 = L >> 1;
        const float* xin = (L == 0) ? p.in[I_X] : XA;
        float* xout = (L == NLAYER - 1) ? p.out : XA;
        u32* gcnt = gcnt_all + L * 16;
        if (even) {
            if (IN(base + 0)) REPEAT(K_INPROJ) phase_inproj(shm, XH, Wt_in + (size_t)i2 * 3072 * 1024, Hb, Vt, GVt);
            SEAM(base + 0);
            if (IN(base + 1)) {
                const float lam_init = 0.8f - 0.6f * expf(-0.3f * (float)L);
                REPEAT(K_ATTN) phase_attn((char*)lds, Hb, Vt, p.in[I_RELB], p.in[I_DLAM] + i2 * 256, p.in[I_DNORM] + i2 * 128, lam_init, MIX);
                __syncthreads();
                REPEAT(K_G1) phase_gla_g1((char*)lds, Hb, GVt, LR, p.in[I_WGG] + i2 * 2 * 16 * 256, p.in[I_BGG] + i2 * 2 * 256, ST, DEC);
            }
            SEAM(base + 1);
            if (IN(base + 2)) phase_gla_g2(ST, DEC, PS);
            SEAM(base + 2);
            if (IN(base + 3)) REPEAT(K_G3) phase_gla_g3((char*)lds, Hb, GVt, LR, p.in[I_WGG] + i2 * 2 * 16 * 256, p.in[I_BGG] + i2 * 2 * 256, PS, p.in[I_GNORM] + i2 * 128, MIX);
            SEAM(base + 3);
            if (IN(base + 4)) REPEAT(K_MIXPROJ) phase_mixproj(shm, MIX, Wt_out + (size_t)i2 * 1048576, false, xin, nullptr, Z);
            SEAM(base + 4);
        } else {
            if (IN(base + 0)) REPEAT(K_POOL) phase_rows_pool(xin, MIX);
            if (IN(base + 0) && IN(base + 4)) xcd_barrier(bar);
            if (IN(base + 4)) REPEAT(K_MIXPROJ) phase_mixproj(shm, MIX, Wt_pool + (size_t)i2 * 4 * 65536, true, xin, p.in[I_PSCALE] + i2 * 1024, Z);
            SEAM(base + 4);
        }
        if (IN(base + 5)) phase_rows_ln1(ldsf, (LAS RouteLds*)(lds + 98304), Z, p.in[I_LNG] + (L * 2) * 1024, p.in[I_LNB] + (L * 2) * 1024,
                                         p.in[I_WR], p.in[I_RB], XB, XH, gcnt, slot_tok, tinfo);
        SEAM(base + 5);
        if (IN(base + 6)) REPEAT(K_MOE1) phase_moe1(shm, mp, gcnt, slot_tok, XH, Wt_g + (size_t)L * 16 * 1048576, Wt_u + (size_t)L * 16 * 1048576, Hmoe);
        SEAM(base + 6);
        if (IN(base + 7)) REPEAT(K_MOE2) phase_moe2(shm, mp, gcnt, Hmoe, Wt_d + (size_t)L * 16 * 1048576, Y);
        SEAM(base + 7);
        if (IN(base + 8)) REPEAT(K_LN2) phase_rows_ln2(ldsf, mp, gcnt, XB, Y, tinfo, p.in[I_LNG] + (L * 2 + 1) * 1024, p.in[I_LNB] + (L * 2 + 1) * 1024, xout, XH,
                                         (L + 1 < NLAYER && ((L + 1) & 1) == 0) ? p.in[I_WIN] + (size_t)((L + 1) >> 1) * 1024 * IN_COLS : nullptr, LR);
        SEAM(base + 8);
    }
#undef IN
#undef SEAM
}

extern "C" void kernel_launch(void* const* d_in, const int* in_sizes, int n_in, void* d_out, int out_size, void* d_ws, size_t ws_size, hipStream_t stream) {
    static int grid = 0;
    if (grid == 0) {
        if (n_in != 18 || ws_size < WS_END) { fprintf(stderr, "kernel_launch: unexpected inputs (n_in %d, ws %zu < %zu)\n", n_in, ws_size, (size_t)WS_END); grid = -1; return; }
        int dev = 0, cus = 0, per_cu = 0;
        hipGetDevice(&dev);
        hipDeviceGetAttribute(&cus, hipDeviceAttributeMultiprocessorCount, dev);
        if (hipFuncSetAttribute((const void*)fwd_kernel, hipFuncAttributeMaxDynamicSharedMemorySize, LDS_BYTES) != hipSuccess) { fprintf(stderr, "kernel_launch: hipFuncSetAttribute failed\n"); grid = -1; return; }
        if (hipOccupancyMaxActiveBlocksPerMultiprocessor(&per_cu, (const void*)fwd_kernel, NTHR, LDS_BYTES) != hipSuccess || per_cu < 1) {
            fprintf(stderr, "kernel_launch: occupancy query reports %d blocks per CU\n", per_cu); }
        (void)hipGetLastError();
        grid = cus;
    }
    if (grid < 0) return;
    hipMemsetAsync((char*)d_ws + WS_CTL, 0, CTL_BYTES, stream);
    Params p{};
    for (int i = 0; i < 18; ++i) p.in[i] = (const float*)d_in[i];
    p.out = (float*)d_out; p.ws = (unsigned char*)d_ws;
#if ONE_LAUNCH
    p.ph_lo = 0; p.ph_hi = NPHASE;
    hipLaunchKernelGGL(fwd_kernel, dim3(grid), dim3(NTHR), LDS_BYTES, stream, p);
#else
    for (int k = 0; k < NPHASE; ++k) {
        const int L = (k - 1) / 9, r = (k - 1) % 9;
        if (k > 0 && (L & 1) == 1 && (r == 1 || r == 2 || r == 3)) continue;
        p.ph_lo = k; p.ph_hi = k + 1;
        hipLaunchKernelGGL(fwd_kernel, dim3(grid), dim3(NTHR), LDS_BYTES, stream, p);
    }
#endif
}
```

```cpp
#include <hip/hip_runtime.h>
#include <stdint.h>
#include <stdio.h>

typedef unsigned short u16;
typedef unsigned int u32;
typedef __attribute__((ext_vector_type(8))) short bf16x8;
typedef __attribute__((ext_vector_type(4))) float f32x4;
typedef __attribute__((ext_vector_type(16))) float f32x16;
typedef __attribute__((ext_vector_type(4))) unsigned u32x4;
#define LAS __attribute__((address_space(3)))

#ifndef ONE_LAUNCH
#define ONE_LAUNCH 1
#endif
#ifndef REPMASK
#define REPMASK 0
#endif
#define REPS(kind) (1 + ((REPMASK >> (kind)) & 1))
#define REPEAT(kind) for (int rep_ = 0; rep_ < REPS(kind); ++rep_, __syncthreads())
enum { K_CONV = 0, K_INPROJ, K_ATTN, K_G1, K_G3, K_MIXPROJ, K_MOE1, K_MOE2, K_LN2, K_POOL, K_ROWSP };

constexpr int TOK = 16384, DM = 1024, SEQ = 2048, NBATCH = 8, NLAYER = 4;
constexpr int HC = 2560;
constexpr int NEXP = 16;
constexpr int IN_COLS = 3104;
constexpr float ALPHA = 1.681792830507429f;
constexpr float LN_EPS = 1e-5f, RMS_EPS = 1e-6f;
constexpr int NTHR = 512;
constexpr int LDS_BYTES = 163840 - 256;
constexpr int LDS_BARW = LDS_BYTES - 16;
constexpr int LDS_MOEMAP = LDS_BARW - 256;

constexpr size_t WS_CTL   = 0;
constexpr size_t CTL_BYTES = 65536;
constexpr size_t CTL_CNT  = 16384;
constexpr size_t CTL_CUR  = 20480;
constexpr size_t WS_WIN   = WS_CTL + CTL_BYTES;
constexpr size_t WS_WOUT  = WS_WIN + (size_t)2 * 3072 * 1024 * 2;
constexpr size_t WS_WPOOL = WS_WOUT + (size_t)2 * 1024 * 1024 * 2;
constexpr size_t WS_WG    = WS_WPOOL + (size_t)2 * 4 * 256 * 256 * 2;
constexpr size_t WS_WU    = WS_WG + (size_t)64 * 1048576 * 2;
constexpr size_t WS_WD    = WS_WU + (size_t)64 * 1048576 * 2;
constexpr size_t WS_XA    = WS_WD + (size_t)64 * 1048576 * 2;
constexpr size_t WS_XB    = WS_XA + (size_t)TOK * DM * 4;
constexpr size_t WS_XH    = WS_XB + (size_t)TOK * DM * 4;
constexpr size_t WS_MIXIN = WS_XH + (size_t)TOK * DM * 2;
constexpr size_t WS_LR    = WS_MIXIN + (size_t)TOK * DM * 2;
constexpr size_t WS_VT    = WS_LR + (size_t)TOK * 32 * 4;
constexpr size_t WS_GVT   = WS_VT + (size_t)TOK * 512 * 2;
constexpr size_t WS_R1    = WS_GVT + (size_t)TOK * 512 * 2;
constexpr size_t R1_BYTES = (size_t)TOK * HC * 2;
constexpr size_t WS_R2    = WS_R1 + R1_BYTES;
constexpr size_t YH_ELEMS = (size_t)36864 * 1024;
constexpr size_t R2_BYTES = (size_t)2 * YH_ELEMS * 2;
constexpr size_t R2_PS    = (size_t)64 * 1048576;
constexpr size_t WS_SLOT  = WS_R2 + R2_BYTES;
constexpr size_t WS_TINFO = WS_SLOT + (size_t)16 * 16384 * 4;
constexpr size_t WS_DEC   = WS_TINFO + (size_t)TOK * 32;
constexpr size_t WS_END   = WS_DEC + (size_t)1024 * 2 * 64 * 4;

typedef __attribute__((ext_vector_type(2))) __bf16 bf16x2_t;
__device__ __forceinline__ u16 f2bf(float f) { return __builtin_bit_cast(u16, (__bf16)f); }
__device__ __forceinline__ float bf2f(u16 h) { return __uint_as_float(((u32)h) << 16); }
__device__ __forceinline__ u32 pack2(float a, float b) { bf16x2_t v; v[0] = (__bf16)a; v[1] = (__bf16)b; return __builtin_bit_cast(u32, v); }
__device__ __forceinline__ float wave_sum(float v) {
#pragma unroll
    for (int o = 32; o > 0; o >>= 1) v += __shfl_xor(v, o);
    return v;
}
__device__ __forceinline__ int otid() { int t = threadIdx.x; asm volatile("" : "+v"(t)); return t; }
__device__ __forceinline__ unsigned char* ows(unsigned char* w) { asm volatile("" : "+s"(w)); return w; }
__device__ __forceinline__ float sigmoidf_(float x) { return 1.f / (1.f + __expf(-x)); }

#define XB_TMO      128
#define XB_XCNT(j)  (256  + 64 * (j))
#define XB_XSUB(j)  (1280 + 64 * (j))
#define XB_XGEN(j)  (2304 + 64 * (j))
#define XB_TOP      3328
#define XB_TOPGEN   3392
#define XCD_BAR_WORDS 3456
#define XB_SPIN_CAP (1u << 20)
__device__ __forceinline__ unsigned xb_ld(unsigned* p)              { return __hip_atomic_load(p, __ATOMIC_RELAXED, __HIP_MEMORY_SCOPE_AGENT); }
__device__ __forceinline__ unsigned xb_add(unsigned* p, unsigned v) { return __hip_atomic_fetch_add(p, v, __ATOMIC_RELAXED, __HIP_MEMORY_SCOPE_AGENT); }
__device__ __forceinline__ unsigned xb_xcc_id() { return (unsigned)__builtin_amdgcn_s_getreg((3 << 11) | 20) & 0xFu; }
#define XB_SPIN(cond, bar) do { unsigned _sp = 0; while (cond) { __builtin_amdgcn_s_sleep(1); \
    if ((++_sp & 255u) == 0u) { if (xb_ld(&(bar)[XB_TMO])) break; if (_sp > XB_SPIN_CAP) { atomicAdd(&(bar)[XB_TMO], 1u); break; } } } } while (0)
struct XcdBarrier { unsigned* bar; unsigned x; volatile LAS unsigned* st; };
__device__ __forceinline__ XcdBarrier xcd_barrier_post(unsigned* bar, volatile LAS unsigned* st) {
    XcdBarrier b; b.bar = bar; b.x = xb_xcc_id(); b.st = st;
    if (threadIdx.x == 0) (void)xb_add(&bar[XB_XCNT(b.x)], 1u);
    return b;
}
__device__ __forceinline__ void xcd_barrier_complete(unsigned* bar, unsigned x, unsigned& nloc, unsigned& nx) {
    const unsigned G = gridDim.x * gridDim.y * gridDim.z;
    unsigned sum, cnt, mine, sp = 0u;
    for (;;) {
        sum = 0u; cnt = 0u; mine = 0u;
#pragma unroll
        for (unsigned j = 0; j < 16; ++j) { const unsigned c = xb_ld(&bar[XB_XCNT(j)]); sum += c; cnt += (c > 0u) ? 1u : 0u; mine = (j == x) ? c : mine; }
        if (sum == G) break;
        __builtin_amdgcn_s_sleep(1);
        if ((++sp & 255u) == 0u) { if (xb_ld(&bar[XB_TMO])) break; if (sp > XB_SPIN_CAP) { atomicAdd(&bar[XB_TMO], 1u); break; } }
    }
    nloc = mine > 0u ? mine : 1u; nx = cnt > 0u ? cnt : 1u;
}
__device__ __forceinline__ void xcd_barrier(const XcdBarrier& b) {
    asm volatile("s_waitcnt vmcnt(0)" ::: "memory");
    __syncthreads();
    if (threadIdx.x == 0) {
        unsigned* bar = b.bar;
        __builtin_amdgcn_s_waitcnt(0);
        unsigned nloc = b.st[0], nx = b.st[1];
        if (nloc == 0u) { xcd_barrier_complete(bar, b.x, nloc, nx); b.st[0] = nloc; b.st[1] = nx; }
        const unsigned old = xb_add(&bar[XB_XSUB(b.x)], 1u);
        const unsigned gen = old / nloc;
        if (old + 1u == (gen + 1u) * nloc) {
            __builtin_amdgcn_fence(__ATOMIC_RELEASE, "agent");
            asm volatile("s_waitcnt vmcnt(0)" ::: "memory");
            const unsigned og = xb_add(&bar[XB_TOP], 1u);
            const unsigned tg = og / nx;
            if (og + 1u == (tg + 1u) * nx) xb_add(&bar[XB_TOPGEN], 1u);
            else XB_SPIN(xb_ld(&bar[XB_TOPGEN]) == tg, bar);
            __builtin_amdgcn_fence(__ATOMIC_ACQUIRE, "agent");
            xb_add(&bar[XB_XGEN(b.x)], 1u);
            asm volatile("s_waitcnt vmcnt(0)" ::: "memory");
        } else {
            XB_SPIN(xb_ld(&bar[XB_XGEN(b.x)]) == gen, bar);
            __builtin_amdgcn_fence(__ATOMIC_ACQUIRE, "agent");
            asm volatile("s_waitcnt vmcnt(0)" ::: "memory");
        }
    }
    __syncthreads();
}

struct Params {
    const float* in[18];
    float* out;
    unsigned char* ws;
    int ph_lo, ph_hi;
};
enum { I_X = 0, I_RELB, I_WIN, I_WGG, I_BGG, I_GNORM, I_DLAM, I_DNORM, I_WOUT, I_WPOOL, I_PSCALE, I_LNG, I_LNB, I_WR, I_RB, I_WG, I_WU, I_WD };

constexpr int BK = 64, HALF = 128, HT = HALF * BK;
__device__ __forceinline__ int lds_byte(int r, int c) {
    int st = (r >> 4) * 2 + (c >> 5), rr = r & 15, cc = c & 31, ob = rr * 64 + cc * 2;
    return st * 1024 + (ob ^ (((ob >> 9) & 1) << 5));
}
__device__ __forceinline__ void stage_rc(int b, int& R, int& C) {
    int st = b / 1024, sb = b % 1024, swz = sb ^ (((sb >> 9) & 1) << 5);
    R = (st >> 1) * 16 + swz / 64; C = (st & 1) * 32 + (swz % 64) / 2;
}
__device__ __forceinline__ int perm32(int rho) { const int n = rho >> 4, i = rho & 15; return 8 * (i >> 2) + 4 * n + (i & 3); }

#define WAIT_V(n) asm volatile("s_waitcnt vmcnt(" #n ")" ::: "memory")
#define WAIT_L(n) asm volatile("s_waitcnt lgkmcnt(" #n ")" ::: "memory")
#define BAR __builtin_amdgcn_s_barrier()
#define SCHED __builtin_amdgcn_sched_barrier(0)

__device__ __forceinline__ int grow_of(int w, int q) { asm volatile("" : "+v"(w)); return (int)(((unsigned)w >> (16 * (q & 1))) & 0x3fffu); }
struct GUnit { const u16* A; const u16* B0; const u16* B1; int aq[4]; int i0, i1, i2; };

template <class P>
__device__ __forceinline__ void gemm_stream(u16* shm, const P& ph) {
#define SA(b, h) (shm + ((b) * 2 + (h)) * HT)
#define SB(b, h) (shm + (4 + (b) * 2 + (h)) * HT)
#define GLDS(src, dst) __builtin_amdgcn_global_load_lds((const unsigned*)(src), (unsigned*)(dst), 16, 0, 0)
#define GLDS_O(base, off, dst) do { int _o = (off); asm volatile("" : "+v"(_o)); GLDS((base) + _o, dst); } while (0)
#define GLDS_OC(base, off, cadd, dst) do { int _o = (off); asm volatile("" : "+v"(_o)); GLDS((base) + (_o + (cadd)), dst); } while (0)
#define GROW_OF(w, q) (grow_of((w), (q)) * P::LDA + (bo & 63))
#define AQ1(U, q) (P::GATHER ? GROW_OF((U).aq[(q) >> 1], q) : (U).aq[0] + (q) * (64 * P::LDA))
#define AQ2(LASTF, q) (P::GATHER ? GROW_OF(((LASTF) ? nxt.aq[(q) >> 1] : cur.aq[(q) >> 1]), q) : ((LASTF) ? nxt.aq[0] : cur.aq[0]) + (q) * (64 * P::LDA))
#define STAGE_A1(Pb, kt) do { const u16* _s = cur.A + (kt) * BK; char* _d = (char*)(Pb) + tz * 16; GLDS_O(_s, AQ1(cur, 2), _d); GLDS_O(_s, AQ1(cur, 3), _d + 8192); } while (0)
#define STAGE_A2(LASTF, Pb, h, kk) do { const u16* _s = A2 + (kk) * BK; char* _d = (char*)(Pb) + tz * 16; GLDS_O(_s, AQ2(LASTF, 2 * (h)), _d); GLDS_O(_s, AQ2(LASTF, 2 * (h) + 1), _d + 8192); } while (0)
#define STAGE_B2(Pb, h, kk) do { const u16* _s = ((h) ? B12 : B02) + (kk) * BK; char* _d = (char*)(Pb) + tz * 16; GLDS_O(_s, bo, _d); GLDS_OC(_s, bo, ldb64, _d + 8192); } while (0)
#define STAGE_AP(Pb, h, kt) do { const u16* _s = cur.A + (kt) * BK; char* _d = (char*)(Pb) + tz * 16; GLDS_O(_s, AQ1(cur, 2 * (h)), _d); GLDS_O(_s, AQ1(cur, 2 * (h) + 1), _d + 8192); } while (0)
#define STAGE_BP(Pb, h, kt) do { const u16* _s = ((h) ? cur.B1 : cur.B0) + (kt) * BK; char* _d = (char*)(Pb) + tz * 16; GLDS_O(_s, bo, _d); GLDS_OC(_s, bo, ldb64, _d + 8192); } while (0)
#define LDA(dst, b, h) do { int _a = aoff; asm volatile("" : "+v"(_a)); const char* _p = (const char*)SA(b, h) + _a; \
        _Pragma("unroll") for (int m = 0; m < 4; ++m) _Pragma("unroll") for (int k = 0; k < 2; ++k) dst[m][k] = *reinterpret_cast<const bf16x8*>(_p + m * 2048 + k * 1024); } while (0)
#define LDB(dst, b, h) do { int _a = boff; asm volatile("" : "+v"(_a)); const char* _p = (const char*)SB(b, h) + _a; \
        _Pragma("unroll") for (int n = 0; n < 2; ++n) _Pragma("unroll") for (int k = 0; k < 2; ++k) dst[n][k] = *reinterpret_cast<const bf16x8*>(_p + n * 2048 + k * 1024); } while (0)
#define MMA(ai, bj, At, Bt) do { __builtin_amdgcn_s_setprio(1); \
        _Pragma("unroll") for (int m = 0; m < 4; ++m) _Pragma("unroll") for (int n = 0; n < 2; ++n) _Pragma("unroll") for (int k = 0; k < 2; ++k) \
            acc[ai][bj][m][n] = P::SWAP ? __builtin_amdgcn_mfma_f32_16x16x32_bf16(Bt[n][k], At[m][k], acc[ai][bj][m][n], 0, 0, 0) \
                                        : __builtin_amdgcn_mfma_f32_16x16x32_bf16(At[m][k], Bt[n][k], acc[ai][bj][m][n], 0, 0, 0); \
        __builtin_amdgcn_s_setprio(0); } while (0)
#define ACC_ZERO() do { _Pragma("unroll") for (int a_ = 0; a_ < 2; ++a_) _Pragma("unroll") for (int b_ = 0; b_ < 2; ++b_) _Pragma("unroll") for (int m_ = 0; m_ < 4; ++m_) _Pragma("unroll") for (int n_ = 0; n_ < 2; ++n_) \
        acc[a_][b_][m_][n_] = f32x4{0.f, 0.f, 0.f, 0.f}; } while (0)
    int tz = otid();
    int wid = tz >> 6, lane = tz & 63, wr = wid >> 2, wc = wid & 3, fr = lane & 15, fq = lane >> 4;
    int R0, C0; stage_rc(tz * 16, R0, C0);
    const int aoff = lds_byte(wr * 64 + fr, fq * 8), boff = lds_byte(wc * 32 + fr, fq * 8);
    GUnit cur, nxt;
    if (!ph.next(0, cur, R0, C0)) return;
    if (P::GATHER) ph.load_rows(cur, R0);
    const int ldb = ph.ldb(), nt = ph.nt();
    const int bo = (P::PERM ? ((R0 & ~31) + perm32(R0 & 31)) : R0) * ldb + C0, ldb64 = 64 * ldb;
    f32x4 acc[2][2][4][2]; ACC_ZERO();
    bf16x8 At[4][2], B0[2][2], B1[2][2];
    STAGE_BP(SB(0, 0), 0, 0); STAGE_AP(SA(0, 0), 0, 0); STAGE_BP(SB(0, 1), 1, 0); STAGE_AP(SA(0, 1), 1, 0);
    if (wr == 1) BAR;
    WAIT_V(4); BAR;
    STAGE_BP(SB(1, 0), 0, 1); STAGE_AP(SA(1, 0), 0, 1); STAGE_BP(SB(1, 1), 1, 1);
    WAIT_V(6); BAR;
    for (int ui = 0;; ++ui) {
        int R0n, C0n; stage_rc(otid() * 16, R0n, C0n);
        const bool has_next = ph.next(ui + 1, nxt, R0n, C0n);
        if (P::GATHER && has_next) ph.load_rows(nxt, R0n);
        if (!has_next) nxt = cur;
#define KTRIP(LASTF) { \
            const u16* A2 = (LASTF) ? nxt.A : cur.A + (t + 2) * BK; \
            const u16* B02 = (LASTF) ? nxt.B0 : cur.B0 + (t + 2) * BK; \
            const u16* B12 = (LASTF) ? nxt.B1 : cur.B1 + (t + 2) * BK; \
            LDB(B0, 0, 0); SCHED; LDA(At, 0, 0); STAGE_A1(SA(1, 1), t + 1); \
            WAIT_L(8); BAR; WAIT_L(0); MMA(0, 0, At, B0); BAR; SCHED; \
            LDB(B1, 0, 1); STAGE_B2(SB(0, 0), 0, 0); \
            BAR; WAIT_L(0); MMA(0, 1, At, B1); BAR; \
            LDA(At, 0, 1); STAGE_A2(LASTF, SA(0, 0), 0, 0); \
            BAR; WAIT_L(0); MMA(1, 0, At, B0); BAR; SCHED; \
            STAGE_B2(SB(0, 1), 1, 0); \
            WAIT_V(6); BAR; MMA(1, 1, At, B1); BAR; \
            LDB(B0, 1, 0); SCHED; LDA(At, 1, 0); STAGE_A2(LASTF, SA(0, 1), 1, 0); \
            WAIT_L(8); BAR; WAIT_L(0); MMA(0, 0, At, B0); BAR; SCHED; \
            LDB(B1, 1, 1); STAGE_B2(SB(1, 0), 0, 1); \
            BAR; WAIT_L(0); MMA(0, 1, At, B1); BAR; \
            LDA(At, 1, 1); STAGE_A2(LASTF, SA(1, 0), 0, 1); \
            BAR; WAIT_L(0); MMA(1, 0, At, B0); BAR; SCHED; \
            STAGE_B2(SB(1, 1), 1, 1); \
            WAIT_V(6); BAR; MMA(1, 1, At, B1); BAR; }
        for (int t = 0; t < nt - 2; t += 2) KTRIP(0)
        { const int t = nt - 2; KTRIP(1) }
#undef KTRIP
        ph.epi(acc, cur);
        if (!has_next) break;
        ACC_ZERO();
        cur = nxt;
    }
    WAIT_V(0);
    if (wr == 0) BAR;
    BAR;
#undef SA
#undef SB
#undef GLDS_O
#undef GLDS_OC
#undef AQ1
#undef GROW_OF
#undef AQ2
#undef STAGE_A1
#undef STAGE_A2
#undef STAGE_B2
#undef STAGE_AP
#undef STAGE_BP
#undef LDA
#undef LDB
#undef MMA
#undef ACC_ZERO
}
#define EPI_GEOM() int tz_ = otid(); const int wid_ = tz_ >> 6, lane_ = tz_ & 63, wr = wid_ >> 2, wc = wid_ & 3, fr = lane_ & 15, fq = lane_ >> 4
#define EPI_LOOP4 _Pragma("unroll") for (int ai = 0; ai < 2; ++ai) _Pragma("unroll") for (int bj = 0; bj < 2; ++bj) _Pragma("unroll") for (int m = 0; m < 4; ++m)
typedef f32x4 AccT[2][2][4][2];

template <bool VT>
struct InprojP {
    static constexpr bool GATHER = false, SWAP = !VT, PERM = true; static constexpr int LDA = DM;
    const u16* XH; const u16* Wt; u16* Hb; u16* Vt; u16* GVt;
    __device__ __forceinline__ void load_rows(GUnit&, int) const {}
    __device__ __forceinline__ int ldb() const { return DM; }
    __device__ __forceinline__ int nt() const { return DM / BK; }
    __device__ __forceinline__ bool next(int i, GUnit& u, int R0, int C0) const {
        const int id = blockIdx.x + i * gridDim.x; if (id >= 64 * (VT ? 4 : 8)) return false;
        const int pm = id & 63, idx = id >> 6;
        const int pn = VT ? (idx < 2 ? idx + 2 : idx + 8) : (idx < 2 ? idx : idx + 2);
        u.A = XH; u.aq[0] = (pm * 256 + R0) * DM + C0; u.aq[1] = 0; u.aq[2] = 0; u.aq[3] = 0;
        u.B0 = Wt + (size_t)(pn * 256) * DM; u.B1 = u.B0 + (size_t)128 * DM; u.i0 = pm; u.i1 = pn; u.i2 = 0; return true;
    }
    __device__ __forceinline__ void epi(const AccT& acc, const GUnit& u) const {
        EPI_GEOM(); const int brow = u.i0 * 256, pn = u.i1, bcol = pn * 256;
        if (!VT) {
            EPI_LOOP4 {
                const int row = brow + ai * 128 + wr * 64 + m * 16 + fr, col = bcol + bj * 128 + wc * 32 + fq * 8;
                u32x4 v; v[0] = pack2(acc[ai][bj][m][0][0], acc[ai][bj][m][0][1]); v[1] = pack2(acc[ai][bj][m][0][2], acc[ai][bj][m][0][3]);
                v[2] = pack2(acc[ai][bj][m][1][0], acc[ai][bj][m][1][1]); v[3] = pack2(acc[ai][bj][m][1][2], acc[ai][bj][m][1][3]);
                *reinterpret_cast<u32x4*>(Hb + (size_t)row * HC + col) = v;
            }
        } else {
            u16* dstT = pn >= 10 ? Vt : GVt;
            EPI_LOOP4 _Pragma("unroll") for (int n = 0; n < 2; ++n) {
                const int row = brow + ai * 128 + wr * 64 + m * 16 + fq * 4;
                const int col = (pn & 1) * 256 + bj * 128 + wc * 32 + 8 * (fr >> 2) + 4 * n + (fr & 3);
                const int b = row >> 11, s = row & 2047, hd = col >> 7, dv = col & 127;
                uint2 v; v.x = pack2(acc[ai][bj][m][n][0], acc[ai][bj][m][n][1]); v.y = pack2(acc[ai][bj][m][n][2], acc[ai][bj][m][n][3]);
                *reinterpret_cast<uint2*>(dstT + ((size_t)((b * 4 + hd) * 128 + dv)) * SEQ + s) = v;
            }
        }
    }
};
__device__ __forceinline__ void phase_inproj(u16* shm, const u16* __restrict__ XH, const u16* __restrict__ Wt, u16* __restrict__ Hb, u16* __restrict__ Vt, u16* __restrict__ GVt) {
    { InprojP<false> ph{XH, Wt, Hb, Vt, GVt}; gemm_stream(shm, ph); }
    { InprojP<true> ph{XH, Wt, Hb, Vt, GVt}; gemm_stream(shm, ph); }
}

struct MixprojP {
    static constexpr bool GATHER = false, SWAP = true, PERM = false; static constexpr int LDA = DM;
    const u16* MIX; const u16* Wt; bool pool; const float* xin; const float* scale; float* Z;
    __device__ __forceinline__ void load_rows(GUnit&, int) const {}
    __device__ __forceinline__ int ldb() const { return pool ? 256 : 1024; }
    __device__ __forceinline__ int nt() const { return pool ? 4 : 16; }
    __device__ __forceinline__ bool next(int i, GUnit& u, int R0, int C0) const {
        const int id = blockIdx.x + i * gridDim.x; if (id >= 64 * 4) return false;
        const int pm = id & 63, pn = id >> 6;
        u.A = MIX; u.aq[0] = (pm * 256 + R0) * DM + C0 + (pool ? pn * 256 : 0); u.aq[1] = 0; u.aq[2] = 0; u.aq[3] = 0;
        u.B0 = pool ? (Wt + (size_t)pn * 65536) : (Wt + (size_t)(pn * 256) * DM); u.B1 = u.B0 + (size_t)128 * (pool ? 256 : 1024);
        u.i0 = pm; u.i1 = pn; u.i2 = 0; return true;
    }
    __device__ __forceinline__ void epi(const AccT& acc, const GUnit& u) const {
        EPI_GEOM(); const int brow = u.i0 * 256, bcol = u.i1 * 256;
        EPI_LOOP4 _Pragma("unroll") for (int n = 0; n < 2; ++n) {
            const int row = brow + ai * 128 + wr * 64 + m * 16 + fr;
            const int col = bcol + bj * 128 + wc * 32 + n * 16 + fq * 4;
            const float4 xv = *reinterpret_cast<const float4*>(xin + (size_t)row * DM + col);
            float4 sc = make_float4(1.f, 1.f, 1.f, 1.f);
            if (pool) sc = *reinterpret_cast<const float4*>(scale + col);
            float4 o;
            o.x = ALPHA * xv.x + acc[ai][bj][m][n][0] * sc.x; o.y = ALPHA * xv.y + acc[ai][bj][m][n][1] * sc.y;
            o.z = ALPHA * xv.z + acc[ai][bj][m][n][2] * sc.z; o.w = ALPHA * xv.w + acc[ai][bj][m][n][3] * sc.w;
            *reinterpret_cast<float4*>(Z + (size_t)row * DM + col) = o;
        }
    }
};
__device__ __forceinline__ void phase_mixproj(u16* shm, const u16* __restrict__ MIX, const u16* __restrict__ Wt, bool pool,
                              const float* __restrict__ xin, const float* __restrict__ scale, float* __restrict__ Z) {
    MixprojP ph{MIX, Wt, pool, xin, scale, Z};
    gemm_stream(shm, ph);
}

struct MoeMap { int toff[17]; int cnt[16]; };
__device__ __forceinline__ void moe_build_map(LAS MoeMap* mp, const u32* __restrict__ gcnt) {
    if (otid() == 0) {
        int o = 0;
        for (int e = 0; e < 16; ++e) { int c = (int)__hip_atomic_load(gcnt + e, __ATOMIC_RELAXED, __HIP_MEMORY_SCOPE_AGENT); mp->cnt[e] = c; mp->toff[e] = o; o += (c + 255) >> 8; }
        mp->toff[16] = o;
    }
    __syncthreads();
}
__device__ __forceinline__ int moe_unit_meta(LAS MoeMap* mp, int sh, int nunits) {
    const int i = otid() & 63;
    const int id = blockIdx.x + i * gridDim.x;
    int w = 0;
    if (id < nunits) {
        const int rt = id >> sh;
        int e = 0;
        for (int k = 1; k < 16; ++k) e += (rt >= mp->toff[k]) ? 1 : 0;
        w = e | (mp->toff[e] << 4) | (mp->cnt[e] << 12);
    }
    return w;
}
struct Moe1P {
    static constexpr bool GATHER = true, SWAP = true, PERM = true; static constexpr int LDA = DM;
    int meta; const u16* slot_tok; const u16* XH; const u16* Wg; const u16* Wu; u16* Hout; int RT;
    __device__ __forceinline__ int ldb() const { return DM; }
    __device__ __forceinline__ int nt() const { return DM / BK; }
    __device__ __forceinline__ bool next(int i, GUnit& u, int R0, int C0) const {
        const int id = blockIdx.x + i * gridDim.x; if (id >= RT * 8) return false;
        const int rt = id >> 3, ft = id & 7;
        const int w = __builtin_amdgcn_readlane(meta, i);
        const int e = w & 15, pos0 = (rt - ((w >> 4) & 255)) * 256;
        u.aq[0] = e * 16384 + pos0;
        u.A = XH; u.B0 = Wg + ((size_t)e * 1024 + ft * 128) * DM; u.B1 = Wu + ((size_t)e * 1024 + ft * 128) * DM;
        u.i0 = rt; u.i1 = ft; u.i2 = e; return true;
    }
    __device__ __forceinline__ void load_rows(GUnit& u, int R0) const {
        const uint2 v = *reinterpret_cast<const uint2*>(slot_tok + u.aq[0] + R0 * 4);
        u.aq[0] = (int)v.x; u.aq[1] = (int)v.y;
    }
    __device__ __forceinline__ void epi(const AccT& acc, const GUnit& u) const {
        EPI_GEOM(); const int rt = u.i0, ft = u.i1;
        _Pragma("unroll") for (int ai = 0; ai < 2; ++ai) _Pragma("unroll") for (int m = 0; m < 4; ++m) {
            const int row = rt * 256 + ai * 128 + wr * 64 + m * 16 + fr, col = ft * 128 + wc * 32 + fq * 8;
            float hv[8];
#pragma unroll
            for (int n = 0; n < 2; ++n)
#pragma unroll
                for (int j = 0; j < 4; ++j) { const float g = acc[ai][0][m][n][j], uu = acc[ai][1][m][n][j]; hv[n * 4 + j] = g * sigmoidf_(g) * uu; }
            u32x4 v; v[0] = pack2(hv[0], hv[1]); v[1] = pack2(hv[2], hv[3]); v[2] = pack2(hv[4], hv[5]); v[3] = pack2(hv[6], hv[7]);
            *reinterpret_cast<u32x4*>(Hout + (size_t)row * 1024 + col) = v;
        }
    }
};
__device__ __forceinline__ int phase_moe1(u16* shm, LAS MoeMap* mp, const u32* __restrict__ gcnt, const u16* __restrict__ slot_tok, const u16* __restrict__ XH,
                           const u16* __restrict__ Wg, const u16* __restrict__ Wu, u16* __restrict__ Hout) {
    moe_build_map(mp, gcnt);
    const int RT = mp->toff[16];
    Moe1P ph{moe_unit_meta(mp, 3, RT * 8), slot_tok, XH, Wg, Wu, Hout, RT};
    gemm_stream(shm, ph);
    return RT * 8;
}

struct Moe2P {
    static constexpr bool GATHER = false, SWAP = true, PERM = true; static constexpr int LDA = 1024;
    int meta; const u16* Hin; const u16* Wd; u16* Y; int RT;
    __device__ __forceinline__ void load_rows(GUnit&, int) const {}
    __device__ __forceinline__ int ldb() const { return 1024; }
    __device__ __forceinline__ int nt() const { return 1024 / BK; }
    __device__ __forceinline__ bool next(int i, GUnit& u, int R0, int C0) const {
        const int id = blockIdx.x + i * gridDim.x; if (id >= RT * 4) return false;
        const int rt = id >> 2, pn = id & 3;
        const int e = __builtin_amdgcn_readlane(meta, i) & 15;
        u.A = Hin; u.aq[0] = (rt * 256 + R0) * 1024 + C0; u.aq[1] = 0; u.aq[2] = 0; u.aq[3] = 0;
        u.B0 = Wd + ((size_t)e * 1024 + pn * 256) * 1024; u.B1 = u.B0 + (size_t)128 * 1024;
        u.i0 = rt; u.i1 = pn; u.i2 = e; return true;
    }
    __device__ __forceinline__ void epi(const AccT& acc, const GUnit& u) const {
        EPI_GEOM(); const int rt = u.i0, pn = u.i1;
        EPI_LOOP4 {
            const int row = rt * 256 + ai * 128 + wr * 64 + m * 16 + fr, col = pn * 256 + bj * 128 + wc * 32 + fq * 8;
            u32x4 v; v[0] = pack2(acc[ai][bj][m][0][0], acc[ai][bj][m][0][1]); v[1] = pack2(acc[ai][bj][m][0][2], acc[ai][bj][m][0][3]);
            v[2] = pack2(acc[ai][bj][m][1][0], acc[ai][bj][m][1][1]); v[3] = pack2(acc[ai][bj][m][1][2], acc[ai][bj][m][1][3]);
            *reinterpret_cast<u32x4*>(Y + (size_t)row * 1024 + col) = v;
        }
    }
};
__device__ __forceinline__ int phase_moe2(u16* shm, LAS MoeMap* mp, const u32* __restrict__ gcnt, const u16* __restrict__ Hin, const u16* __restrict__ Wd, u16* __restrict__ Y) {
    moe_build_map(mp, gcnt);
    const int RT = mp->toff[16];
    Moe2P ph{moe_unit_meta(mp, 2, RT * 4), Hin, Wd, Y, RT};
    gemm_stream(shm, ph);
    return RT * 4;
}

struct ConvDesc { const float* src; u16* dst; int ld, K; };
__device__ __forceinline__ void conv_desc_expert(const Params& p, int L, int q, ConvDesc& d) {
    unsigned char* ws = p.ws;
    const int which = q >> 10, r = q & 1023, mtx = L * 16 + (r >> 6), tt = r & 63, kt = tt >> 3, ntl = tt & 7;
    d.src = p.in[I_WG + which] + (size_t)mtx * 1048576 + (size_t)(kt * 128) * 1024 + ntl * 128; d.ld = 1024; d.K = 1024;
    d.dst = (u16*)(ws + (which == 0 ? WS_WG : (which == 1 ? WS_WU : WS_WD))) + (size_t)mtx * 1048576 + (size_t)(ntl * 128) * 1024 + kt * 128;
}
__device__ __forceinline__ void conv_desc(const Params& p, int t, ConvDesc& d) {
    unsigned char* ws = p.ws;
    if (t < 384) {
        const int i = t / 192, r = t % 192, kt = r / 24, ntl = r % 24;
        const int n0 = ntl * 128, n0src = n0 + (n0 >= 1536 ? 32 : 0);
        d.src = p.in[I_WIN] + (size_t)i * 1024 * IN_COLS + (size_t)(kt * 128) * IN_COLS + n0src; d.ld = IN_COLS; d.K = 1024;
        d.dst = (u16*)(ws + WS_WIN) + (size_t)i * 3072 * 1024 + (size_t)n0 * 1024 + kt * 128;
    } else if (t < 512) {
        const int q = t - 384, i = q >> 6, r = q & 63, kt = r >> 3, ntl = r & 7;
        d.src = p.in[I_WOUT] + (size_t)i * 1048576 + (size_t)(kt * 128) * 1024 + ntl * 128; d.ld = 1024; d.K = 1024;
        d.dst = (u16*)(ws + WS_WOUT) + (size_t)i * 1048576 + (size_t)(ntl * 128) * 1024 + kt * 128;
    } else if (t < 544) {
        const int q = t - 512, mtx = q >> 2, r = q & 3, kt = r >> 1, ntl = r & 1;
        d.src = p.in[I_WPOOL] + (size_t)mtx * 65536 + (size_t)(kt * 128) * 256 + ntl * 128; d.ld = 256; d.K = 256;
        d.dst = (u16*)(ws + WS_WPOOL) + (size_t)mtx * 65536 + (size_t)(ntl * 128) * 256 + kt * 128;
    } else {
        conv_desc_expert(p, 0, t - 544, d);
    }
}
__device__ __forceinline__ void conv_issue(const ConvDesc& d, float (&v)[4][8]) {
    const int tid = otid(), n = tid & 127, kq = tid >> 7;
#pragma unroll
    for (int i = 0; i < 4; ++i)
#pragma unroll
        for (int j = 0; j < 8; ++j) v[i][j] = __builtin_nontemporal_load(d.src + (size_t)((kq + 4 * i) * 8 + j) * d.ld + n);
}
__device__ __forceinline__ void phase_convert(char* lds, const Params& p) {
    const int total = 544 + 3072;
    const int tid = otid();
    int t = blockIdx.x;
    ConvDesc cur; float v[4][8];
    if (t < total) { conv_desc(p, t, cur); conv_issue(cur, v); }
    while (t < total) {
        { const int n = tid & 127, kq = tid >> 7;
#pragma unroll
          for (int i = 0; i < 4; ++i) {
              u32x4 o; o[0] = pack2(v[i][0], v[i][1]); o[1] = pack2(v[i][2], v[i][3]); o[2] = pack2(v[i][4], v[i][5]); o[3] = pack2(v[i][6], v[i][7]);
              *reinterpret_cast<u32x4*>(lds + (n * 136 + (kq + 4 * i) * 8) * 2) = o;
          } }
        __syncthreads();
        u16* dst = cur.dst; const int K = cur.K;
        const int tn = t + gridDim.x;
        if (tn < total) { conv_desc(p, tn, cur); conv_issue(cur, v); }
        { const int k16 = tid & 15, nr = tid >> 4;
#pragma unroll
          for (int pz = 0; pz < 4; ++pz) {
              const int n = nr + 32 * pz;
              const u32x4 o = *reinterpret_cast<const u32x4*>(lds + (n * 136 + k16 * 8) * 2);
              *reinterpret_cast<u32x4*>(dst + (size_t)n * K + k16 * 8) = o;
          } }
        __syncthreads();
        t = tn;
    }
}

__device__ __forceinline__ void conv_pull(char* lds, const Params& p, int L, int maxtiles) {
    const int total = 3072;
    const int tid = otid();
    u32* cursor = (u32*)(p.ws + WS_CTL + CTL_CUR) + L * 64;
    volatile LAS int* shn = (volatile LAS int*)(lds + 40960);
    if (tid == 0) shn[0] = maxtiles > 0 ? (int)__hip_atomic_fetch_add(cursor, 1u, __ATOMIC_RELAXED, __HIP_MEMORY_SCOPE_AGENT) : total;
    __syncthreads();
    int t = shn[0], n = 1;
    ConvDesc cur; float v[4][8];
    if (t < total) { conv_desc_expert(p, L, t, cur); conv_issue(cur, v); }
    while (t < total) {
        { const int nn = tid & 127, kq = tid >> 7;
#pragma unroll
          for (int i = 0; i < 4; ++i) {
              u32x4 o; o[0] = pack2(v[i][0], v[i][1]); o[1] = pack2(v[i][2], v[i][3]); o[2] = pack2(v[i][4], v[i][5]); o[3] = pack2(v[i][6], v[i][7]);
              *reinterpret_cast<u32x4*>(lds + (nn * 136 + (kq + 4 * i) * 8) * 2) = o;
          } }
        if (tid == 0) shn[1] = (n < maxtiles) ? (int)__hip_atomic_fetch_add(cursor, 1u, __ATOMIC_RELAXED, __HIP_MEMORY_SCOPE_AGENT) : total;
        __syncthreads();
        u16* dst = cur.dst; const int K = cur.K;
        const int tn = shn[1]; ++n;
        if (tn < total) { conv_desc_expert(p, L, tn, cur); conv_issue(cur, v); }
        { const int k16 = tid & 15, nr = tid >> 4;
#pragma unroll
          for (int pz = 0; pz < 4; ++pz) {
              const int nn = nr + 32 * pz;
              const u32x4 o = *reinterpret_cast<const u32x4*>(lds + (nn * 136 + k16 * 8) * 2);
              *reinterpret_cast<u32x4*>(dst + (size_t)nn * K + k16 * 8) = o;
          } }
        __syncthreads();
        t = tn;
    }
}
__device__ __forceinline__ int spare_quota(int nunits, int q) { const int rem = nunits % (int)gridDim.x; return (rem != 0 && (int)blockIdx.x >= rem) ? q : 0; }

__device__ __forceinline__ int rho_of_k(int k) { return ((k >> 2) & 63) + 64 * ((k & 3) + 4 * (k >> 8)); }
template <int NO>
__device__ __forceinline__ void load_skinny(float* sW, const float* __restrict__ W, int ld, int c0) {
    for (int idx = otid(); idx < 1024 * (NO / 4); idx += NTHR) {
        const int k = idx / (NO / 4), c4 = (idx % (NO / 4)) * 4;
        const float4 v = *reinterpret_cast<const float4*>(W + (size_t)k * ld + c0 + c4);
        *reinterpret_cast<float4*>(sW + rho_of_k(k) * (NO + 4) + c4) = v;
    }
}
template <int NO>
__device__ __forceinline__ void skinny_dot(const float* sW, const float (&xv)[16], float (&o)[NO]) {
    const int lane = otid() & 63;
#pragma unroll
    for (int e = 0; e < NO; ++e) o[e] = 0.f;
#pragma unroll
    for (int i = 0; i < 4; ++i)
#pragma unroll
        for (int jj = 0; jj < 4; ++jj) {
            const float x = xv[i * 4 + jj];
            const float* wrow = sW + (lane + 64 * (jj + 4 * i)) * (NO + 4);
#pragma unroll
            for (int e4 = 0; e4 < NO; e4 += 4) {
                const float4 w = *reinterpret_cast<const float4*>(wrow + e4);
                o[e4] += x * w.x; o[e4 + 1] += x * w.y; o[e4 + 2] += x * w.z; o[e4 + 3] += x * w.w;
            }
            __builtin_amdgcn_sched_barrier(0);
        }
#pragma unroll
    for (int e = 0; e < NO; ++e) o[e] = wave_sum(o[e]);
}
__device__ __forceinline__ void store_row_bf16(u16* __restrict__ dst, const float (&v)[16], int lane) {
#pragma unroll
    for (int i = 0; i < 4; ++i) {
        uint2 o; o.x = pack2(v[i * 4], v[i * 4 + 1]); o.y = pack2(v[i * 4 + 2], v[i * 4 + 3]);
        *reinterpret_cast<uint2*>(dst + i * 256 + lane * 4) = o;
    }
}
__device__ __forceinline__ void store_row_f32(float* __restrict__ dst, const float (&v)[16], int lane) {
#pragma unroll
    for (int i = 0; i < 4; ++i) *reinterpret_cast<float4*>(dst + i * 256 + lane * 4) = make_float4(v[i * 4], v[i * 4 + 1], v[i * 4 + 2], v[i * 4 + 3]);
}
__device__ __forceinline__ void load_row_f32(const float* __restrict__ src, float (&v)[16], int lane) {
#pragma unroll
    for (int i = 0; i < 4; ++i) { const float4 t = *reinterpret_cast<const float4*>(src + i * 256 + lane * 4); v[i * 4] = t.x; v[i * 4 + 1] = t.y; v[i * 4 + 2] = t.z; v[i * 4 + 3] = t.w; }
}
__device__ __forceinline__ void layer_norm_row(float (&v)[16], const float* __restrict__ g, const float* __restrict__ b, int lane) {
    float s = 0.f;
#pragma unroll
    for (int i = 0; i < 16; ++i) s += v[i];
    const float mu = wave_sum(s) * (1.f / 1024.f);
    float q = 0.f;
#pragma unroll
    for (int i = 0; i < 16; ++i) { const float d = v[i] - mu; q += d * d; }
    const float rs = rsqrtf(wave_sum(q) * (1.f / 1024.f) + LN_EPS);
#pragma unroll
    for (int i = 0; i < 4; ++i) {
        const float4 gg = *reinterpret_cast<const float4*>(g + i * 256 + lane * 4);
        const float4 bb = *reinterpret_cast<const float4*>(b + i * 256 + lane * 4);
        v[i * 4] = (v[i * 4] - mu) * rs * gg.x + bb.x; v[i * 4 + 1] = (v[i * 4 + 1] - mu) * rs * gg.y + bb.y;
        v[i * 4 + 2] = (v[i * 4 + 2] - mu) * rs * gg.z + bb.z; v[i * 4 + 3] = (v[i * 4 + 3] - mu) * rs * gg.w + bb.w;
    }
}

__device__ __forceinline__ void phase_rows_prologue(float* sW, const float* __restrict__ x, const float* __restrict__ w_in0, u16* __restrict__ XH, float* __restrict__ LR) {
    load_skinny<32>(sW, w_in0, IN_COLS, 1536);
    __syncthreads();
    const int tid_ = otid(); const int lane = tid_ & 63, wave = tid_ >> 6;
    for (int row = blockIdx.x * 8 + wave; row < TOK; row += gridDim.x * 8) {
        float v[16]; load_row_f32(x + (size_t)row * DM, v, lane);
        store_row_bf16(XH + (size_t)row * DM, v, lane);
        float o[32]; skinny_dot<32>(sW, v, o);
        if (lane < 32) { float r = 0.f;
#pragma unroll
            for (int e = 0; e < 32; ++e) r = (lane == e) ? o[e] : r;
            LR[(size_t)row * 32 + lane] = r; }
    }
}

__device__ __forceinline__ void layer_norm_regs(float (&v)[16], const float (&gg)[16], const float (&bb)[16]) {
    float s = 0.f;
#pragma unroll
    for (int i = 0; i < 16; ++i) s += v[i];
    const float mu = wave_sum(s) * (1.f / 1024.f);
    float q = 0.f;
#pragma unroll
    for (int i = 0; i < 16; ++i) { const float d = v[i] - mu; q += d * d; }
    const float rs = rsqrtf(wave_sum(q) * (1.f / 1024.f) + LN_EPS);
#pragma unroll
    for (int i = 0; i < 16; ++i) v[i] = (v[i] - mu) * rs * gg[i] + bb[i];
}
__device__ __forceinline__ void wave_sum16(float (&o)[16]) {
    const int lane = otid() & 63;
    float a8[8], a4[4], a2[2], a1;
    { const bool hi = (lane & 32) != 0;
#pragma unroll
      for (int i = 0; i < 8; ++i) { const float send = hi ? o[i] : o[8 + i]; const float keep = hi ? o[8 + i] : o[i]; a8[i] = keep + __shfl_xor(send, 32); } }
    { const bool hi = (lane & 16) != 0;
#pragma unroll
      for (int i = 0; i < 4; ++i) { const float send = hi ? a8[i] : a8[4 + i]; const float keep = hi ? a8[4 + i] : a8[i]; a4[i] = keep + __shfl_xor(send, 16); } }
    { const bool hi = (lane & 8) != 0;
#pragma unroll
      for (int i = 0; i < 2; ++i) { const float send = hi ? a4[i] : a4[2 + i]; const float keep = hi ? a4[2 + i] : a4[i]; a2[i] = keep + __shfl_xor(send, 8); } }
    { const bool hi = (lane & 4) != 0;
      const float send = hi ? a2[0] : a2[1]; const float keep = hi ? a2[1] : a2[0]; a1 = keep + __shfl_xor(send, 4); }
    a1 += __shfl_xor(a1, 1); a1 += __shfl_xor(a1, 2);
#pragma unroll
    for (int e = 0; e < 16; ++e) o[e] = __builtin_bit_cast(float, __builtin_amdgcn_readlane(__builtin_bit_cast(int, a1), 32 * ((e >> 3) & 1) + 16 * ((e >> 2) & 1) + 8 * ((e >> 1) & 1) + 4 * (e & 1)));
}
template <int NO>
__device__ __forceinline__ void skinny_partial(const float* sW, const float (&xv)[16], float (&o)[NO]) {
    const int lane = otid() & 63;
#pragma unroll
    for (int e = 0; e < NO; ++e) o[e] = 0.f;
#pragma unroll
    for (int i = 0; i < 4; ++i)
#pragma unroll
        for (int jj = 0; jj < 4; ++jj) {
            const float x = xv[i * 4 + jj];
            const float* wrow = sW + (lane + 64 * (jj + 4 * i)) * (NO + 4);
#pragma unroll
            for (int e4 = 0; e4 < NO; e4 += 4) {
                const float4 w = *reinterpret_cast<const float4*>(wrow + e4);
                o[e4] += x * w.x; o[e4 + 1] += x * w.y; o[e4 + 2] += x * w.z; o[e4 + 3] += x * w.w;
            }
            __builtin_amdgcn_sched_barrier(0);
        }
}

struct RouteLds { int e0[64], e1[64], lp0[64], lp1[64]; float w0[64], w1[64]; int cnt[16], base[16]; };
__device__ __forceinline__ void ln1_row(const float* sW, LAS RouteLds* rl, float (&v)[16], const float (&gg)[16], const float (&bb)[16], const float (&rb)[16],
                                        float* __restrict__ X1, u16* __restrict__ XH, int row, int lr, int lane) {
    layer_norm_regs(v, gg, bb);
    store_row_f32(X1 + (size_t)row * DM, v, lane);
    store_row_bf16(XH + (size_t)row * DM, v, lane);
    float o[16]; skinny_partial<16>(sW, v, o); wave_sum16(o);
    float aff[16], sel[16];
#pragma unroll
    for (int e = 0; e < 16; ++e) { aff[e] = __builtin_amdgcn_rcpf(1.f + __builtin_amdgcn_exp2f(-1.4426950408889634f * o[e])); sel[e] = aff[e] + rb[e]; }
    int bestg = 0; float bests = -1e30f;
#pragma unroll
    for (int gi = 0; gi < 4; ++gi) {
        float m1 = -1e30f, m2 = -1e30f;
#pragma unroll
        for (int j = 0; j < 4; ++j) { const float s = sel[gi * 4 + j]; if (s > m1) { m2 = m1; m1 = s; } else if (s > m2) m2 = s; }
        const float gs = m1 + m2;
        if (gs > bests) { bests = gs; bestg = gi; }
    }
    int i0 = 0, i1 = 0; float s0 = -1e30f, s1 = -1e30f, a0 = 0.f, a1 = 0.f;
#pragma unroll
    for (int e = 0; e < 16; ++e) {
        const bool in = (e >> 2) == bestg;
        const float s = sel[e];
        if (in) { if (s > s0) { s1 = s0; i1 = i0; a1 = a0; s0 = s; i0 = e; a0 = aff[e]; } else if (s > s1) { s1 = s; i1 = e; a1 = aff[e]; } }
    }
    if (lane == 0) { const float inv = 1.f / (a0 + a1); rl->e0[lr] = i0; rl->e1[lr] = i1; rl->w0[lr] = a0 * inv; rl->w1[lr] = a1 * inv; }
}
__device__ __forceinline__ void phase_rows_ln1(float* sW, LAS RouteLds* rl, const float* __restrict__ Z, const float* __restrict__ g, const float* __restrict__ b,
                               const float* __restrict__ w_router, const float* __restrict__ rbias,
                               float* __restrict__ X1, u16* __restrict__ XH, u32* __restrict__ gcnt, u16* __restrict__ slot_tok, int* __restrict__ tinfo) {
    load_skinny<16>(sW, w_router, 16, 0);
    const int tid = otid(); const int lane = tid & 63, wave = tid >> 6;
    float gg[16], bb[16], rb[16];
    load_row_f32(g, gg, lane); load_row_f32(b, bb, lane);
#pragma unroll
    for (int e = 0; e < 16; ++e) rb[e] = rbias[e];
    __syncthreads();
    for (int blk = blockIdx.x; blk < TOK / 64; blk += gridDim.x) {
        if (tid < 16) rl->cnt[tid] = 0;
        __syncthreads();
        const int lr0 = wave * 8, row0 = blk * 64 + lr0;
        float va[16], vb[16];
        load_row_f32(Z + (size_t)row0 * DM, va, lane);
#pragma unroll 1
        for (int rr = 0; rr < 8; rr += 2) {
            load_row_f32(Z + (size_t)(row0 + rr + 1) * DM, vb, lane);
            ln1_row(sW, rl, va, gg, bb, rb, X1, XH, row0 + rr, lr0 + rr, lane);
            if (rr + 2 < 8) load_row_f32(Z + (size_t)(row0 + rr + 2) * DM, va, lane);
            ln1_row(sW, rl, vb, gg, bb, rb, X1, XH, row0 + rr + 1, lr0 + rr + 1, lane);
        }
        __syncthreads();
        if (tid < 64) { rl->lp0[tid] = atomicAdd((int*)&rl->cnt[rl->e0[tid]], 1); rl->lp1[tid] = atomicAdd((int*)&rl->cnt[rl->e1[tid]], 1); }
        __syncthreads();
        if (tid < 16) rl->base[tid] = (int)atomicAdd(gcnt + tid, (u32)rl->cnt[tid]);
        __syncthreads();
        if (tid < 64) {
            const int row = blk * 64 + tid;
            const int e0 = rl->e0[tid], e1 = rl->e1[tid];
            const int p0 = rl->base[e0] + rl->lp0[tid], p1 = rl->base[e1] + rl->lp1[tid];
            slot_tok[e0 * 16384 + (p0 & ~255) + ((p0 & 63) << 2) + ((p0 >> 6) & 3)] = (u16)row;
            slot_tok[e1 * 16384 + (p1 & ~255) + ((p1 & 63) << 2) + ((p1 >> 6) & 3)] = (u16)row;
            int4 a; a.x = e0; a.y = p0; a.z = e1; a.w = p1;
            *reinterpret_cast<int4*>(tinfo + (size_t)row * 8) = a;
            float2 w; w.x = rl->w0[tid]; w.y = rl->w1[tid];
            *reinterpret_cast<float2*>(tinfo + (size_t)row * 8 + 4) = w;
        }
        __syncthreads();
    }
}

struct Ln2Row { float x[16]; uint2 y0[4], y1[4]; };
__device__ __forceinline__ void ln2_issue(Ln2Row& r, const float* __restrict__ X1, const u16* __restrict__ Y, int row, size_t r0, size_t r1, int lane) {
    load_row_f32(X1 + (size_t)row * DM, r.x, lane);
#pragma unroll
    for (int i = 0; i < 4; ++i) { r.y0[i] = *reinterpret_cast<const uint2*>(Y + r0 * 1024 + i * 256 + lane * 4); r.y1[i] = *reinterpret_cast<const uint2*>(Y + r1 * 1024 + i * 256 + lane * 4); }
}
__device__ __forceinline__ void ln2_row(const float* sW, Ln2Row& r, float w0, float w1, const float (&gg)[16], const float (&bb)[16], float* __restrict__ X2, u16* __restrict__ XH,
                                        bool do_lr, float* __restrict__ LR, int row, int lane) {
    float v[16];
#pragma unroll
    for (int i = 0; i < 4; ++i) {
        v[i * 4 + 0] = ALPHA * r.x[i * 4 + 0] + w0 * bf2f((u16)(r.y0[i].x & 0xffff)) + w1 * bf2f((u16)(r.y1[i].x & 0xffff));
        v[i * 4 + 1] = ALPHA * r.x[i * 4 + 1] + w0 * bf2f((u16)(r.y0[i].x >> 16)) + w1 * bf2f((u16)(r.y1[i].x >> 16));
        v[i * 4 + 2] = ALPHA * r.x[i * 4 + 2] + w0 * bf2f((u16)(r.y0[i].y & 0xffff)) + w1 * bf2f((u16)(r.y1[i].y & 0xffff));
        v[i * 4 + 3] = ALPHA * r.x[i * 4 + 3] + w0 * bf2f((u16)(r.y0[i].y >> 16)) + w1 * bf2f((u16)(r.y1[i].y >> 16));
    }
    layer_norm_regs(v, gg, bb);
    store_row_f32(X2 + (size_t)row * DM, v, lane);
    store_row_bf16(XH + (size_t)row * DM, v, lane);
    if (do_lr) {
        float o[32]; skinny_partial<32>(sW, v, o);
#pragma unroll
        for (int e = 0; e < 32; ++e) o[e] = wave_sum(o[e]);
        if (lane < 32) { float q = 0.f;
#pragma unroll
            for (int e = 0; e < 32; ++e) q = (lane == e) ? o[e] : q;
            LR[(size_t)row * 32 + lane] = q; }
    }
}
__device__ __forceinline__ void phase_rows_ln2(float* sW, LAS MoeMap* mp, const u32* __restrict__ gcnt, const float* __restrict__ X1, const u16* __restrict__ Y, const int* __restrict__ tinfo,
                               const float* __restrict__ g, const float* __restrict__ b, float* __restrict__ X2, u16* __restrict__ XH,
                               const float* __restrict__ w_in_next, float* __restrict__ LR) {
    moe_build_map(mp, gcnt);
    const bool do_lr = w_in_next != nullptr;
    if (do_lr) { load_skinny<32>(sW, w_in_next, IN_COLS, 1536); __syncthreads(); }
    const int tid_ = otid(); const int lane = tid_ & 63, wave = tid_ >> 6;
    float gg[16], bb[16];
    load_row_f32(g, gg, lane); load_row_f32(b, bb, lane);
    for (int blk = blockIdx.x; blk < TOK / 64; blk += gridDim.x) {
        const int row0 = blk * 64 + wave * 8;
        int rr0 = 0, rr1 = 0; float rw0 = 0.f, rw1 = 0.f;
        if (lane < 8) {
            const int4 a = *reinterpret_cast<const int4*>(tinfo + (size_t)(row0 + lane) * 8);
            const float2 w = *reinterpret_cast<const float2*>(tinfo + (size_t)(row0 + lane) * 8 + 4);
            rr0 = mp->toff[a.x] * 256 + a.y; rr1 = mp->toff[a.z] * 256 + a.w; rw0 = w.x; rw1 = w.y;
        }
#define LN2_R0(k) ((size_t)__builtin_amdgcn_readlane(rr0, (k)))
#define LN2_R1(k) ((size_t)__builtin_amdgcn_readlane(rr1, (k)))
#define LN2_W0(k) (__builtin_bit_cast(float, __builtin_amdgcn_readlane(__builtin_bit_cast(int, rw0), (k))))
#define LN2_W1(k) (__builtin_bit_cast(float, __builtin_amdgcn_readlane(__builtin_bit_cast(int, rw1), (k))))
        Ln2Row ra, rb;
        ln2_issue(ra, X1, Y, row0, LN2_R0(0), LN2_R1(0), lane);
#pragma unroll 1
        for (int k = 0; k < 8; k += 2) {
            ln2_issue(rb, X1, Y, row0 + k + 1, LN2_R0(k + 1), LN2_R1(k + 1), lane);
            ln2_row(sW, ra, LN2_W0(k), LN2_W1(k), gg, bb, X2, XH, do_lr, LR, row0 + k, lane);
            if (k + 2 < 8) ln2_issue(ra, X1, Y, row0 + k + 2, LN2_R0(k + 2), LN2_R1(k + 2), lane);
            ln2_row(sW, rb, LN2_W0(k + 1), LN2_W1(k + 1), gg, bb, X2, XH, do_lr, LR, row0 + k + 1, lane);
        }
#undef LN2_R0
#undef LN2_R1
#undef LN2_W0
#undef LN2_W1
    }
}

__device__ __forceinline__ void phase_rows_pool(const float* __restrict__ X, u16* __restrict__ MIX) {
    const int tid_ = otid(); const int lane = tid_ & 63, wave = tid_ >> 6;
    for (int row = blockIdx.x * 8 + wave; row < TOK; row += gridDim.x * 8) {
        const int pos = row & (SEQ - 1), rb = row - pos;
        float v[16];
#pragma unroll
        for (int i = 0; i < 4; ++i) {
            const int half = 1 << i;
            const int lo = max(pos - half, 0), hi = min(pos + half, SEQ);
            float4 s = make_float4(0.f, 0.f, 0.f, 0.f);
            for (int t = lo; t < hi; ++t) { const float4 q = *reinterpret_cast<const float4*>(X + (size_t)(rb + t) * DM + i * 256 + lane * 4); s.x += q.x; s.y += q.y; s.z += q.z; s.w += q.w; }
            const float4 c = *reinterpret_cast<const float4*>(X + (size_t)row * DM + i * 256 + lane * 4);
            const float inv = 1.f / (float)(hi - lo);
            v[i * 4] = s.x * inv - c.x; v[i * 4 + 1] = s.y * inv - c.y; v[i * 4 + 2] = s.z * inv - c.z; v[i * 4 + 3] = s.w * inv - c.w;
        }
        store_row_bf16(MIX + (size_t)row * DM, v, lane);
    }
}

__device__ __forceinline__ float log_sigmoid_(float x) {
    return fminf(x, 0.f) - 0.6931471805599453f * __builtin_amdgcn_logf(1.f + __builtin_amdgcn_exp2f(-1.4426950408889634f * fabsf(x))); }
constexpr int GROW = 72;
constexpr int GL_SB = 0;
constexpr int GL_LR = GL_SB + 32768;
constexpr int GL_TOT = GL_LR + 8192;
constexpr int GL_T0 = GL_TOT + 2048;
constexpr int GL_VT = GL_T0 + 3 * 9216;
constexpr int GL_PT = GL_VT + 18432;
constexpr int GL_RED = GL_PT + 18432;
constexpr int GL_END = GL_RED + 1024;
struct GateRegs { float4 lr4; float w[16]; float bias; };
__device__ __forceinline__ void gla_gates_issue(GateRegs& g, const float* __restrict__ LR, const float* __restrict__ wgg, const float* __restrict__ bgg, int t0, int hd) {
    const int tid = otid();
    g.lr4 = *reinterpret_cast<const float4*>(LR + (size_t)t0 * 32 + tid * 4);
    const int d = tid >> 8, kk = tid & 63;
#pragma unroll
    for (int r = 0; r < 16; ++r) g.w[r] = wgg[(d * 16 + r) * 256 + hd * 64 + kk];
    g.bias = bgg[d * 256 + hd * 64 + kk];
}
__device__ __forceinline__ void gla_gates(char* lds, const GateRegs& g) {
    float* sb = reinterpret_cast<float*>(lds + GL_SB);
    float* slr = reinterpret_cast<float*>(lds + GL_LR);
    float* stot = reinterpret_cast<float*>(lds + GL_TOT);
    const int tid = otid();
    *reinterpret_cast<float4*>(slr + tid * 4) = g.lr4;
    const int d = tid >> 8, jq = (tid >> 6) & 3, kk = tid & 63;
    __syncthreads();
    float la[16];
#pragma unroll
    for (int jj = 0; jj < 16; ++jj) {
        const float* lrow = slr + (jq * 16 + jj) * 32 + d * 16;
        float a = g.bias;
#pragma unroll
        for (int r4 = 0; r4 < 16; r4 += 4) { const float4 l4 = *reinterpret_cast<const float4*>(lrow + r4); a += l4.x * g.w[r4] + l4.y * g.w[r4 + 1] + l4.z * g.w[r4 + 2] + l4.w * g.w[r4 + 3]; }
        la[jj] = log_sigmoid_(a) * (1.f / 16.f);
    }
    if (d == 0) {
#pragma unroll
        for (int jj = 1; jj < 16; ++jj) la[jj] += la[jj - 1];
        stot[(d * 4 + jq) * 64 + kk] = la[15];
    } else {
#pragma unroll
        for (int jj = 14; jj >= 0; --jj) la[jj] += la[jj + 1];
        stot[(d * 4 + jq) * 64 + kk] = la[0];
    }
    __syncthreads();
    float off = 0.f;
#pragma unroll
    for (int q = 0; q < 4; ++q) { const float tq = stot[(d * 4 + q) * 64 + kk]; off += ((d == 0) ? (q < jq) : (q > jq)) ? tq : 0.f; }
#pragma unroll
    for (int jj = 0; jj < 16; ++jj) sb[d * 4096 + (jq * 16 + jj) * 64 + kk] = la[jj] + off;
    __syncthreads();
}
__device__ __forceinline__ void gla_tile128_issue(u32x4 (&r)[2], const u16* __restrict__ src, size_t src_ld) {
    const int tid = otid();
#pragma unroll
    for (int i = 0; i < 2; ++i) { const int p = tid + i * 512, row = p >> 3, c = (p & 7) * 8; r[i] = *reinterpret_cast<const u32x4*>(src + (size_t)row * src_ld + c); }
}
__device__ __forceinline__ void gla_tile128_write(char* dst, const u32x4 (&r)[2]) {
    const int tid = otid();
#pragma unroll
    for (int i = 0; i < 2; ++i) { const int p = tid + i * 512, row = p >> 3, c = (p & 7) * 8; *reinterpret_cast<u32x4*>(dst + (row * GROW + c) * 2) = r[i]; }
}
__device__ __forceinline__ void phase_gla_g1(char* lds, const u16* __restrict__ Hb, const u16* __restrict__ GVt, const float* __restrict__ LR,
                                             const float* __restrict__ wgg, const float* __restrict__ bgg, float* __restrict__ ST, float* __restrict__ DEC) {
    const int tid = otid(), lane = tid & 63, wave = tid >> 6, lq = lane & 31, hh = lane >> 5;
    const float* sb = reinterpret_cast<const float*>(lds + GL_SB);
    for (int item = blockIdx.x; item < 1024; item += gridDim.x) {
        const int c = item & 31, hd = (item >> 5) & 3, b = item >> 7;
        const int t0 = b * SEQ + c * 64;
        GateRegs gr; gla_gates_issue(gr, LR, wgg, bgg, t0, hd);
        u32x4 vreg[2]; gla_tile128_issue(vreg, GVt + ((size_t)(b * 4 + hd) * 128) * SEQ + c * 64, SEQ);
        const int kk = tid & 63, jg = tid >> 6;
        u16 kraw[8];
#pragma unroll
        for (int jj = 0; jj < 8; ++jj) kraw[jj] = Hb[(size_t)(t0 + jg * 8 + jj) * HC + 256 + hd * 64 + kk];
        gla_gates(lds, gr);
        gla_tile128_write(lds + GL_VT, vreg);
#pragma unroll
        for (int d = 0; d < 2; ++d) {
            const float bend = d == 0 ? sb[63 * 64 + kk] : sb[4096 + kk];
            u16* dstT = reinterpret_cast<u16*>(lds + GL_T0 + d * 9216) + kk * GROW + jg * 8;
            float v[8];
#pragma unroll
            for (int jj = 0; jj < 8; ++jj) v[jj] = bf2f(kraw[jj]) * __expf(bend - sb[d * 4096 + (jg * 8 + jj) * 64 + kk]);
            uint4 o; o.x = pack2(v[0], v[1]); o.y = pack2(v[2], v[3]); o.z = pack2(v[4], v[5]); o.w = pack2(v[6], v[7]);
            *reinterpret_cast<uint4*>(dstT) = o;
            if (jg == 0) DEC[((size_t)item * 2 + d) * 64 + kk] = __expf(bend);
        }
        __syncthreads();
        {
            const int d = wave >> 2, vb = wave & 3;
            f32x16 acc[2];
#pragma unroll
            for (int kt = 0; kt < 2; ++kt)
#pragma unroll
                for (int i = 0; i < 16; ++i) acc[kt][i] = 0.f;
            const char* khT = lds + GL_T0 + d * 9216;
            const char* vT = lds + GL_VT;
#pragma unroll
            for (int ks = 0; ks < 4; ++ks) {
                const bf16x8 bf = *reinterpret_cast<const bf16x8*>(vT + ((vb * 32 + lq) * GROW + ks * 16 + hh * 8) * 2);
#pragma unroll
                for (int kt = 0; kt < 2; ++kt) {
                    const bf16x8 af = *reinterpret_cast<const bf16x8*>(khT + ((kt * 32 + lq) * GROW + ks * 16 + hh * 8) * 2);
                    acc[kt] = __builtin_amdgcn_mfma_f32_32x32x16_bf16(af, bf, acc[kt], 0, 0, 0);
                }
            }
            float* dst = ST + ((size_t)item * 2 + d) * 8192 + (size_t)(vb * 32 + lq) * 64;
#pragma unroll
            for (int kt = 0; kt < 2; ++kt)
#pragma unroll
                for (int g4 = 0; g4 < 4; ++g4)
                    *reinterpret_cast<float4*>(dst + kt * 32 + g4 * 8 + hh * 4) = make_float4(acc[kt][g4 * 4], acc[kt][g4 * 4 + 1], acc[kt][g4 * 4 + 2], acc[kt][g4 * 4 + 3]);
        }
        __syncthreads();
    }
}

__device__ __forceinline__ void phase_gla_g2(const float* __restrict__ ST, const float* __restrict__ DEC, u16* __restrict__ PS) {
    const int nwork = 64 * 2048;
    for (int w = blockIdx.x * NTHR + otid(); w < nwork; w += gridDim.x * NTHR) {
        const int e4 = w & 2047, bhd = w >> 11, d = bhd & 1, bh = bhd >> 1;
        const int kk4 = (e4 & 15) * 4;
        float4 st = make_float4(0.f, 0.f, 0.f, 0.f);
#pragma unroll 4
        for (int s = 0; s < 32; ++s) {
            const int c = d == 0 ? s : 31 - s;
            const size_t item = (size_t)bh * 32 + c;
            const float4 ds = *(reinterpret_cast<const float4*>(ST + (item * 2 + d) * 8192) + e4);
            const float4 dec = *reinterpret_cast<const float4*>(DEC + (item * 2 + d) * 64 + kk4);
            uint2 o; o.x = pack2(st.x, st.y); o.y = pack2(st.z, st.w);
            *(reinterpret_cast<uint2*>(PS + (item * 2 + d) * 8192) + e4) = o;
            st.x = dec.x * st.x + ds.x; st.y = dec.y * st.y + ds.y; st.z = dec.z * st.z + ds.z; st.w = dec.w * st.w + ds.w;
        }
    }
}

__device__ __forceinline__ void phase_gla_g3(char* lds, const u16* __restrict__ Hb, const u16* __restrict__ GVt, const float* __restrict__ LR,
                                             const float* __restrict__ wgg, const float* __restrict__ bgg, const u16* __restrict__ PS,
                                             const float* __restrict__ gnorm, u16* __restrict__ MIX) {
    const int tid = otid(), lane = tid & 63, wave = tid >> 6, lq = lane & 31, hh = lane >> 5;
    const int ib = wave & 1, vb = wave >> 1;
    const int pi_lq = (lq & 0x13) | ((lq & 4) << 1) | ((lq & 8) >> 1);
    const float* sb = reinterpret_cast<const float*>(lds + GL_SB);
    float* red = reinterpret_cast<float*>(lds + GL_RED);
    u16* tQt = reinterpret_cast<u16*>(lds + GL_T0);
    u16* tKt = reinterpret_cast<u16*>(lds + GL_T0 + 9216);
    u16* tQh = reinterpret_cast<u16*>(lds + GL_T0 + 2 * 9216);
    for (int item = blockIdx.x; item < 1024; item += gridDim.x) {
        const int c = item & 31, hd = (item >> 5) & 3, b = item >> 7;
        const int t0 = b * SEQ + c * 64;
        GateRegs gr; gla_gates_issue(gr, LR, wgg, bgg, t0, hd);
        u32x4 vreg[2], preg0[2], preg1[2];
        gla_tile128_issue(vreg, GVt + ((size_t)(b * 4 + hd) * 128) * SEQ + c * 64, SEQ);
        gla_tile128_issue(preg0, PS + ((size_t)item * 2 + 0) * 8192, 64);
        gla_tile128_issue(preg1, PS + ((size_t)item * 2 + 1) * 8192, 64);
        const int kk = (tid & 31) * 2, jr = tid >> 5;
        u32 qraw[4], kraw[4];
#pragma unroll
        for (int ps = 0; ps < 4; ++ps) {
            qraw[ps] = *reinterpret_cast<const u32*>(Hb + (size_t)(t0 + jr + ps * 16) * HC + hd * 64 + kk);
            kraw[ps] = *reinterpret_cast<const u32*>(Hb + (size_t)(t0 + jr + ps * 16) * HC + 256 + hd * 64 + kk);
        }
        uint2 graw[4];
#pragma unroll
        for (int g4 = 0; g4 < 4; ++g4) graw[g4] = *reinterpret_cast<const uint2*>(Hb + (size_t)(t0 + ib * 32 + lq) * HC + 1024 + hd * 128 + vb * 32 + g4 * 8 + hh * 4);
        gla_gates(lds, gr);
        gla_tile128_write(lds + GL_VT, vreg);
        f32x16 oacc;
#pragma unroll
        for (int i = 0; i < 16; ++i) oacc[i] = 0.f;
#pragma unroll
        for (int d = 0; d < 2; ++d) {
            {
                const float* bd = sb + d * 4096;
                const int mid = d == 0 ? 31 : 32;
                const float bm0 = bd[mid * 64 + kk], bm1 = bd[mid * 64 + kk + 1];
                const float em0 = __expf(bm0), em1 = __expf(bm1);
#pragma unroll
                for (int ps = 0; ps < 4; ++ps) {
                    const int j = jr + ps * 16;
                    const float2 bj = *reinterpret_cast<const float2*>(bd + j * 64 + kk);
                    const float e0 = __expf(bj.x - bm0), e1 = __expf(bj.y - bm1);
                    const float q0 = bf2f((u16)(qraw[ps] & 0xffff)) * 0.125f * e0, q1 = bf2f((u16)(qraw[ps] >> 16)) * 0.125f * e1;
                    const float k0 = bf2f((u16)(kraw[ps] & 0xffff)) * __builtin_amdgcn_rcpf(e0), k1 = bf2f((u16)(kraw[ps] >> 16)) * __builtin_amdgcn_rcpf(e1);
                    *reinterpret_cast<u32*>(tQt + j * GROW + kk) = pack2(q0, q1);
                    *reinterpret_cast<u32*>(tKt + j * GROW + kk) = pack2(k0, k1);
                    *reinterpret_cast<u32*>(tQh + j * GROW + kk) = pack2(q0 * em0, q1 * em1);
                }
            }
            if (d == 0) gla_tile128_write(lds + GL_PT, preg0); else gla_tile128_write(lds + GL_PT, preg1);
            __syncthreads();
            f32x16 sacc[2];
#pragma unroll
            for (int jt = 0; jt < 2; ++jt) {
#pragma unroll
                for (int i = 0; i < 16; ++i) sacc[jt][i] = 0.f;
#pragma unroll
                for (int ks = 0; ks < 4; ++ks) {
                    const bf16x8 af = *reinterpret_cast<const bf16x8*>(reinterpret_cast<const char*>(tKt) + ((jt * 32 + pi_lq) * GROW + ks * 16 + hh * 8) * 2);
                    const bf16x8 bf = *reinterpret_cast<const bf16x8*>(reinterpret_cast<const char*>(tQt) + ((ib * 32 + lq) * GROW + ks * 16 + hh * 8) * 2);
                    sacc[jt] = __builtin_amdgcn_mfma_f32_32x32x16_bf16(af, bf, sacc[jt], 0, 0, 0);
                }
            }
            const int iq = ib * 32 + lq;
            bf16x8 pf[4];
#pragma unroll
            for (int jt = 0; jt < 2; ++jt)
#pragma unroll
                for (int s2 = 0; s2 < 2; ++s2) {
                    float pv[8];
#pragma unroll
                    for (int jj = 0; jj < 8; ++jj) {
                        const int j = jt * 32 + s2 * 16 + hh * 8 + jj;
                        const bool keep = d == 0 ? (j <= iq) : (j > iq);
                        pv[jj] = keep ? sacc[jt][s2 * 8 + jj] : 0.f;
                    }
                    union { bf16x8 v; u32 w[4]; } cv;
                    cv.w[0] = pack2(pv[0], pv[1]); cv.w[1] = pack2(pv[2], pv[3]); cv.w[2] = pack2(pv[4], pv[5]); cv.w[3] = pack2(pv[6], pv[7]);
                    pf[jt * 2 + s2] = cv.v;
                }
            const char* vT = lds + GL_VT;
            const char* pT = lds + GL_PT;
#pragma unroll
            for (int jt = 0; jt < 2; ++jt)
#pragma unroll
                for (int s2 = 0; s2 < 2; ++s2) {
                    const bf16x8 af = *reinterpret_cast<const bf16x8*>(vT + ((vb * 32 + lq) * GROW + jt * 32 + s2 * 16 + hh * 8) * 2);
                    oacc = __builtin_amdgcn_mfma_f32_32x32x16_bf16(af, pf[jt * 2 + s2], oacc, 0, 0, 0);
                }
#pragma unroll
            for (int ks = 0; ks < 4; ++ks) {
                const bf16x8 af = *reinterpret_cast<const bf16x8*>(pT + ((vb * 32 + lq) * GROW + ks * 16 + hh * 8) * 2);
                const bf16x8 bf = *reinterpret_cast<const bf16x8*>(reinterpret_cast<const char*>(tQh) + ((ib * 32 + lq) * GROW + ks * 16 + hh * 8) * 2);
                oacc = __builtin_amdgcn_mfma_f32_32x32x16_bf16(af, bf, oacc, 0, 0, 0);
            }
            __syncthreads();
        }
        float ss = 0.f;
#pragma unroll
        for (int i = 0; i < 16; ++i) ss += oacc[i] * oacc[i];
        ss += __shfl_xor(ss, 32);
        if (hh == 0) red[vb * 64 + ib * 32 + lq] = ss;
        __syncthreads();
        const int iq = ib * 32 + lq;
        const float tot = red[iq] + red[64 + iq] + red[128 + iq] + red[192 + iq];
        const float rs = rsqrtf(tot * (1.f / 128.f) + RMS_EPS);
        const int t = t0 + iq;
#pragma unroll
        for (int g4 = 0; g4 < 4; ++g4) {
            const int vv = vb * 32 + g4 * 8 + hh * 4;
            const float4 gn = *reinterpret_cast<const float4*>(gnorm + vv);
            const uint2 gg = graw[g4];
            const float g0 = bf2f((u16)(gg.x & 0xffff)), g1 = bf2f((u16)(gg.x >> 16)), g2 = bf2f((u16)(gg.y & 0xffff)), g3 = bf2f((u16)(gg.y >> 16));
            uint2 ov;
            ov.x = pack2(oacc[g4 * 4] * rs * gn.x * (g0 * sigmoidf_(g0)), oacc[g4 * 4 + 1] * rs * gn.y * (g1 * sigmoidf_(g1)));
            ov.y = pack2(oacc[g4 * 4 + 2] * rs * gn.z * (g2 * sigmoidf_(g2)), oacc[g4 * 4 + 3] * rs * gn.w * (g3 * sigmoidf_(g3)));
            *reinterpret_cast<uint2*>(MIX + (size_t)t * DM + hd * 128 + vv) = ov;
        }
        __syncthreads();
    }
}

constexpr int KROW = 136, VROW = 72;
constexpr int ATT_KBYTES = 64 * KROW * 2, ATT_VBYTES = 128 * VROW * 2;
constexpr int ATT_BUF = ATT_KBYTES + ATT_VBYTES;
constexpr int ATT_TBL = 2 * ATT_BUF;
constexpr int ATT_MISC = ATT_TBL + 4096 * 4;
__device__ __forceinline__ int t5_bucket(int rel) {
    const int n = rel < 0 ? -rel : rel;
    int v;
    if (n < 8) v = n;
    else v = 8 + (n >= 12) + (n >= 16) + (n >= 23) + (n >= 32) + (n >= 46) + (n >= 64) + (n >= 91);
    return v + (rel > 0 ? 16 : 0);
}
__device__ __forceinline__ void phase_attn(char* lds, const u16* __restrict__ Hb, const u16* __restrict__ Vt, const float* __restrict__ relb, const float* __restrict__ dlam,
                           const float* __restrict__ dnorm, float lam_init, u16* __restrict__ MIX) {
    const int tid = otid(), lane = tid & 63, wave = tid >> 6, map = wave >> 2, qsub = wave & 3, lq = lane & 31, hh = lane >> 5;
    float* tbl = reinterpret_cast<float*>(lds + ATT_TBL);
    float* misc = reinterpret_cast<float*>(lds + ATT_MISC);
    const float LOG2E = 1.4426950408889634f;
    if (wave == 0) {
        float a = dlam[lane] * dlam[64 + lane], bq = dlam[128 + lane] * dlam[192 + lane];
        a = wave_sum(a); bq = wave_sum(bq);
        if (lane == 0) misc[0] = expf(a) - expf(bq) + lam_init;
    }
    __syncthreads();
    const float lam_full = misc[0];
    const int pi_lq = (lq & 0x13) | ((lq & 4) << 1) | ((lq & 8) >> 1);
    for (int item = blockIdx.x; item < 512; item += gridDim.x) {
        const int qb = item & 15, hd = (item >> 4) & 3, b = item >> 6;
        for (int i = tid; i < 4095; i += NTHR) tbl[i] = relb[t5_bucket(i - 2047) * 4 + hd] * LOG2E;
        const float c_lo = relb[15 * 4 + hd] * LOG2E, c_hi = relb[31 * 4 + hd] * LOG2E;
        const int q0 = qb * 128 + qsub * 32;
        const size_t trow = (size_t)b * SEQ;
        bf16x8 qf[4];
#pragma unroll
        for (int ks = 0; ks < 4; ++ks)
            qf[ks] = *reinterpret_cast<const bf16x8*>(Hb + (trow + q0 + lq) * HC + 1536 + hd * 128 + map * 64 + ks * 16 + hh * 8);
        f32x16 oacc[4];
#pragma unroll
        for (int db = 0; db < 4; ++db)
#pragma unroll
            for (int i = 0; i < 16; ++i) oacc[db][i] = 0.f;
        float m_run = -1e30f, l_run = 0.f;
        const u16* kbase = Hb + trow * HC + 2048 + hd * 128;
        const u16* vbase = Vt + ((size_t)(b * 4 + hd) * 128) * SEQ;
        uint4 kreg[2], vreg[2];
#define ATT_LOAD(k0) do { \
            for (int i_ = 0; i_ < 2; ++i_) { const int p_ = tid + i_ * 512; \
                kreg[i_] = *reinterpret_cast<const uint4*>(kbase + (size_t)((k0) + (p_ >> 4)) * HC + (p_ & 15) * 8); \
                vreg[i_] = *reinterpret_cast<const uint4*>(vbase + (size_t)(p_ >> 3) * SEQ + (k0) + (p_ & 7) * 8); } } while (0)
#define ATT_WRITE(buf) do { char* kb_ = lds + (buf) * ATT_BUF; char* vb_ = kb_ + ATT_KBYTES; \
            for (int i_ = 0; i_ < 2; ++i_) { const int p_ = tid + i_ * 512; \
                *reinterpret_cast<uint4*>(kb_ + ((p_ >> 4) * KROW + (p_ & 15) * 8) * 2) = kreg[i_]; \
                *reinterpret_cast<uint4*>(vb_ + ((p_ >> 3) * VROW + (p_ & 7) * 8) * 2) = vreg[i_]; } } while (0)
        ATT_LOAD(0);
        ATT_WRITE(0);
        __syncthreads();
        for (int kt = 0; kt < 32; ++kt) {
            const int k0 = kt * 64;
            if (kt + 1 < 32) ATT_LOAD(k0 + 64);
            const char* kb = lds + (kt & 1) * ATT_BUF;
            const char* vb = kb + ATT_KBYTES;
            f32x16 sacc[2];
#pragma unroll
            for (int st = 0; st < 2; ++st) {
#pragma unroll
                for (int i = 0; i < 16; ++i) sacc[st][i] = 0.f;
#pragma unroll
                for (int ks = 0; ks < 4; ++ks) {
                    const bf16x8 kf = *reinterpret_cast<const bf16x8*>(kb + ((st * 32 + pi_lq) * KROW + map * 64 + ks * 16 + hh * 8) * 2);
                    sacc[st] = __builtin_amdgcn_mfma_f32_32x32x16_bf16(kf, qf[ks], sacc[st], 0, 0, 0);
                }
            }
            const float c1 = 0.125f * LOG2E;
            float mx = -1e30f;
            const bool far_hi = (k0 - (q0 + 31)) >= 128, far_lo = (q0 - (k0 + 63)) >= 128;
            if (far_hi || far_lo) {
                const float cb = far_hi ? c_hi : c_lo;
#pragma unroll
                for (int st = 0; st < 2; ++st)
#pragma unroll
                    for (int i = 0; i < 16; ++i) { const float s = sacc[st][i] * c1 + cb; sacc[st][i] = s; mx = fmaxf(mx, s); }
            } else {
                const int rbase = k0 - (q0 + lq) + 2047 + 8 * hh;
#pragma unroll
                for (int st = 0; st < 2; ++st)
#pragma unroll
                    for (int i = 0; i < 16; ++i) {
                        const int koff = st * 32 + (i & 3) + 4 * ((i >> 2) & 1) + 16 * (i >> 3);
                        const float s = sacc[st][i] * c1 + tbl[rbase + koff];
                        sacc[st][i] = s; mx = fmaxf(mx, s);
                    }
            }
            mx = fmaxf(mx, __shfl_xor(mx, 32));
            if (!__all(mx - m_run <= 8.f)) {
                const float m_new = fmaxf(m_run, mx);
                const float alpha = __builtin_amdgcn_exp2f(m_run - m_new);
                m_run = m_new; l_run *= alpha;
#pragma unroll
                for (int db = 0; db < 4; ++db)
#pragma unroll
                    for (int i = 0; i < 16; ++i) oacc[db][i] *= alpha;
            }
            float psum = 0.f;
            bf16x8 pf[4];
#pragma unroll
            for (int st = 0; st < 2; ++st)
#pragma unroll
                for (int s2 = 0; s2 < 2; ++s2) {
                    float pv[8];
#pragma unroll
                    for (int j = 0; j < 8; ++j) { pv[j] = __builtin_amdgcn_exp2f(sacc[st][s2 * 8 + j] - m_run); psum += pv[j]; }
                    union { bf16x8 v; u32 w[4]; } cv;
                    cv.w[0] = pack2(pv[0], pv[1]); cv.w[1] = pack2(pv[2], pv[3]); cv.w[2] = pack2(pv[4], pv[5]); cv.w[3] = pack2(pv[6], pv[7]);
                    pf[st * 2 + s2] = cv.v;
                }
            l_run += psum;
#pragma unroll
            for (int db = 0; db < 4; ++db)
#pragma unroll
                for (int st = 0; st < 2; ++st)
#pragma unroll
                    for (int s2 = 0; s2 < 2; ++s2) {
                        const bf16x8 vf = *reinterpret_cast<const bf16x8*>(vb + ((db * 32 + lq) * VROW + st * 32 + s2 * 16 + hh * 8) * 2);
                        oacc[db] = __builtin_amdgcn_mfma_f32_32x32x16_bf16(vf, pf[st * 2 + s2], oacc[db], 0, 0, 0);
                    }
            if (kt + 1 < 32) ATT_WRITE((kt + 1) & 1);
            __syncthreads();
        }
        const float l_tot = l_run + __shfl_xor(l_run, 32);
        float* xch = reinterpret_cast<float*>(lds);
        const int qrow = qsub * 32 + lq;
        if (map == 1) {
            const float sc = lam_full / l_tot;
#pragma unroll
            for (int db = 0; db < 4; ++db)
#pragma unroll
                for (int g4 = 0; g4 < 4; ++g4) {
                    const int dv = db * 32 + g4 * 8 + hh * 4;
                    *reinterpret_cast<float4*>(xch + qrow * 132 + dv) = make_float4(oacc[db][g4 * 4] * sc, oacc[db][g4 * 4 + 1] * sc, oacc[db][g4 * 4 + 2] * sc, oacc[db][g4 * 4 + 3] * sc);
                }
        }
        __syncthreads();
        if (map == 0) {
            const float inv = 1.f / l_tot;
            float ss = 0.f;
#pragma unroll
            for (int db = 0; db < 4; ++db)
#pragma unroll
                for (int g4 = 0; g4 < 4; ++g4) {
                    const int dv = db * 32 + g4 * 8 + hh * 4;
                    const float4 o1 = *reinterpret_cast<const float4*>(xch + qrow * 132 + dv);
                    float v0 = oacc[db][g4 * 4] * inv - o1.x, v1 = oacc[db][g4 * 4 + 1] * inv - o1.y, v2 = oacc[db][g4 * 4 + 2] * inv - o1.z, v3 = oacc[db][g4 * 4 + 3] * inv - o1.w;
                    oacc[db][g4 * 4] = v0; oacc[db][g4 * 4 + 1] = v1; oacc[db][g4 * 4 + 2] = v2; oacc[db][g4 * 4 + 3] = v3;
                    ss += v0 * v0 + v1 * v1 + v2 * v2 + v3 * v3;
                }
            ss += __shfl_xor(ss, 32);
            const float rs = rsqrtf(ss * (1.f / 128.f) + RMS_EPS) * (1.f - lam_init);
            u16* dst = MIX + (trow + q0 + lq) * DM + 512 + hd * 128;
#pragma unroll
            for (int db = 0; db < 4; ++db)
#pragma unroll
                for (int g4 = 0; g4 < 4; ++g4) {
                    const int dv = db * 32 + g4 * 8 + hh * 4;
                    const float4 nw = *reinterpret_cast<const float4*>(dnorm + dv);
                    uint2 ov; ov.x = pack2(oacc[db][g4 * 4] * rs * nw.x, oacc[db][g4 * 4 + 1] * rs * nw.y);
                    ov.y = pack2(oacc[db][g4 * 4 + 2] * rs * nw.z, oacc[db][g4 * 4 + 3] * rs * nw.w);
                    *reinterpret_cast<uint2*>(dst + dv) = ov;
                }
        }
        __syncthreads();
    }
#undef ATT_LOAD
#undef ATT_WRITE
}

constexpr int NPHASE = 1 + 9 * NLAYER;
constexpr int CONV_QUOTA = 9;
__global__ void __launch_bounds__(NTHR, 2) fwd_kernel(Params p) {
    extern __shared__ __attribute__((aligned(16))) unsigned char lds[];
    unsigned char* ws = p.ws;
    const int lo = p.ph_lo, hi = p.ph_hi;
    volatile LAS unsigned* barw = (volatile LAS unsigned*)(lds + LDS_BARW);
    if (threadIdx.x == 0) { barw[0] = 0u; barw[1] = 0u; barw[2] = 0u; barw[3] = 0u; }
    __syncthreads();
    XcdBarrier bar; bar.bar = (unsigned*)(ws + WS_CTL); bar.x = 0; bar.st = barw;
    const bool multi = (hi - lo) > 1;
    if (multi) bar = xcd_barrier_post((unsigned*)(ws + WS_CTL), barw);
#define IN(k) (lo <= (k) && (k) < hi)
#define SEAM(k) do { if (IN(k) && IN((k) + 1)) xcd_barrier(bar); } while (0)

    u16* shm = reinterpret_cast<u16*>(lds);
    float* ldsf = reinterpret_cast<float*>(lds);
    LAS MoeMap* mp = (LAS MoeMap*)(lds + LDS_MOEMAP);
#define WSB() (ows(ws))
#define Wt_in ((u16*)(WSB() + WS_WIN))
#define Wt_out ((u16*)(WSB() + WS_WOUT))
#define Wt_pool ((u16*)(WSB() + WS_WPOOL))
#define Wt_g ((u16*)(WSB() + WS_WG))
#define Wt_u ((u16*)(WSB() + WS_WU))
#define Wt_d ((u16*)(WSB() + WS_WD))
#define XA ((float*)(WSB() + WS_XA))
#define XB ((float*)(WSB() + WS_XB))
#define XH ((u16*)(WSB() + WS_XH))
#define MIX ((u16*)(WSB() + WS_MIXIN))
#define LR ((float*)(WSB() + WS_LR))
#define Vt ((u16*)(WSB() + WS_VT))
#define GVt ((u16*)(WSB() + WS_GVT))
#define PS ((u16*)(WSB() + WS_R2 + R2_PS))
#define Hb ((u16*)(WSB() + WS_R1))
#define Hmoe ((u16*)(WSB() + WS_R1))
#define ST ((float*)(WSB() + WS_R2))
#define Z ((float*)(WSB() + WS_R2))
#define Y ((u16*)(WSB() + WS_R2))
#define slot_tok ((u16*)(WSB() + WS_SLOT))
#define tinfo ((int*)(WSB() + WS_TINFO))
#define DEC ((float*)(WSB() + WS_DEC))
#define gcnt_all ((u32*)(WSB() + WS_CTL + CTL_CNT))

    if (IN(0)) {
        REPEAT(K_CONV) phase_convert((char*)lds, p);
        __syncthreads();
        REPEAT(K_ROWSP) phase_rows_prologue(ldsf, p.in[I_X], p.in[I_WIN], XH, LR);
    }
    SEAM(0);
    for (int L = 0; L < NLAYER; ++L) {
        const int base = 1 + 9 * L;
        const bool even = (L & 1) == 0;
        const int i2 = L >> 1;
#define xin ((L == 0) ? p.in[I_X] : (const float*)XA)
#define xout ((L == NLAYER - 1) ? p.out : XA)
#define gcnt (gcnt_all + L * 16)
        if (even) {
            if (IN(base + 0)) REPEAT(K_INPROJ) phase_inproj(shm, XH, Wt_in + (size_t)i2 * 3072 * 1024, Hb, Vt, GVt);
            SEAM(base + 0);
            if (IN(base + 1)) {
                const float lam_init = 0.8f - 0.6f * expf(-0.3f * (float)L);
                REPEAT(K_ATTN) phase_attn((char*)lds, Hb, Vt, p.in[I_RELB], p.in[I_DLAM] + i2 * 256, p.in[I_DNORM] + i2 * 128, lam_init, MIX);
                __syncthreads();
                REPEAT(K_G1) phase_gla_g1((char*)lds, Hb, GVt, LR, p.in[I_WGG] + i2 * 2 * 16 * 256, p.in[I_BGG] + i2 * 2 * 256, ST, DEC);
            }
            SEAM(base + 1);
            if (IN(base + 2)) phase_gla_g2(ST, DEC, PS);
            SEAM(base + 2);
            if (IN(base + 3)) REPEAT(K_G3) phase_gla_g3((char*)lds, Hb, GVt, LR, p.in[I_WGG] + i2 * 2 * 16 * 256, p.in[I_BGG] + i2 * 2 * 256, PS, p.in[I_GNORM] + i2 * 128, MIX);
            SEAM(base + 3);
            if (IN(base + 4)) REPEAT(K_MIXPROJ) phase_mixproj(shm, MIX, Wt_out + (size_t)i2 * 1048576, false, xin, nullptr, Z);
            SEAM(base + 4);
        } else {
            if (IN(base + 0)) REPEAT(K_POOL) phase_rows_pool(xin, MIX);
            if (IN(base + 0) && IN(base + 4)) xcd_barrier(bar);
            if (IN(base + 4)) REPEAT(K_MIXPROJ) phase_mixproj(shm, MIX, Wt_pool + (size_t)i2 * 4 * 65536, true, xin, p.in[I_PSCALE] + i2 * 1024, Z);
            SEAM(base + 4);
        }
        if (IN(base + 5)) {
            if (L >= 1) { conv_pull((char*)lds, p, L, 1 << 30); __syncthreads(); }
            phase_rows_ln1(ldsf, (LAS RouteLds*)(lds + 98304), Z, p.in[I_LNG] + (L * 2) * 1024, p.in[I_LNB] + (L * 2) * 1024,
                                         p.in[I_WR], p.in[I_RB], XB, XH, gcnt, slot_tok, tinfo);
        }
        SEAM(base + 5);
        if (IN(base + 6)) { int nu = 0; REPEAT(K_MOE1) nu = phase_moe1(shm, mp, gcnt, slot_tok, XH, Wt_g + (size_t)L * 16 * 1048576, Wt_u + (size_t)L * 16 * 1048576, Hmoe);
            if (L + 1 < NLAYER) conv_pull((char*)lds, p, L + 1, spare_quota(nu, CONV_QUOTA)); }
        SEAM(base + 6);
        if (IN(base + 7)) { int nu = 0; REPEAT(K_MOE2) nu = phase_moe2(shm, mp, gcnt, Hmoe, Wt_d + (size_t)L * 16 * 1048576, Y);
            if (L + 1 < NLAYER) conv_pull((char*)lds, p, L + 1, spare_quota(nu, CONV_QUOTA)); }
        SEAM(base + 7);
        if (IN(base + 8)) REPEAT(K_LN2) phase_rows_ln2(ldsf, mp, gcnt, XB, Y, tinfo, p.in[I_LNG] + (L * 2 + 1) * 1024, p.in[I_LNB] + (L * 2 + 1) * 1024, xout, XH,
                                         (L + 1 < NLAYER && ((L + 1) & 1) == 0) ? p.in[I_WIN] + (size_t)((L + 1) >> 1) * 1024 * IN_COLS : nullptr, LR);
        SEAM(base + 8);
    }
#undef IN
#undef SEAM
#undef WSB
#undef Wt_in
#undef Wt_out
#undef Wt_pool
#undef Wt_g
#undef Wt_u
#undef Wt_d
#undef XA
#undef XB
#undef XH
#undef MIX
#undef LR
#undef Vt
#undef GVt
#undef PS
#undef Hb
#undef Hmoe
#undef ST
#undef Z
#undef Y
#undef slot_tok
#undef tinfo
#undef DEC
#undef gcnt_all
#undef xin
#undef xout
#undef gcnt
}

extern "C" void kernel_launch(void* const* d_in, const int* in_sizes, int n_in, void* d_out, int out_size, void* d_ws, size_t ws_size, hipStream_t stream) {
    static int grid = 0;
    if (grid == 0) {
        if (n_in != 18 || ws_size < WS_END) { fprintf(stderr, "kernel_launch: unexpected inputs (n_in %d, ws %zu < %zu)\n", n_in, ws_size, (size_t)WS_END); grid = -1; return; }
        int dev = 0, cus = 0, per_cu = 0;
        hipGetDevice(&dev);
        hipDeviceGetAttribute(&cus, hipDeviceAttributeMultiprocessorCount, dev);
        if (hipFuncSetAttribute((const void*)fwd_kernel, hipFuncAttributeMaxDynamicSharedMemorySize, LDS_BYTES) != hipSuccess) { fprintf(stderr, "kernel_launch: hipFuncSetAttribute failed\n"); grid = -1; return; }
        if (hipOccupancyMaxActiveBlocksPerMultiprocessor(&per_cu, (const void*)fwd_kernel, NTHR, LDS_BYTES) != hipSuccess || per_cu < 1) {
            fprintf(stderr, "kernel_launch: occupancy query reports %d blocks per CU\n", per_cu); }
        (void)hipGetLastError();
        grid = cus;
    }
    if (grid < 0) return;
    hipMemsetAsync((char*)d_ws + WS_CTL, 0, CTL_BYTES, stream);
    Params p{};
    for (int i = 0; i < 18; ++i) p.in[i] = (const float*)d_in[i];
    p.out = (float*)d_out; p.ws = (unsigned char*)d_ws;
#if ONE_LAUNCH
    p.ph_lo = 0; p.ph_hi = NPHASE;
    hipLaunchKernelGGL(fwd_kernel, dim3(grid), dim3(NTHR), LDS_BYTES, stream, p);
#else
    for (int k = 0; k < NPHASE; ++k) {
        const int L = (k - 1) / 9, r = (k - 1) % 9;
        if (k > 0 && (L & 1) == 1 && (r == 1 || r == 2 || r == 3)) continue;
        p.ph_lo = k; p.ph_hi = k + 1;
        hipLaunchKernelGGL(fwd_kernel, dim3(grid), dim3(NTHR), LDS_BYTES, stream, p);
    }
#endif
}
```
